# Optimizing an MI355X kernel written in HIP

```python
import math
import jax, jax.numpy as jnp
from jax import lax
import numpy as np

D_MODEL = 1024
BATCH = 4
SEQ = 8192
DEPTH = 2
DEC_BATCH = 4
DEC_SEQ = 4096
PAST_LEN = 128

GRID_W = 64
MIX_W = D_MODEL
HY_W = MIX_W // 2
ATT_W = MIX_W - HY_W
HEAD_DIM = 64
N_HEADS = ATT_W // HEAD_DIM
WIN_ROWS = 8
WIN_COLS = 16
SHORT_CONV = 3
POS_EMB_DIM = 33
POS_BANDS = (POS_EMB_DIM - 1) // 2
FILTER_HIDDEN = 64
FAST_DECAY_PCT = 0.3
SLOW_DECAY_PCT = 1.5
DECAY_TARGET = 1e-2
EPS = 1e-6
N_IN = 4 * HY_W + 4 * ATT_W

kernel_name = "hymba_hyena_natten_encoder"


def rmsnorm(x, g):
    xf = x.astype(jnp.float32)
    y = xf * lax.rsqrt(jnp.mean(xf * xf, axis=-1, keepdims=True) + EPS)
    return (y * g.astype(jnp.float32)).astype(x.dtype)


def short_conv(u, w, b):
    p = jnp.pad(u, ((0, 0), (1, 1), (0, 0)))
    return w[0] * p[:, :-2] + w[1] * p[:, 1:-1] + w[2] * p[:, 2:] + b


def hyena_filter(L, w1, b1, fr1, w2, b2, fr2, w3):
    f32 = jnp.float32
    t01 = jnp.linspace(0.0, 1.0, L, dtype=f32)[:, None]
    w = 2.0 * math.pi * jnp.arange(L, dtype=f32)[:, None] / L
    f = jnp.linspace(1e-4, POS_BANDS - 1, POS_BANDS, dtype=f32)[None, :]
    z = jnp.concatenate([t01, jnp.cos(f * w), -jnp.sin(f * w)], axis=-1)
    h = jnp.sin(fr1.astype(f32) * (z @ w1.astype(f32) + b1.astype(f32)))
    h = jnp.sin(fr2.astype(f32) * (h @ w2.astype(f32) + b2.astype(f32)))
    h = h @ w3.astype(f32)
    min_decay = math.log(DECAY_TARGET) / SLOW_DECAY_PCT
    max_decay = math.log(DECAY_TARGET) / FAST_DECAY_PCT
    deltas = jnp.linspace(min_decay, max_decay, 2 * HY_W, dtype=f32)[None, :]
    h = h * jnp.exp(-t01 * jnp.abs(deltas))
    h_fwd, h_bwd = h[:, :HY_W], h[:, HY_W:]
    return jnp.concatenate([h_fwd, jnp.zeros((1, HY_W), f32), h_bwd[:0:-1]], axis=0)


def long_conv(u, kfilt, bias):
    L = u.shape[1]
    uf = u.astype(jnp.float32)
    U = jnp.fft.rfft(uf, n=2 * L, axis=1)
    K = jnp.fft.rfft(kfilt, n=2 * L, axis=0)
    y = jnp.fft.irfft(U * K[None], n=2 * L, axis=1)[:, :L]
    return (y + uf * bias.astype(jnp.float32)).astype(u.dtype)


def neighbourhood_attention(q, k, v, rpb):
    B, L = q.shape[0], q.shape[1]
    rows = L // GRID_W
    kr = min(WIN_ROWS, rows)
    grid = lambda a: a.reshape(B, rows, GRID_W, N_HEADS, HEAD_DIM)
    qg, kg, vg = grid(q), grid(k), grid(v)
    cols = np.arange(GRID_W)
    col_start = np.clip(cols - WIN_COLS // 2, 0, GRID_W - WIN_COLS)
    col_idx = col_start[:, None] + np.arange(WIN_COLS)[None, :]
    col_off = col_idx - cols[:, None] + (WIN_COLS - 1)
    rpb_c = rpb.astype(jnp.float32)[:, :, col_off]
    scale = HEAD_DIM ** -0.5

    def one_row(r):
        r0 = jnp.clip(r - kr // 2, 0, rows - kr)
        q_r = lax.dynamic_index_in_dim(qg, r, axis=1, keepdims=False)
        k_band = lax.dynamic_slice_in_dim(kg, r0, kr, axis=1)
        v_band = lax.dynamic_slice_in_dim(vg, r0, kr, axis=1)
        k_win = k_band[:, :, col_idx]
        v_win = v_band[:, :, col_idx]
        row_off = r0 + jnp.arange(kr) - r + (WIN_ROWS - 1)
        bias = rpb_c[:, row_off].transpose(0, 2, 1, 3)
        s = jnp.einsum('bchd,bkcwhd->bhckw', q_r, k_win).astype(jnp.float32) * scale + bias
        p = jax.nn.softmax(s.reshape(B, N_HEADS, GRID_W, kr * WIN_COLS), axis=-1)
        p = p.reshape(B, N_HEADS, GRID_W, kr, WIN_COLS).astype(v.dtype)
        return jnp.einsum('bhckw,bkcwhd->bchd', p, v_win)

    out = lax.map(one_row, jnp.arange(rows))
    return out.transpose(1, 0, 2, 3, 4).reshape(B, L, N_HEADS * HEAD_DIM)


def encoder_layer(x, norm_g, w_in, conv_w, conv_b, f_w1, f_b1, f_fr1, f_w2, f_b2, f_fr2,
                  f_w3, hy_bias, qn_g, kn_g, rpb, on_hy, on_att, w_out):
    B, L, _ = x.shape
    h = rmsnorm(x, norm_g)
    z = h @ w_in
    hy_in, hy_gate, att_qkv, att_gate = jnp.split(
        z, [3 * HY_W, 4 * HY_W, 4 * HY_W + 3 * ATT_W], axis=-1)
    hy_in = short_conv(hy_in, conv_w, conv_b)
    x0, x1, vv = jnp.split(hy_in, 3, axis=-1)
    kfilt = hyena_filter(L, f_w1, f_b1, f_fr1, f_w2, f_b2, f_fr2, f_w3)
    y_hy = x0 * long_conv(x1 * vv, kfilt, hy_bias)
    y_hy = rmsnorm(y_hy, on_hy) * jax.nn.silu(hy_gate)
    q, k, v = jnp.split(att_qkv, 3, axis=-1)
    q = rmsnorm(q.reshape(B, L, N_HEADS, HEAD_DIM), qn_g)
    k = rmsnorm(k.reshape(B, L, N_HEADS, HEAD_DIM), kn_g)
    v = v.reshape(B, L, N_HEADS, HEAD_DIM)
    y_att = neighbourhood_attention(q, k, v, rpb)
    y_att = rmsnorm(y_att, on_att) * jax.nn.silu(att_gate)
    return x + jnp.concatenate([y_hy, y_att], axis=-1) @ w_out


def trunk(x, norm_g, w_in, conv_w, conv_b, f_w1, f_b1, f_fr1, f_w2, f_b2, f_fr2, f_w3,
          hy_bias, qn_g, kn_g, rpb, on_hy, on_att, w_out):
    for i in range(DEPTH):
        x = encoder_layer(x, norm_g[i], w_in[i], conv_w[i], conv_b[i], f_w1[i], f_b1[i],
                          f_fr1[i], f_w2[i], f_b2[i], f_fr2[i], f_w3[i], hy_bias[i],
                          qn_g[i], kn_g[i], rpb[i], on_hy[i], on_att[i], w_out[i])
    return x


def setup_inputs(seed: int = 0) -> dict:
    key = jax.random.key(seed)
    ks = jax.random.split(key, 24)
    f32 = jnp.float32
    nrm = lambda k, shape, s: jax.random.normal(k, shape, f32) * s
    gain = lambda k, shape: 1.0 + 0.01 * jax.random.normal(k, shape, f32)
    return {
        "x_prompt": jax.random.normal(ks[0], (BATCH, SEQ, D_MODEL), f32),
        "x_sample": jax.random.normal(ks[1], (DEC_BATCH, DEC_SEQ, D_MODEL), f32),
        "norm_g": gain(ks[2], (DEPTH, D_MODEL)),
        "w_in": nrm(ks[3], (DEPTH, D_MODEL, N_IN), D_MODEL ** -0.5),
        "conv_w": nrm(ks[4], (DEPTH, SHORT_CONV, 3 * HY_W), SHORT_CONV ** -0.5),
        "conv_b": nrm(ks[5], (DEPTH, 3 * HY_W), 0.01),
        "f_w1": nrm(ks[6], (DEPTH, POS_EMB_DIM, FILTER_HIDDEN), POS_EMB_DIM ** -0.5),
        "f_b1": nrm(ks[7], (DEPTH, FILTER_HIDDEN), 0.1),
        "f_fr1": gain(ks[8], (DEPTH, FILTER_HIDDEN)),
        "f_w2": nrm(ks[9], (DEPTH, FILTER_HIDDEN, FILTER_HIDDEN), FILTER_HIDDEN ** -0.5),
        "f_b2": nrm(ks[10], (DEPTH, FILTER_HIDDEN), 0.1),
        "f_fr2": gain(ks[11], (DEPTH, FILTER_HIDDEN)),
        "f_w3": nrm(ks[12], (DEPTH, FILTER_HIDDEN, 2 * HY_W), FILTER_HIDDEN ** -0.5),
        "hy_bias": nrm(ks[13], (DEPTH, HY_W), 0.5),
        "qn_g": gain(ks[14], (DEPTH, HEAD_DIM)),
        "kn_g": gain(ks[15], (DEPTH, HEAD_DIM)),
        "rpb": nrm(ks[16], (DEPTH, N_HEADS, 2 * WIN_ROWS - 1, 2 * WIN_COLS - 1), 0.02),
        "on_hy": gain(ks[17], (DEPTH, HY_W)),
        "on_att": gain(ks[18], (DEPTH, ATT_W)),
        "w_out": nrm(ks[19], (DEPTH, MIX_W, D_MODEL), MIX_W ** -0.5),
    }


def reference(x_prompt, x_sample, norm_g, w_in, conv_w, conv_b, f_w1, f_b1, f_fr1, f_w2,
              f_b2, f_fr2, f_w3, hy_bias, qn_g, kn_g, rpb, on_hy, on_att, w_out):
    y_prompt = trunk(x_prompt, norm_g, w_in, conv_w, conv_b, f_w1, f_b1, f_fr1, f_w2, f_b2,
                     f_fr2, f_w3, hy_bias, qn_g, kn_g, rpb, on_hy, on_att, w_out)
    y_sample = trunk(x_sample, norm_g, w_in, conv_w, conv_b, f_w1, f_b1, f_fr1, f_w2, f_b2,
                     f_fr2, f_w3, hy_bias, qn_g, kn_g, rpb, on_hy, on_att, w_out)
    return (y_prompt, y_sample)
```

```cpp
#include <hip/hip_runtime.h>
#include <hip/hip_cooperative_groups.h>
#include <stdint.h>
#include <stdio.h>
namespace cg = cooperative_groups;

#ifndef MULTI
#define MULTI 1
#endif

typedef __attribute__((ext_vector_type(8))) short bf16x8;
typedef __attribute__((ext_vector_type(4))) short s16x4;
typedef __attribute__((ext_vector_type(16))) float f32x16;
typedef __attribute__((ext_vector_type(4))) float f32x4;
typedef short v4i16_t __attribute__((ext_vector_type(4)));
typedef __attribute__((ext_vector_type(4))) unsigned int u32x4;
typedef __attribute__((ext_vector_type(2))) unsigned int u32x2;
typedef __attribute__((address_space(3))) const char* lds_cptr;

#define NTOK 49152
#define NPTOK 32768
#define EPSV 1e-6f
#define LOG2E 1.4426950408889634f
#define LDS_BYTES 69760

struct Params {
  const float* xp; const float* xs;
  const float* norm_g; const float* w_in; const float* conv_w; const float* conv_b;
  const float* f_w1; const float* f_b1; const float* f_fr1; const float* f_w2; const float* f_b2;
  const float* f_fr2; const float* f_w3; const float* hy_bias; const float* qn_g; const float* kn_g;
  const float* rpb; const float* on_hy; const float* on_att; const float* w_out;
  float* out;
  unsigned short* zT;
  unsigned short* z2;
  unsigned short* filt;
  unsigned short* winT;
  unsigned short* woutT;
  float* ssqA;
};

__device__ __forceinline__ unsigned short f2bf(float f) {
  unsigned int u = __float_as_uint(f);
  u += 0x7fffu + ((u >> 16) & 1u);
  return (unsigned short)(u >> 16);
}
__device__ __forceinline__ float bf2f(unsigned short h) { return __uint_as_float(((unsigned int)h) << 16); }
__device__ __forceinline__ unsigned int pack2(float a, float b) { return (unsigned)f2bf(a) | ((unsigned)f2bf(b) << 16); }
__device__ __forceinline__ float lo2f(unsigned int u) { return __uint_as_float(u << 16); }
__device__ __forceinline__ float hi2f(unsigned int u) { return __uint_as_float(u & 0xffff0000u); }
__device__ __forceinline__ float silu_f(float g) { return g / (1.f + __expf(-g)); }
__device__ __forceinline__ int swz_off(int row, int ch) { return row * 128 + ((ch ^ ((row >> 1) & 7)) << 4); }

__device__ __forceinline__ f32x16 mfma32(bf16x8 a, bf16x8 b, f32x16 c) { return __builtin_amdgcn_mfma_f32_32x32x16_bf16(a, b, c, 0, 0, 0); }
__device__ __forceinline__ f32x4 mfma16(bf16x8 a, bf16x8 b, f32x4 c) { return __builtin_amdgcn_mfma_f32_16x16x32_bf16(a, b, c, 0, 0, 0); }

__device__ __forceinline__ u32x4 mk4(unsigned a, unsigned b, unsigned c, unsigned d) { u32x4 r = {a, b, c, d}; return r; }
__device__ __forceinline__ u32x2 mk2(unsigned a, unsigned b) { u32x2 r = {a, b}; return r; }
__device__ __forceinline__ bf16x8 u4_to_frag(u32x4 v) {
  union { u32x4 u; bf16x8 f; } x; x.u = v; return x.f;
}

__device__ void filter_unit(const Params& P, int u, char* lds) {
  const int tid = threadIdx.x, lane = tid & 63;
  const int wave = __builtin_amdgcn_readfirstlane(tid >> 6);
  const int l = u / 192; const int rr = u % 192;
  const int set = rr < 128 ? 0 : 1; const int pch = set ? rr - 128 : rr;
  const int L = set ? 4096 : 8192;
  const int p = pch * 64 + lane;
  const float t01 = (float)p / (float)(L - 1);
  const float pl = (float)p / (float)L;
  float* zs = (float*)lds;
  float* h1s = zs + 33 * 64;
  float* h2s = h1s + 64 * 64;
  if (wave == 0) {
    zs[lane] = t01;
#pragma unroll
    for (int k = 0; k < 16; ++k) {
      float fk = 1e-4f + (float)k * ((15.f - 1e-4f) / 15.f);
      float tr = fk * pl; tr -= floorf(tr);
      zs[(1 + k) * 64 + lane] = __builtin_amdgcn_cosf(tr);
      zs[(17 + k) * 64 + lane] = -__builtin_amdgcn_sinf(tr);
    }
  }
  __syncthreads();
  const float* w1 = P.f_w1 + l * 33 * 64; const float* b1 = P.f_b1 + l * 64; const float* fr1 = P.f_fr1 + l * 64;
  const float* w2 = P.f_w2 + l * 64 * 64; const float* b2 = P.f_b2 + l * 64; const float* fr2 = P.f_fr2 + l * 64;
  const float* w3 = P.f_w3 + l * 64 * 1024;
  const int j0 = wave * 16;
  {
    float acc[16];
#pragma unroll
    for (int j = 0; j < 16; ++j) acc[j] = b1[j0 + j];
#pragma unroll 3
    for (int i = 0; i < 33; ++i) {
      const float zv = zs[i * 64 + lane];
#pragma unroll
      for (int j = 0; j < 16; ++j) acc[j] += zv * w1[i * 64 + j0 + j];
    }
#pragma unroll
    for (int j = 0; j < 16; ++j) h1s[(j0 + j) * 64 + lane] = __builtin_amdgcn_sinf(fr1[j0 + j] * acc[j] * 0.15915494309189535f);
  }
  __syncthreads();
  {
    float acc[16];
#pragma unroll
    for (int j = 0; j < 16; ++j) acc[j] = b2[j0 + j];
#pragma unroll 4
    for (int i = 0; i < 64; ++i) {
      const float hv = h1s[i * 64 + lane];
#pragma unroll
      for (int j = 0; j < 16; ++j) acc[j] += hv * w2[i * 64 + j0 + j];
    }
#pragma unroll
    for (int j = 0; j < 16; ++j) h2s[(j0 + j) * 64 + lane] = __builtin_amdgcn_sinf(fr2[j0 + j] * acc[j] * 0.15915494309189535f);
  }
  __syncthreads();
  const float mind = -3.0701134573253943f, maxd = -15.350567286626972f;
  const int setoff = set ? 16384 : 0;
  const int col0 = wave * 256;
  for (int cb = 0; cb < 256; cb += 16) {
    float acc[16];
#pragma unroll
    for (int e = 0; e < 16; ++e) acc[e] = 0.f;
#pragma unroll 4
    for (int j = 0; j < 64; ++j) {
      const float hv = h2s[j * 64 + lane];
#pragma unroll
      for (int e = 0; e < 16; ++e) acc[e] += hv * w3[j * 1024 + col0 + cb + e];
    }
#pragma unroll
    for (int e = 0; e < 16; ++e) {
      int col = col0 + cb + e;
      float delta = fabsf(mind + (float)col * ((maxd - mind) / 1023.f));
      float val = acc[e] * __expf(-t01 * delta);
      int c = col & 511;
      unsigned short* dst = P.filt + ((long)(l * 512 + c)) * 24576 + setoff;
      if (col < 512) dst[L - p] = f2bf(val);
      else { if (p > 0) dst[L + p] = f2bf(val); else dst[0] = 0; }
    }
  }
  __syncthreads();
}

__device__ void phase_prep(const Params& P, int bid, int nb, char* lds) {
  const int tid = threadIdx.x;
  const long gt = (long)bid * 256 + tid, gs = (long)nb * 256;
  for (long i = gt; i < 2L * 128 * 4096; i += gs) {
    int n = (int)(i & 4095); int kc = (int)((i >> 12) & 127); int l = (int)(i >> 19);
    const float* w = P.w_in + ((long)l * 1024 + kc * 8) * 4096 + n;
    const float* g = P.norm_g + l * 1024 + kc * 8;
    unsigned int o[4];
#pragma unroll
    for (int j = 0; j < 4; ++j) o[j] = pack2(w[(long)(2 * j) * 4096] * g[2 * j], w[(long)(2 * j + 1) * 4096] * g[2 * j + 1]);
    *(u32x4*)(P.winT + ((long)l * 4096 + n) * 1024 + kc * 8) = mk4(o[0], o[1], o[2], o[3]);
  }
  for (long i = gt; i < 2L * 128 * 1024; i += gs) {
    int n = (int)(i & 1023); int kc = (int)((i >> 10) & 127); int l = (int)(i >> 17);
    const float* w = P.w_out + ((long)l * 1024 + kc * 8) * 1024 + n;
    const float* g = (kc < 64) ? (P.on_hy + l * 512 + kc * 8) : (P.on_att + l * 512 + (kc - 64) * 8);
    unsigned int o[4];
#pragma unroll
    for (int j = 0; j < 4; ++j) o[j] = pack2(w[(long)(2 * j) * 1024] * g[2 * j], w[(long)(2 * j + 1) * 1024] * g[2 * j + 1]);
    *(u32x4*)(P.woutT + ((long)l * 1024 + n) * 1024 + kc * 8) = mk4(o[0], o[1], o[2], o[3]);
  }
  for (int u = bid; u < 384; u += nb) filter_unit(P, u, lds);
}

__device__ void p1_tile(const Params& P, int layer, int mt, int nt, char* lds) {
  const int tid = threadIdx.x, lane = tid & 63, wave = tid >> 6;
  const int tok0 = mt * 128, n0 = nt * 128;
  bool swap; int dst0; int mode = 0;
  if (n0 < 1536) { swap = false; dst0 = n0; }
  else if (n0 < 2048) { swap = false; dst0 = 2048 + (n0 - 1536); }
  else if (n0 < 2560) { swap = true; dst0 = n0 - 2048; mode = 1; }
  else if (n0 < 3072) { swap = true; dst0 = 512 + (n0 - 2560); mode = 2; }
  else if (n0 < 3584) { swap = false; dst0 = 1536 + (n0 - 3072); }
  else { swap = true; dst0 = 1024 + (n0 - 3584); }
  const float* xsrc = (layer == 0) ? ((tok0 < NPTOK) ? P.xp + (long)tok0 * 1024 : P.xs + (long)(tok0 - NPTOK) * 1024)
                                   : P.out + (long)tok0 * 1024;
  const unsigned short* wsrc = P.winT + ((long)layer * 4096 + n0) * 1024;
  char* As = lds; char* Bs = lds + 16384; char* S = lds; float* rs = (float*)(lds + 40960);
  const int wp = wave >> 1, wq = wave & 1;
  const char* Pb = swap ? Bs : As; const char* Qb = swap ? As : Bs;
  f32x16 acc[2][2];
#pragma unroll
  for (int i = 0; i < 2; ++i)
#pragma unroll
    for (int j = 0; j < 2; ++j)
#pragma unroll
      for (int e = 0; e < 16; ++e) acc[i][j][e] = 0.f;
  const int r8 = tid >> 3, ch = tid & 7;
  f32x4 av[4][2]; u32x4 bv[4]; float ssq[4] = {0.f, 0.f, 0.f, 0.f};
#pragma unroll
  for (int i = 0; i < 4; ++i) {
    const float* s = xsrc + (long)(r8 + 32 * i) * 1024 + ch * 8;
    av[i][0] = *(const f32x4*)s; av[i][1] = *(const f32x4*)(s + 4);
    bv[i] = *(const u32x4*)(wsrc + (long)(r8 + 32 * i) * 1024 + ch * 8);
  }
  for (int ks = 0; ks < 16; ++ks) {
#pragma unroll
    for (int i = 0; i < 4; ++i) {
      f32x4 a0 = av[i][0], a1 = av[i][1];
      ssq[i] += a0.x * a0.x + a0.y * a0.y + a0.z * a0.z + a0.w * a0.w + a1.x * a1.x + a1.y * a1.y + a1.z * a1.z + a1.w * a1.w;
      u32x4 pk = mk4(pack2(a0.x, a0.y), pack2(a0.z, a0.w), pack2(a1.x, a1.y), pack2(a1.z, a1.w));
      *(u32x4*)(As + swz_off(r8 + 32 * i, ch)) = pk;
      *(u32x4*)(Bs + swz_off(r8 + 32 * i, ch)) = bv[i];
    }
    __syncthreads();
    if (ks < 15) {
      const int k0 = (ks + 1) * 64;
#pragma unroll
      for (int i = 0; i < 4; ++i) {
        const float* s = xsrc + (long)(r8 + 32 * i) * 1024 + k0 + ch * 8;
        av[i][0] = *(const f32x4*)s; av[i][1] = *(const f32x4*)(s + 4);
        bv[i] = *(const u32x4*)(wsrc + (long)(r8 + 32 * i) * 1024 + k0 + ch * 8);
      }
    }
#pragma unroll
    for (int kk = 0; kk < 4; ++kk) {
      bf16x8 a[2], b[2];
#pragma unroll
      for (int i = 0; i < 2; ++i) a[i] = *(const bf16x8*)(Pb + swz_off(64 * wp + 32 * i + (lane & 31), 2 * kk + (lane >> 5)));
#pragma unroll
      for (int j = 0; j < 2; ++j) b[j] = *(const bf16x8*)(Qb + swz_off(64 * wq + 32 * j + (lane & 31), 2 * kk + (lane >> 5)));
#pragma unroll
      for (int i = 0; i < 2; ++i)
#pragma unroll
        for (int j = 0; j < 2; ++j) acc[i][j] = mfma32(a[i], b[j], acc[i][j]);
    }
    __syncthreads();
  }
#pragma unroll
  for (int i = 0; i < 4; ++i) {
    float s = ssq[i];
    s += __shfl_xor(s, 1); s += __shfl_xor(s, 2); s += __shfl_xor(s, 4);
    if (ch == 0) rs[r8 + 32 * i] = rsqrtf(s * (1.f / 1024.f) + EPSV);
  }
  __syncthreads();
#pragma unroll
  for (int i = 0; i < 2; ++i)
#pragma unroll
    for (int j = 0; j < 2; ++j) {
      const int q = 64 * wq + 32 * j + (lane & 31);
#pragma unroll
      for (int g4 = 0; g4 < 4; ++g4) {
        const int p = 64 * wp + 32 * i + 8 * g4 + 4 * (lane >> 5);
        float v[4];
#pragma unroll
        for (int e = 0; e < 4; ++e) v[e] = acc[i][j][4 * g4 + e] * (swap ? rs[q] : rs[p + e]);
        *(u32x2*)(S + q * 272 + p * 2) = mk2(pack2(v[0], v[1]), pack2(v[2], v[3]));
      }
    }
  __syncthreads();
#pragma unroll
  for (int it = 0; it < 8; ++it) {
    const int id = tid + 256 * it; const int row = id >> 4, c16 = id & 15;
    u32x4 v = *(const u32x4*)(S + row * 272 + c16 * 16);
    if (!swap) {
      *(u32x4*)(P.zT + (long)(dst0 + row) * NTOK + tok0 + c16 * 8) = v;
    } else {
      if (mode) {
        float f[8];
        f[0] = lo2f(v.x); f[1] = hi2f(v.x); f[2] = lo2f(v.y); f[3] = hi2f(v.y);
        f[4] = lo2f(v.z); f[5] = hi2f(v.z); f[6] = lo2f(v.w); f[7] = hi2f(v.w);
        float ss = 0.f;
#pragma unroll
        for (int e = 0; e < 8; ++e) ss += f[e] * f[e];
        ss += __shfl_xor(ss, 1); ss += __shfl_xor(ss, 2); ss += __shfl_xor(ss, 4);
        float sc = rsqrtf(ss * (1.f / 64.f) + EPSV);
        if (mode == 1) sc *= 0.125f * LOG2E;
        const float* g = (mode == 1 ? P.qn_g : P.kn_g) + layer * 64 + (c16 & 7) * 8;
#pragma unroll
        for (int e = 0; e < 8; ++e) f[e] *= sc * g[e];
        v = mk4(pack2(f[0], f[1]), pack2(f[2], f[3]), pack2(f[4], f[5]), pack2(f[6], f[7]));
      }
      *(u32x4*)(P.z2 + (long)(tok0 + row) * 1536 + dst0 + c16 * 8) = v;
    }
  }
  __syncthreads();
}

__device__ void phase_p1(const Params& P, int layer, int bid, int nb, char* lds) {
  for (int v = bid; v < 12288; v += nb) {
    int wv = v >> 9, within = v & 511, x = within & 7, idx = within >> 3;
    int mt = wv * 16 + (x >> 2) * 8 + (idx >> 3);
    int nt = (x & 3) * 8 + (idx & 7);
    p1_tile(P, layer, mt, nt, lds);
  }
}

template <int R>
__device__ void conv_unit(const Params& P, int layer, int set, int c, int bp, char* lds) {
  constexpr int L = 2048 * R, NB = L / 32, UB = (NB + 32) * 64;
  char* U = lds; char* F = lds + 2 * UB;
  const int tid = threadIdx.x, lane = tid & 63, wave = tid >> 6;
  const long tokbase = (long)(set ? NPTOK : 0) + (long)(2 * bp) * L;
  const unsigned short* x0r = P.zT + (long)c * NTOK + tokbase;
  const unsigned short* x1r = P.zT + (long)(512 + c) * NTOK + tokbase;
  const unsigned short* vr = P.zT + (long)(1024 + c) * NTOK + tokbase;
  const float* cw = P.conv_w + layer * 3 * 1536; const float* cb = P.conv_b + layer * 1536;
  {
    const float w1a = cw[512 + c], w1b = cw[1536 + 512 + c], w1c = cw[3072 + 512 + c], b1 = cb[512 + c];
    const float wva = cw[1024 + c], wvb = cw[1536 + 1024 + c], wvc = cw[3072 + 1024 + c], bvv = cb[1024 + c];
    {
      int bb = tid >> 7; int rem = tid & 127; int side = rem >> 6; int o = rem & 63;
      *(u32x4*)(U + bb * UB + (side ? (NB + 16) * 64 : 0) + o * 16) = mk4(0, 0, 0, 0);
    }
    for (int id = tid; id < 2 * L / 8; id += 256) {
      const int bb = id / (L / 8); const int t8 = (id % (L / 8)) * 8;
      const unsigned short* a = x1r + (long)bb * L + t8; const unsigned short* b = vr + (long)bb * L + t8;
      u32x4 xa = *(const u32x4*)a; u32x4 xb = *(const u32x4*)b;
      float xs[10], vs[10];
      xs[0] = t8 > 0 ? bf2f(a[-1]) : 0.f; xs[9] = (t8 + 8 < L) ? bf2f(a[8]) : 0.f;
      vs[0] = t8 > 0 ? bf2f(b[-1]) : 0.f; vs[9] = (t8 + 8 < L) ? bf2f(b[8]) : 0.f;
      xs[1] = lo2f(xa.x); xs[2] = hi2f(xa.x); xs[3] = lo2f(xa.y); xs[4] = hi2f(xa.y);
      xs[5] = lo2f(xa.z); xs[6] = hi2f(xa.z); xs[7] = lo2f(xa.w); xs[8] = hi2f(xa.w);
      vs[1] = lo2f(xb.x); vs[2] = hi2f(xb.x); vs[3] = lo2f(xb.y); vs[4] = hi2f(xb.y);
      vs[5] = lo2f(xb.z); vs[6] = hi2f(xb.z); vs[7] = lo2f(xb.w); vs[8] = hi2f(xb.w);
      float uu[8];
#pragma unroll
      for (int e = 0; e < 8; ++e) {
        float x1c = w1a * xs[e] + w1b * xs[e + 1] + w1c * xs[e + 2] + b1;
        float vc = wva * vs[e] + wvb * vs[e + 1] + wvc * vs[e + 2] + bvv;
        uu[e] = x1c * vc;
      }
      const int blk = (t8 >> 5) + 16; const int chunk = (t8 >> 3) & 3;
      *(u32x4*)(U + bb * UB + blk * 64 + ((chunk ^ ((blk >> 2) & 3)) << 4)) =
          mk4(pack2(uu[0], uu[1]), pack2(uu[2], uu[3]), pack2(uu[4], uu[5]), pack2(uu[6], uu[7]));
    }
    const unsigned short* fsrc = P.filt + ((long)(layer * 512 + c)) * 24576 + (set ? 16384 : 0);
    for (int id = tid; id < 2 * L / 8; id += 256) *(u32x4*)(F + id * 16) = *(const u32x4*)(fsrc + id * 8);
    if (tid == 0) *(u32x4*)(F + 2 * L * 2) = mk4(0, 0, 0, 0);
  }
  __syncthreads();

  const int T0w = wave * (NB / 4);
  const int ii = lane & 31, h = lane >> 5;
  const int bb = (lane >> 4) & 1, mm = lane & 15;
  f32x16 acc[R];
#pragma unroll
  for (int r = 0; r < R; ++r)
#pragma unroll
    for (int e = 0; e < 16; ++e) acc[r][e] = 0.f;
  bf16x8 Ar[R][2];

#define LOAD_A(dst, dd) do { \
    _Pragma("unroll") for (int kk_ = 0; kk_ < 2; ++kk_) { \
      const int ms_ = L - 32 * (dd) - ii + 16 * kk_ + 8 * h; \
      const unsigned sh_ = (unsigned)(ms_ & 1) * 16u; \
      const unsigned* fp_ = (const unsigned*)F + (ms_ >> 1); \
      unsigned d0_ = fp_[0], d1_ = fp_[1], d2_ = fp_[2], d3_ = fp_[3], d4_ = fp_[4]; \
      union { unsigned u[4]; bf16x8 f; } x_; \
      x_.u[0] = __builtin_amdgcn_alignbit(d1_, d0_, sh_); x_.u[1] = __builtin_amdgcn_alignbit(d2_, d1_, sh_); \
      x_.u[2] = __builtin_amdgcn_alignbit(d3_, d2_, sh_); x_.u[3] = __builtin_amdgcn_alignbit(d4_, d3_, sh_); \
      (dst)[kk_] = x_.f; } } while (0)

  constexpr int NSTEP = NB / 16 + 1;
  constexpr int NQ = (NSTEP + R - 1) / R;
  for (int e = 0; e < 16; ++e) {
    const int sb0 = -15 + e;
    const int D0 = T0w - sb0;
#pragma unroll
    for (int s = 1; s < R; ++s) LOAD_A(Ar[s], D0 + 16 * s);
    for (int Q = 0; Q < NQ; ++Q) {
#pragma unroll
      for (int u = 0; u < R; ++u) {
        const int q = Q * R + u; const int sb = sb0 + 16 * q;
        if (sb < NB) {
          LOAD_A(Ar[(R - u) % R], D0 - 16 * q);
          const int blk = sb + mm + 16;
          bf16x8 Bf[2];
#pragma unroll
          for (int kk = 0; kk < 2; ++kk)
            Bf[kk] = *(const bf16x8*)(U + bb * UB + blk * 64 + (((2 * kk + h) ^ ((blk >> 2) & 3)) << 4));
#pragma unroll
          for (int r = 0; r < R; ++r) {
            acc[r] = mfma32(Ar[(r - u + R) % R][0], Bf[0], acc[r]);
            acc[r] = mfma32(Ar[(r - u + R) % R][1], Bf[1], acc[r]);
          }
        }
      }
    }
  }
#undef LOAD_A
  {
    const float hb = P.hy_bias[layer * 512 + c];
    const float w0a = cw[c], w0b = cw[1536 + c], w0c = cw[3072 + c], b0 = cb[c];
    unsigned short* yout = P.zT + (long)(512 + c) * NTOK + tokbase;
#pragma unroll
    for (int r = 0; r < R; ++r) {
      const int t0 = T0w + 16 * r + mm; const int blk = t0 + 16;
#pragma unroll
      for (int g4 = 0; g4 < 4; ++g4) {
        const int t = t0 * 32 + 8 * g4 + 4 * h;
        u32x2 uv = *(const u32x2*)(U + bb * UB + blk * 64 + ((g4 ^ ((blk >> 2) & 3)) << 4) + 8 * h);
        const unsigned short* xp = x0r + (long)bb * L + t;
        u32x2 xv = *(const u32x2*)xp;
        float xs[6];
        xs[0] = t > 0 ? bf2f(xp[-1]) : 0.f; xs[5] = (t + 4 < L) ? bf2f(xp[4]) : 0.f;
        xs[1] = lo2f(xv.x); xs[2] = hi2f(xv.x); xs[3] = lo2f(xv.y); xs[4] = hi2f(xv.y);
        float us[4] = {lo2f(uv.x), hi2f(uv.x), lo2f(uv.y), hi2f(uv.y)};
        float o[4];
#pragma unroll
        for (int e = 0; e < 4; ++e) {
          float x0c = w0a * xs[e] + w0b * xs[e + 1] + w0c * xs[e + 2] + b0;
          float y = acc[r][4 * g4 + e] + hb * us[e];
          o[e] = x0c * y;
        }
        *(u32x2*)(yout + (long)bb * L + t) = mk2(pack2(o[0], o[1]), pack2(o[2], o[3]));
      }
    }
  }
  __syncthreads();
}

__device__ void attn_unit(const Params& P, int layer, int a, char* lds) {
  float* rp = (float*)lds;
  const int tid = threadIdx.x, lane = tid & 63, wave = tid >> 6;
  const int hd = a & 7, rowg = a >> 3;
  int rows, r;
  if (rowg < 512) { rows = 128; r = rowg & 127; } else { rows = 64; r = (rowg - 512) & 63; }
  const int rowbase = rowg - r;
  const int r0 = min(max(r - 4, 0), rows - 8);
  for (int i = tid; i < 465; i += 256) rp[i] = P.rpb[(layer * 8 + hd) * 465 + i] * LOG2E;
  __syncthreads();
  const int c0 = wave * 16; const int kc0 = min(max(c0 - 8, 0), 32);
  const int qi = lane & 15, g = lane >> 4;
  const long qtok = (long)rowg * 64 + c0 + qi;
  const unsigned short* qptr = P.z2 + qtok * 1536 + hd * 64 + 8 * g;
  const bf16x8 Qf0 = *(const bf16x8*)qptr, Qf1 = *(const bf16x8*)(qptr + 32);
  f32x4 S[16];
  const long bandtok = (long)(rowbase + r0) * 64;
#pragma unroll
  for (int T = 0; T < 16; ++T) {
    const int kr = T >> 1, half = T & 1;
    const long ktok = bandtok + kr * 64 + kc0 + 16 * half + qi;
    const unsigned short* kp = P.z2 + ktok * 1536 + 512 + hd * 64 + 8 * g;
    const bf16x8 K0 = *(const bf16x8*)kp, K1 = *(const bf16x8*)(kp + 32);
    f32x4 s = {0.f, 0.f, 0.f, 0.f};
    s = mfma16(K0, Qf0, s); s = mfma16(K1, Qf1, s);
    S[T] = s;
  }
  const int qc = c0 + qi; const int cs = min(max(qc - 8, 0), 48);
  float mx = -1e30f;
#pragma unroll
  for (int T = 0; T < 16; ++T) {
    const int kr = T >> 1, half = T & 1;
    const int ro = r0 + kr - r + 7;
#pragma unroll
    for (int e = 0; e < 4; ++e) {
      const int kc = kc0 + 16 * half + 4 * g + e;
      const bool valid = (kc >= cs) && (kc < cs + 16);
      const int idx = valid ? (ro * 31 + kc - qc + 15) : 0;
      float v = valid ? (S[T][e] + rp[idx]) : -1e30f;
      S[T][e] = v; mx = fmaxf(mx, v);
    }
  }
  mx = fmaxf(mx, __shfl_xor(mx, 16)); mx = fmaxf(mx, __shfl_xor(mx, 32));
  float sum = 0.f;
#pragma unroll
  for (int T = 0; T < 16; ++T)
#pragma unroll
    for (int e = 0; e < 4; ++e) { float p = exp2f(S[T][e] - mx); S[T][e] = p; sum += p; }
  sum += __shfl_xor(sum, 16); sum += __shfl_xor(sum, 32);
  f32x4 O[4];
#pragma unroll
  for (int dt = 0; dt < 4; ++dt) O[dt] = (f32x4){0.f, 0.f, 0.f, 0.f};
#pragma unroll
  for (int kr = 0; kr < 8; ++kr) {
    union { unsigned u[4]; bf16x8 f; } pf;
    pf.u[0] = pack2(S[2 * kr][0], S[2 * kr][1]); pf.u[1] = pack2(S[2 * kr][2], S[2 * kr][3]);
    pf.u[2] = pack2(S[2 * kr + 1][0], S[2 * kr + 1][1]); pf.u[3] = pack2(S[2 * kr + 1][2], S[2 * kr + 1][3]);
    const long vt = bandtok + kr * 64 + kc0 + 4 * g;
#pragma unroll
    for (int dt = 0; dt < 4; ++dt) {
      const unsigned short* vp = P.zT + (long)(1536 + hd * 64 + 16 * dt + qi) * NTOK + vt;
      u32x2 v0 = *(const u32x2*)vp; u32x2 v1 = *(const u32x2*)(vp + 16);
      union { unsigned u[4]; bf16x8 f; } vf;
      vf.u[0] = v0.x; vf.u[1] = v0.y; vf.u[2] = v1.x; vf.u[3] = v1.y;
      O[dt] = mfma16(vf.f, pf.f, O[dt]);
    }
  }
  const float inv = 1.f / sum; float ss = 0.f;
#pragma unroll
  for (int dt = 0; dt < 4; ++dt) {
    float o[4];
#pragma unroll
    for (int e = 0; e < 4; ++e) { o[e] = O[dt][e] * inv; ss += o[e] * o[e]; }
    *(u32x2*)(P.z2 + qtok * 1536 + hd * 64 + 16 * dt + 4 * g) = mk2(pack2(o[0], o[1]), pack2(o[2], o[3]));
  }
  ss += __shfl_xor(ss, 16); ss += __shfl_xor(ss, 32);
  if (g == 0) P.ssqA[qtok * 8 + hd] = ss;
  __syncthreads();
}

__device__ void phase_p2(const Params& P, int layer, int bid, int nb, char* lds) {
  for (int u = bid; u < 2048; u += nb) {
    if (u < 1024) conv_unit<4>(P, layer, 0, u & 511, u >> 9, lds);
    else conv_unit<2>(P, layer, 1, (u - 1024) & 511, (u - 1024) >> 9, lds);
  }
  for (int a = bid; a < 6144; a += nb) attn_unit(P, layer, a, lds);
}

__device__ __forceinline__ u32x4 ldg16(const void* base, unsigned off) { return *(const u32x4*)((const char*)base + off); }

__device__ __forceinline__ void unpack8(u32x4 v, float* f) {
  f[0] = lo2f(v.x); f[1] = hi2f(v.x); f[2] = lo2f(v.y); f[3] = hi2f(v.y);
  f[4] = lo2f(v.z); f[5] = hi2f(v.z); f[6] = lo2f(v.w); f[7] = hi2f(v.w);
}

__device__ void p3_tile(const Params& P, int layer, int mt, int nt, char* lds) {
  const int tid = threadIdx.x, lane = tid & 63, wave = tid >> 6;
  const int tok0 = mt * 128, n0 = nt * 128;
  const unsigned short* wsrc = P.woutT + ((long)layer * 1024 + n0) * 1024;
  const float* xres = (layer == 0) ? ((tok0 < NPTOK) ? P.xp + (long)tok0 * 1024 : P.xs + (long)(tok0 - NPTOK) * 1024)
                                   : P.out + (long)tok0 * 1024;
  char* As = lds; char* Bs = lds + 20480;
  float* red = (float*)(lds + 36864); float* rh = (float*)(lds + 38912); float* ra = (float*)(lds + 39424);
  if (tid < 128) {
    const f32x4* s = (const f32x4*)(P.ssqA + (long)(tok0 + tid) * 8);
    f32x4 s0 = s[0], s1 = s[1];
    float t = s0.x + s0.y + s0.z + s0.w + s1.x + s1.y + s1.z + s1.w;
    ra[tid] = rsqrtf(t * (1.f / 512.f) + EPSV);
  }
  __syncthreads();
  const int wp = wave >> 1, wq = wave & 1;
  const int r8 = tid >> 3, ch = tid & 7;
  const int kr = tid >> 4, tc = tid & 15;
  f32x16 acc[2][2];
#pragma unroll
  for (int i = 0; i < 2; ++i)
#pragma unroll
    for (int j = 0; j < 2; ++j)
#pragma unroll
      for (int e = 0; e < 16; ++e) acc[i][j][e] = 0.f;
  u32x4 yv[4], gv[4], bv[4];
  const unsigned hy_off = (unsigned)(((512 + kr) * NTOK + tok0 + 8 * tc) * 2);
  const unsigned gt_off = hy_off + (unsigned)(1536u * NTOK * 2u);
  const unsigned at_off = (unsigned)(((tok0 + r8) * 1536 + 8 * ch) * 2);
  const unsigned b_off = (unsigned)((r8 * 1024 + ch * 8) * 2);
#pragma unroll
  for (int i = 0; i < 4; ++i) {
    yv[i] = ldg16(P.zT, hy_off + (unsigned)i * (16u * NTOK * 2u));
    gv[i] = ldg16(P.zT, gt_off + (unsigned)i * (16u * NTOK * 2u));
    bv[i] = ldg16(wsrc, b_off + (unsigned)i * 65536u);
  }
  {
    float ssh[8];
#pragma unroll
    for (int e = 0; e < 8; ++e) ssh[e] = 0.f;
    for (int ks = 0; ks < 8; ++ks) {
#pragma unroll
      for (int i = 0; i < 4; ++i) {
        float y[8], gg[8], a[8];
        unpack8(yv[i], y); unpack8(gv[i], gg);
#pragma unroll
        for (int e = 0; e < 8; ++e) { ssh[e] += y[e] * y[e]; a[e] = y[e] * silu_f(gg[e]); }
        *(u32x4*)(As + (kr + 16 * i) * 320 + tc * 16) = mk4(pack2(a[0], a[1]), pack2(a[2], a[3]), pack2(a[4], a[5]), pack2(a[6], a[7]));
        *(u32x4*)(Bs + swz_off(r8 + 32 * i, ch)) = bv[i];
      }
      __syncthreads();
      if (ks < 7) {
#pragma unroll
        for (int i = 0; i < 4; ++i) {
          yv[i] = ldg16(P.zT, hy_off + (unsigned)(ks + 1) * (64u * NTOK * 2u) + (unsigned)i * (16u * NTOK * 2u));
          gv[i] = ldg16(P.zT, gt_off + (unsigned)(ks + 1) * (64u * NTOK * 2u) + (unsigned)i * (16u * NTOK * 2u));
        }
      } else {
#pragma unroll
        for (int i = 0; i < 4; ++i) {
          yv[i] = ldg16(P.z2, at_off + (unsigned)i * (32u * 1536u * 2u));
          gv[i] = ldg16(P.z2, at_off + (unsigned)i * (32u * 1536u * 2u) + 2048u);
        }
      }
#pragma unroll
      for (int i = 0; i < 4; ++i) bv[i] = ldg16(wsrc, b_off + (unsigned)(ks + 1) * 128u + (unsigned)i * 65536u);
#pragma unroll
      for (int kk = 0; kk < 4; ++kk) {
        bf16x8 a[2], b[2];
#pragma unroll
        for (int i = 0; i < 2; ++i) {
          const int tb = 64 * wp + 32 * i;
          const int l16 = lane & 15;
          const int krow = 16 * kk + 8 * (lane >> 5) + (l16 >> 2);
          const int tcol = tb + 16 * ((lane >> 4) & 1) + 4 * (l16 & 3);
          lds_cptr ap = (lds_cptr)As + krow * 320 + tcol * 2;
          s16x4 lo = __builtin_bit_cast(s16x4, __builtin_amdgcn_ds_read_tr16_b64_v4i16((__attribute__((address_space(3))) v4i16_t*)ap));
          s16x4 hi = __builtin_bit_cast(s16x4, __builtin_amdgcn_ds_read_tr16_b64_v4i16((__attribute__((address_space(3))) v4i16_t*)(ap + 4 * 320)));
          a[i] = (bf16x8){lo[0], lo[1], lo[2], lo[3], hi[0], hi[1], hi[2], hi[3]};
        }
#pragma unroll
        for (int j = 0; j < 2; ++j) b[j] = *(const bf16x8*)(Bs + swz_off(64 * wq + 32 * j + (lane & 31), 2 * kk + (lane >> 5)));
#pragma unroll
        for (int i = 0; i < 2; ++i)
#pragma unroll
          for (int j = 0; j < 2; ++j) acc[i][j] = mfma32(a[i], b[j], acc[i][j]);
      }
      __syncthreads();
    }
#pragma unroll
    for (int e = 0; e < 8; ++e) {
      float s = ssh[e];
      s += __shfl_xor(s, 16); s += __shfl_xor(s, 32);
      if (lane < 16) red[wave * 128 + 8 * tc + e] = s;
    }
  }
  __syncthreads();
  if (tid < 128) rh[tid] = rsqrtf((red[tid] + red[128 + tid] + red[256 + tid] + red[384 + tid]) * (1.f / 512.f) + EPSV);
  __syncthreads();
#pragma unroll
  for (int i = 0; i < 2; ++i)
#pragma unroll
    for (int e = 0; e < 16; ++e) {
      const float sc = rh[64 * wp + 32 * i + (e & 3) + 8 * (e >> 2) + 4 * (lane >> 5)];
      acc[i][0][e] *= sc; acc[i][1][e] *= sc;
    }
  {
    float ra_r[4];
#pragma unroll
    for (int i = 0; i < 4; ++i) ra_r[i] = ra[r8 + 32 * i];
    for (int ks = 8; ks < 16; ++ks) {
#pragma unroll
      for (int i = 0; i < 4; ++i) {
        float y[8], gg[8], a[8];
        unpack8(yv[i], y); unpack8(gv[i], gg);
#pragma unroll
        for (int e = 0; e < 8; ++e) a[e] = y[e] * silu_f(gg[e]) * ra_r[i];
        *(u32x4*)(As + swz_off(r8 + 32 * i, ch)) = mk4(pack2(a[0], a[1]), pack2(a[2], a[3]), pack2(a[4], a[5]), pack2(a[6], a[7]));
        *(u32x4*)(Bs + swz_off(r8 + 32 * i, ch)) = bv[i];
      }
      __syncthreads();
      if (ks < 15) {
#pragma unroll
        for (int i = 0; i < 4; ++i) {
          yv[i] = ldg16(P.z2, at_off + (unsigned)(ks - 7) * 128u + (unsigned)i * (32u * 1536u * 2u));
          gv[i] = ldg16(P.z2, at_off + (unsigned)(ks - 7) * 128u + (unsigned)i * (32u * 1536u * 2u) + 2048u);
          bv[i] = ldg16(wsrc, b_off + (unsigned)(ks + 1) * 128u + (unsigned)i * 65536u);
        }
      }
#pragma unroll
      for (int kk = 0; kk < 4; ++kk) {
        bf16x8 a[2], b[2];
#pragma unroll
        for (int i = 0; i < 2; ++i) a[i] = *(const bf16x8*)(As + swz_off(64 * wp + 32 * i + (lane & 31), 2 * kk + (lane >> 5)));
#pragma unroll
        for (int j = 0; j < 2; ++j) b[j] = *(const bf16x8*)(Bs + swz_off(64 * wq + 32 * j + (lane & 31), 2 * kk + (lane >> 5)));
#pragma unroll
        for (int i = 0; i < 2; ++i)
#pragma unroll
          for (int j = 0; j < 2; ++j) acc[i][j] = mfma32(a[i], b[j], acc[i][j]);
      }
      __syncthreads();
    }
  }
#pragma unroll
  for (int i = 0; i < 2; ++i)
#pragma unroll
    for (int j = 0; j < 2; ++j) {
      const int n = n0 + 64 * wq + 32 * j + (lane & 31);
      const unsigned eoff = (unsigned)(((64 * wp + 32 * i + 4 * (lane >> 5)) * 1024 + n) * 4);
      float* outb = P.out + (long)tok0 * 1024;
#pragma unroll
      for (int g4 = 0; g4 < 4; ++g4) {
        float xr[4];
#pragma unroll
        for (int e = 0; e < 4; ++e) xr[e] = *(const float*)((const char*)xres + (eoff + (unsigned)(g4 * 8 + e) * 4096u));
#pragma unroll
        for (int e = 0; e < 4; ++e) *(float*)((char*)outb + (eoff + (unsigned)(g4 * 8 + e) * 4096u)) = xr[e] + acc[i][j][4 * g4 + e];
      }
    }
  __syncthreads();
}

__device__ void phase_p3(const Params& P, int layer, int bid, int nb, char* lds) {
  for (int v = bid; v < 3072; v += nb) {
    int wv = v >> 9, within = v & 511, x = within & 7, idx = within >> 3;
    int mt = wv * 64 + x * 8 + (idx >> 3);
    int nt = idx & 7;
    p3_tile(P, layer, mt, nt, lds);
  }
}

__device__ __forceinline__ void run_phase(const Params& P, int ph, int bid, int nb, char* lds) {
  switch (ph) {
    case 0: phase_prep(P, bid, nb, lds); break;
    case 1: phase_p1(P, 0, bid, nb, lds); break;
    case 2: phase_p2(P, 0, bid, nb, lds); break;
    case 3: phase_p3(P, 0, bid, nb, lds); break;
    case 4: phase_p1(P, 1, bid, nb, lds); break;
    case 5: phase_p2(P, 1, bid, nb, lds); break;
    case 6: phase_p3(P, 1, bid, nb, lds); break;
  }
}

#if MULTI
__global__ void __launch_bounds__(256, 2) phase_kernel(Params P, int ph) {
  __shared__ __attribute__((aligned(16))) char lds[LDS_BYTES];
  run_phase(P, ph, blockIdx.x, gridDim.x, lds);
}
#else
__global__ void __launch_bounds__(256, 2) mega_kernel(Params P) {
  __shared__ __attribute__((aligned(16))) char lds[LDS_BYTES];
  cg::grid_group grid = cg::this_grid();
  for (int ph = 0; ph < 7; ++ph) {
    run_phase(P, ph, blockIdx.x, gridDim.x, lds);
    if (ph < 6) grid.sync();
  }
}
#endif

extern "C" void kernel_launch(void* const* d_in, const int* in_sizes, int n_in, void* d_out, int out_size,
                              void* d_ws, size_t ws_size, hipStream_t stream) {
  Params P{};
  P.xp = (const float*)d_in[0]; P.xs = (const float*)d_in[1];
  P.norm_g = (const float*)d_in[2]; P.w_in = (const float*)d_in[3]; P.conv_w = (const float*)d_in[4];
  P.conv_b = (const float*)d_in[5]; P.f_w1 = (const float*)d_in[6]; P.f_b1 = (const float*)d_in[7];
  P.f_fr1 = (const float*)d_in[8]; P.f_w2 = (const float*)d_in[9]; P.f_b2 = (const float*)d_in[10];
  P.f_fr2 = (const float*)d_in[11]; P.f_w3 = (const float*)d_in[12]; P.hy_bias = (const float*)d_in[13];
  P.qn_g = (const float*)d_in[14]; P.kn_g = (const float*)d_in[15]; P.rpb = (const float*)d_in[16];
  P.on_hy = (const float*)d_in[17]; P.on_att = (const float*)d_in[18]; P.w_out = (const float*)d_in[19];
  P.out = (float*)d_out;
  char* ws = (char*)d_ws;
  size_t off = 0;
  P.zT = (unsigned short*)(ws + off); off += (size_t)2560 * NTOK * 2;
  P.z2 = (unsigned short*)(ws + off); off += (size_t)NTOK * 1536 * 2;
  P.filt = (unsigned short*)(ws + off); off += (size_t)2 * 512 * 24576 * 2;
  P.winT = (unsigned short*)(ws + off); off += (size_t)2 * 4096 * 1024 * 2;
  P.woutT = (unsigned short*)(ws + off); off += (size_t)2 * 1024 * 1024 * 2;
  P.ssqA = (float*)(ws + off); off += (size_t)NTOK * 8 * 4;
  if (off > ws_size) { fprintf(stderr, "workspace too small: need %zu have %zu\n", off, ws_size); return; }
#if MULTI
  for (int ph = 0; ph < 7; ++ph) phase_kernel<<<512, 256, 0, stream>>>(P, ph);
#else
  static int grid_blocks = 0;
  if (!grid_blocks) {
    int dev = 0, cus = 0, per_cu = 0;
    hipGetDevice(&dev);
    hipDeviceGetAttribute(&cus, hipDeviceAttributeMultiprocessorCount, dev);
    hipOccupancyMaxActiveBlocksPerMultiprocessor(&per_cu, mega_kernel, 256, 0);
    if (per_cu > 2) per_cu = 2;
    grid_blocks = cus * per_cu;
  }
  void* args[] = {&P};
  hipError_t e = hipLaunchCooperativeKernel((void*)mega_kernel, dim3(grid_blocks), dim3(256), args, 0, stream);
  if (e != hipSuccess) fprintf(stderr, "cooperative launch failed: %s (grid %d)\n", hipGetErrorString(e), grid_blocks);
#endif
}
```

```cpp
#include <hip/hip_runtime.h>
#include <hip/hip_cooperative_groups.h>
#include <stdint.h>
#include <stdio.h>
namespace cg = cooperative_groups;

#ifndef MULTI
#define MULTI 0
#endif

typedef __attribute__((ext_vector_type(8))) short bf16x8;
typedef __attribute__((ext_vector_type(4))) short s16x4;
typedef __attribute__((ext_vector_type(16))) float f32x16;
typedef __attribute__((ext_vector_type(4))) float f32x4;
typedef short v4i16_t __attribute__((ext_vector_type(4)));
typedef __attribute__((ext_vector_type(4))) unsigned int u32x4;
typedef __attribute__((ext_vector_type(2))) unsigned int u32x2;
typedef __attribute__((address_space(3))) const char* lds_cptr;

#define NTOK 49152
#define NPTOK 32768
#define EPSV 1e-6f
#define LOG2E 1.4426950408889634f
#define LDS_BYTES 69760

struct Params {
  const float* xp; const float* xs;
  const float* norm_g; const float* w_in; const float* conv_w; const float* conv_b;
  const float* f_w1; const float* f_b1; const float* f_fr1; const float* f_w2; const float* f_b2;
  const float* f_fr2; const float* f_w3; const float* hy_bias; const float* qn_g; const float* kn_g;
  const float* rpb; const float* on_hy; const float* on_att; const float* w_out;
  float* out;
  unsigned short* zT;
  unsigned short* z2;
  unsigned short* filt;
  unsigned short* winT;
  unsigned short* woutT;
  float* ssqA;
};

__device__ __forceinline__ int opaque_tid() { int t = threadIdx.x; asm volatile("" : "+v"(t)); return t; }
__device__ __forceinline__ unsigned short f2bf(float f) {
  unsigned int u = __float_as_uint(f);
  u += 0x7fffu + ((u >> 16) & 1u);
  return (unsigned short)(u >> 16);
}
__device__ __forceinline__ float bf2f(unsigned short h) { return __uint_as_float(((unsigned int)h) << 16); }
__device__ __forceinline__ unsigned int pack2(float a, float b) { return (unsigned)f2bf(a) | ((unsigned)f2bf(b) << 16); }
__device__ __forceinline__ float lo2f(unsigned int u) { return __uint_as_float(u << 16); }
__device__ __forceinline__ float hi2f(unsigned int u) { return __uint_as_float(u & 0xffff0000u); }
__device__ __forceinline__ float silu_f(float g) { return g / (1.f + __expf(-g)); }
__device__ __forceinline__ int swz_off(int row, int ch) { return row * 128 + ((ch ^ ((row >> 1) & 7)) << 4); }

__device__ __forceinline__ f32x16 mfma32(bf16x8 a, bf16x8 b, f32x16 c) { return __builtin_amdgcn_mfma_f32_32x32x16_bf16(a, b, c, 0, 0, 0); }
__device__ __forceinline__ f32x4 mfma16(bf16x8 a, bf16x8 b, f32x4 c) { return __builtin_amdgcn_mfma_f32_16x16x32_bf16(a, b, c, 0, 0, 0); }

__device__ __forceinline__ u32x4 mk4(unsigned a, unsigned b, unsigned c, unsigned d) { u32x4 r = {a, b, c, d}; return r; }
__device__ __forceinline__ u32x2 mk2(unsigned a, unsigned b) { u32x2 r = {a, b}; return r; }
__device__ __forceinline__ bf16x8 u4_to_frag(u32x4 v) {
  union { u32x4 u; bf16x8 f; } x; x.u = v; return x.f;
}

__device__ void filter_unit(const Params& P, int u, char* lds) {
  const int tid = opaque_tid(), lane = tid & 63;
  const int wave = __builtin_amdgcn_readfirstlane(tid >> 6);
  const int l = u / 192; const int rr = u % 192;
  const int set = rr < 128 ? 0 : 1; const int pch = set ? rr - 128 : rr;
  const int L = set ? 4096 : 8192;
  const int p = pch * 64 + lane;
  const float t01 = (float)p / (float)(L - 1);
  const float pl = (float)p / (float)L;
  float* zs = (float*)lds;
  float* h1s = zs + 33 * 64;
  float* h2s = h1s + 64 * 64;
  if (wave == 0) {
    zs[lane] = t01;
#pragma unroll
    for (int k = 0; k < 16; ++k) {
      float fk = 1e-4f + (float)k * ((15.f - 1e-4f) / 15.f);
      float tr = fk * pl; tr -= floorf(tr);
      zs[(1 + k) * 64 + lane] = __builtin_amdgcn_cosf(tr);
      zs[(17 + k) * 64 + lane] = -__builtin_amdgcn_sinf(tr);
    }
  }
  __syncthreads();
  const float* w1 = P.f_w1 + l * 33 * 64; const float* b1 = P.f_b1 + l * 64; const float* fr1 = P.f_fr1 + l * 64;
  const float* w2 = P.f_w2 + l * 64 * 64; const float* b2 = P.f_b2 + l * 64; const float* fr2 = P.f_fr2 + l * 64;
  const float* w3 = P.f_w3 + l * 64 * 1024;
  const int j0 = wave * 16;
  {
    float acc[16];
#pragma unroll
    for (int j = 0; j < 16; ++j) acc[j] = b1[j0 + j];
#pragma unroll 3
    for (int i = 0; i < 33; ++i) {
      const float zv = zs[i * 64 + lane];
#pragma unroll
      for (int j = 0; j < 16; ++j) acc[j] += zv * w1[i * 64 + j0 + j];
    }
#pragma unroll
    for (int j = 0; j < 16; ++j) h1s[(j0 + j) * 64 + lane] = __builtin_amdgcn_sinf(fr1[j0 + j] * acc[j] * 0.15915494309189535f);
  }
  __syncthreads();
  {
    float acc[16];
#pragma unroll
    for (int j = 0; j < 16; ++j) acc[j] = b2[j0 + j];
#pragma unroll 4
    for (int i = 0; i < 64; ++i) {
      const float hv = h1s[i * 64 + lane];
#pragma unroll
      for (int j = 0; j < 16; ++j) acc[j] += hv * w2[i * 64 + j0 + j];
    }
#pragma unroll
    for (int j = 0; j < 16; ++j) h2s[(j0 + j) * 64 + lane] = __builtin_amdgcn_sinf(fr2[j0 + j] * acc[j] * 0.15915494309189535f);
  }
  __syncthreads();
  const float mind = -3.0701134573253943f, maxd = -15.350567286626972f;
  const int setoff = set ? 16384 : 0;
  const int col0 = wave * 256;
  for (int cb = 0; cb < 256; cb += 16) {
    float acc[16];
#pragma unroll
    for (int e = 0; e < 16; ++e) acc[e] = 0.f;
#pragma unroll 4
    for (int j = 0; j < 64; ++j) {
      const float hv = h2s[j * 64 + lane];
#pragma unroll
      for (int e = 0; e < 16; ++e) acc[e] += hv * w3[j * 1024 + col0 + cb + e];
    }
#pragma unroll
    for (int e = 0; e < 16; ++e) {
      int col = col0 + cb + e;
      float delta = fabsf(mind + (float)col * ((maxd - mind) / 1023.f));
      float val = acc[e] * __expf(-t01 * delta);
      int c = col & 511;
      unsigned short* dst = P.filt + ((long)(l * 512 + c)) * 24576 + setoff;
      if (col < 512) dst[L - p] = f2bf(val);
      else { if (p > 0) dst[L + p] = f2bf(val); else dst[0] = 0; }
    }
  }
  __syncthreads();
}

__device__ void phase_prep(const Params& P, int bid, int nb, char* lds) {
  const int tid = opaque_tid();
  const long gt = (long)bid * 256 + tid, gs = (long)nb * 256;
  for (long i = gt; i < 2L * 128 * 4096; i += gs) {
    int n = (int)(i & 4095); int kc = (int)((i >> 12) & 127); int l = (int)(i >> 19);
    const float* w = P.w_in + ((long)l * 1024 + kc * 8) * 4096 + n;
    const float* g = P.norm_g + l * 1024 + kc * 8;
    unsigned int o[4];
#pragma unroll
    for (int j = 0; j < 4; ++j) o[j] = pack2(w[(long)(2 * j) * 4096] * g[2 * j], w[(long)(2 * j + 1) * 4096] * g[2 * j + 1]);
    *(u32x4*)(P.winT + ((long)l * 4096 + n) * 1024 + kc * 8) = mk4(o[0], o[1], o[2], o[3]);
  }
  for (long i = gt; i < 2L * 128 * 1024; i += gs) {
    int n = (int)(i & 1023); int kc = (int)((i >> 10) & 127); int l = (int)(i >> 17);
    const float* w = P.w_out + ((long)l * 1024 + kc * 8) * 1024 + n;
    const float* g = (kc < 64) ? (P.on_hy + l * 512 + kc * 8) : (P.on_att + l * 512 + (kc - 64) * 8);
    unsigned int o[4];
#pragma unroll
    for (int j = 0; j < 4; ++j) o[j] = pack2(w[(long)(2 * j) * 1024] * g[2 * j], w[(long)(2 * j + 1) * 1024] * g[2 * j + 1]);
    *(u32x4*)(P.woutT + ((long)l * 1024 + n) * 1024 + kc * 8) = mk4(o[0], o[1], o[2], o[3]);
  }
  for (int u = bid; u < 384; u += nb) filter_unit(P, u, lds);
}

__device__ void p1_tile(const Params& P, int layer, int mt, int nt, char* lds) {
  const int tid = opaque_tid(), lane = tid & 63, wave = tid >> 6;
  const int tok0 = mt * 128, n0 = nt * 128;
  bool swap; int dst0; int mode = 0;
  if (n0 < 1536) { swap = false; dst0 = n0; }
  else if (n0 < 2048) { swap = false; dst0 = 2048 + (n0 - 1536); }
  else if (n0 < 2560) { swap = true; dst0 = n0 - 2048; mode = 1; }
  else if (n0 < 3072) { swap = true; dst0 = 512 + (n0 - 2560); mode = 2; }
  else if (n0 < 3584) { swap = false; dst0 = 1536 + (n0 - 3072); }
  else { swap = true; dst0 = 1024 + (n0 - 3584); }
  const float* xsrc = (layer == 0) ? ((tok0 < NPTOK) ? P.xp + (long)tok0 * 1024 : P.xs + (long)(tok0 - NPTOK) * 1024)
                                   : P.out + (long)tok0 * 1024;
  const unsigned short* wsrc = P.winT + ((long)layer * 4096 + n0) * 1024;
  char* As = lds; char* Bs = lds + 16384; char* S = lds; float* rs = (float*)(lds + 40960);
  const int wp = wave >> 1, wq = wave & 1;
  const char* Pb = swap ? Bs : As; const char* Qb = swap ? As : Bs;
  f32x16 acc[2][2];
#pragma unroll
  for (int i = 0; i < 2; ++i)
#pragma unroll
    for (int j = 0; j < 2; ++j)
#pragma unroll
      for (int e = 0; e < 16; ++e) acc[i][j][e] = 0.f;
  const int r8 = tid >> 3, ch = tid & 7;
  f32x4 av[4][2]; u32x4 bv[4]; float ssq[4] = {0.f, 0.f, 0.f, 0.f};
#pragma unroll
  for (int i = 0; i < 4; ++i) {
    const float* s = xsrc + (long)(r8 + 32 * i) * 1024 + ch * 8;
    av[i][0] = *(const f32x4*)s; av[i][1] = *(const f32x4*)(s + 4);
    bv[i] = *(const u32x4*)(wsrc + (long)(r8 + 32 * i) * 1024 + ch * 8);
  }
  for (int ks = 0; ks < 16; ++ks) {
#pragma unroll
    for (int i = 0; i < 4; ++i) {
      f32x4 a0 = av[i][0], a1 = av[i][1];
      ssq[i] += a0.x * a0.x + a0.y * a0.y + a0.z * a0.z + a0.w * a0.w + a1.x * a1.x + a1.y * a1.y + a1.z * a1.z + a1.w * a1.w;
      u32x4 pk = mk4(pack2(a0.x, a0.y), pack2(a0.z, a0.w), pack2(a1.x, a1.y), pack2(a1.z, a1.w));
      *(u32x4*)(As + swz_off(r8 + 32 * i, ch)) = pk;
      *(u32x4*)(Bs + swz_off(r8 + 32 * i, ch)) = bv[i];
    }
    __syncthreads();
    if (ks < 15) {
      const int k0 = (ks + 1) * 64;
#pragma unroll
      for (int i = 0; i < 4; ++i) {
        const float* s = xsrc + (long)(r8 + 32 * i) * 1024 + k0 + ch * 8;
        av[i][0] = *(const f32x4*)s; av[i][1] = *(const f32x4*)(s + 4);
        bv[i] = *(const u32x4*)(wsrc + (long)(r8 + 32 * i) * 1024 + k0 + ch * 8);
      }
    }
#pragma unroll
    for (int kk = 0; kk < 4; ++kk) {
      bf16x8 a[2], b[2];
#pragma unroll
      for (int i = 0; i < 2; ++i) a[i] = *(const bf16x8*)(Pb + swz_off(64 * wp + 32 * i + (lane & 31), 2 * kk + (lane >> 5)));
#pragma unroll
      for (int j = 0; j < 2; ++j) b[j] = *(const bf16x8*)(Qb + swz_off(64 * wq + 32 * j + (lane & 31), 2 * kk + (lane >> 5)));
#pragma unroll
      for (int i = 0; i < 2; ++i)
#pragma unroll
        for (int j = 0; j < 2; ++j) acc[i][j] = mfma32(a[i], b[j], acc[i][j]);
    }
    __syncthreads();
  }
#pragma unroll
  for (int i = 0; i < 4; ++i) {
    float s = ssq[i];
    s += __shfl_xor(s, 1); s += __shfl_xor(s, 2); s += __shfl_xor(s, 4);
    if (ch == 0) rs[r8 + 32 * i] = rsqrtf(s * (1.f / 1024.f) + EPSV);
  }
  __syncthreads();
#pragma unroll
  for (int i = 0; i < 2; ++i)
#pragma unroll
    for (int j = 0; j < 2; ++j) {
      const int q = 64 * wq + 32 * j + (lane & 31);
#pragma unroll
      for (int g4 = 0; g4 < 4; ++g4) {
        const int p = 64 * wp + 32 * i + 8 * g4 + 4 * (lane >> 5);
        float v[4];
#pragma unroll
        for (int e = 0; e < 4; ++e) v[e] = acc[i][j][4 * g4 + e] * (swap ? rs[q] : rs[p + e]);
        *(u32x2*)(S + q * 272 + p * 2) = mk2(pack2(v[0], v[1]), pack2(v[2], v[3]));
      }
    }
  __syncthreads();
#pragma unroll
  for (int it = 0; it < 8; ++it) {
    const int id = tid + 256 * it; const int row = id >> 4, c16 = id & 15;
    u32x4 v = *(const u32x4*)(S + row * 272 + c16 * 16);
    if (!swap) {
      *(u32x4*)(P.zT + (long)(dst0 + row) * NTOK + tok0 + c16 * 8) = v;
    } else {
      if (mode) {
        float f[8];
        f[0] = lo2f(v.x); f[1] = hi2f(v.x); f[2] = lo2f(v.y); f[3] = hi2f(v.y);
        f[4] = lo2f(v.z); f[5] = hi2f(v.z); f[6] = lo2f(v.w); f[7] = hi2f(v.w);
        float ss = 0.f;
#pragma unroll
        for (int e = 0; e < 8; ++e) ss += f[e] * f[e];
        ss += __shfl_xor(ss, 1); ss += __shfl_xor(ss, 2); ss += __shfl_xor(ss, 4);
        float sc = rsqrtf(ss * (1.f / 64.f) + EPSV);
        if (mode == 1) sc *= 0.125f * LOG2E;
        const float* g = (mode == 1 ? P.qn_g : P.kn_g) + layer * 64 + (c16 & 7) * 8;
#pragma unroll
        for (int e = 0; e < 8; ++e) f[e] *= sc * g[e];
        v = mk4(pack2(f[0], f[1]), pack2(f[2], f[3]), pack2(f[4], f[5]), pack2(f[6], f[7]));
      }
      *(u32x4*)(P.z2 + (long)(tok0 + row) * 1536 + dst0 + c16 * 8) = v;
    }
  }
  __syncthreads();
}

__device__ void phase_p1(const Params& P, int layer, int bid, int nb, char* lds) {
  for (int v = bid; v < 12288; v += nb) {
    int wv = v >> 9, within = v & 511, x = within & 7, idx = within >> 3;
    int mt = wv * 16 + (x >> 2) * 8 + (idx >> 3);
    int nt = (x & 3) * 8 + (idx & 7);
    p1_tile(P, layer, mt, nt, lds);
  }
}

template <int R>
__device__ void conv_unit(const Params& P, int layer, int set, int c, int bp, char* lds) {
  constexpr int L = 2048 * R, NB = L / 32, UB = (NB + 32) * 64;
  char* U = lds; char* F = lds + 2 * UB;
  const int tid = opaque_tid(), lane = tid & 63, wave = tid >> 6;
  const long tokbase = (long)(set ? NPTOK : 0) + (long)(2 * bp) * L;
  const unsigned short* x0r = P.zT + (long)c * NTOK + tokbase;
  const unsigned short* x1r = P.zT + (long)(512 + c) * NTOK + tokbase;
  const unsigned short* vr = P.zT + (long)(1024 + c) * NTOK + tokbase;
  const float* cw = P.conv_w + layer * 3 * 1536; const float* cb = P.conv_b + layer * 1536;
  {
    const float w1a = cw[512 + c], w1b = cw[1536 + 512 + c], w1c = cw[3072 + 512 + c], b1 = cb[512 + c];
    const float wva = cw[1024 + c], wvb = cw[1536 + 1024 + c], wvc = cw[3072 + 1024 + c], bvv = cb[1024 + c];
    {
      int bb = tid >> 7; int rem = tid & 127; int side = rem >> 6; int o = rem & 63;
      *(u32x4*)(U + bb * UB + (side ? (NB + 16) * 64 : 0) + o * 16) = mk4(0, 0, 0, 0);
    }
    for (int id = tid; id < 2 * L / 8; id += 256) {
      const int bb = id / (L / 8); const int t8 = (id % (L / 8)) * 8;
      const unsigned short* a = x1r + (long)bb * L + t8; const unsigned short* b = vr + (long)bb * L + t8;
      u32x4 xa = *(const u32x4*)a; u32x4 xb = *(const u32x4*)b;
      float xs[10], vs[10];
      xs[0] = t8 > 0 ? bf2f(a[-1]) : 0.f; xs[9] = (t8 + 8 < L) ? bf2f(a[8]) : 0.f;
      vs[0] = t8 > 0 ? bf2f(b[-1]) : 0.f; vs[9] = (t8 + 8 < L) ? bf2f(b[8]) : 0.f;
      xs[1] = lo2f(xa.x); xs[2] = hi2f(xa.x); xs[3] = lo2f(xa.y); xs[4] = hi2f(xa.y);
      xs[5] = lo2f(xa.z); xs[6] = hi2f(xa.z); xs[7] = lo2f(xa.w); xs[8] = hi2f(xa.w);
      vs[1] = lo2f(xb.x); vs[2] = hi2f(xb.x); vs[3] = lo2f(xb.y); vs[4] = hi2f(xb.y);
      vs[5] = lo2f(xb.z); vs[6] = hi2f(xb.z); vs[7] = lo2f(xb.w); vs[8] = hi2f(xb.w);
      float uu[8];
#pragma unroll
      for (int e = 0; e < 8; ++e) {
        float x1c = w1a * xs[e] + w1b * xs[e + 1] + w1c * xs[e + 2] + b1;
        float vc = wva * vs[e] + wvb * vs[e + 1] + wvc * vs[e + 2] + bvv;
        uu[e] = x1c * vc;
      }
      const int blk = (t8 >> 5) + 16; const int chunk = (t8 >> 3) & 3;
      *(u32x4*)(U + bb * UB + blk * 64 + ((chunk ^ ((blk >> 2) & 3)) << 4)) =
          mk4(pack2(uu[0], uu[1]), pack2(uu[2], uu[3]), pack2(uu[4], uu[5]), pack2(uu[6], uu[7]));
    }
    const unsigned short* fsrc = P.filt + ((long)(layer * 512 + c)) * 24576 + (set ? 16384 : 0);
    for (int id = tid; id < 2 * L / 8; id += 256) *(u32x4*)(F + id * 16) = *(const u32x4*)(fsrc + id * 8);
    if (tid == 0) *(u32x4*)(F + 2 * L * 2) = mk4(0, 0, 0, 0);
  }
  __syncthreads();

  const int T0w = wave * (NB / 4);
  const int ii = lane & 31, h = lane >> 5;
  const int bb = (lane >> 4) & 1, mm = lane & 15;
  f32x16 acc[R];
#pragma unroll
  for (int r = 0; r < R; ++r)
#pragma unroll
    for (int e = 0; e < 16; ++e) acc[r][e] = 0.f;
  bf16x8 Ar[R][2];

#define LOAD_A(dst, dd) do { \
    _Pragma("unroll") for (int kk_ = 0; kk_ < 2; ++kk_) { \
      const int ms_ = L - 32 * (dd) - ii + 16 * kk_ + 8 * h; \
      const unsigned sh_ = (unsigned)(ms_ & 1) * 16u; \
      const unsigned* fp_ = (const unsigned*)F + (ms_ >> 1); \
      unsigned d0_ = fp_[0], d1_ = fp_[1], d2_ = fp_[2], d3_ = fp_[3], d4_ = fp_[4]; \
      union { unsigned u[4]; bf16x8 f; } x_; \
      x_.u[0] = __builtin_amdgcn_alignbit(d1_, d0_, sh_); x_.u[1] = __builtin_amdgcn_alignbit(d2_, d1_, sh_); \
      x_.u[2] = __builtin_amdgcn_alignbit(d3_, d2_, sh_); x_.u[3] = __builtin_amdgcn_alignbit(d4_, d3_, sh_); \
      (dst)[kk_] = x_.f; } } while (0)

  constexpr int NSTEP = NB / 16 + 1;
  constexpr int NQ = (NSTEP + R - 1) / R;
  for (int e = 0; e < 16; ++e) {
    const int sb0 = -15 + e;
    const int D0 = T0w - sb0;
#pragma unroll
    for (int s = 1; s < R; ++s) LOAD_A(Ar[s], D0 + 16 * s);
    for (int Q = 0; Q < NQ; ++Q) {
#pragma unroll
      for (int u = 0; u < R; ++u) {
        const int q = Q * R + u; const int sb = sb0 + 16 * q;
        if (sb < NB) {
          LOAD_A(Ar[(R - u) % R], D0 - 16 * q);
          const int blk = sb + mm + 16;
          bf16x8 Bf[2];
#pragma unroll
          for (int kk = 0; kk < 2; ++kk)
            Bf[kk] = *(const bf16x8*)(U + bb * UB + blk * 64 + (((2 * kk + h) ^ ((blk >> 2) & 3)) << 4));
#pragma unroll
          for (int r = 0; r < R; ++r) {
            acc[r] = mfma32(Ar[(r - u + R) % R][0], Bf[0], acc[r]);
            acc[r] = mfma32(Ar[(r - u + R) % R][1], Bf[1], acc[r]);
          }
        }
      }
    }
  }
#undef LOAD_A
  {
    const float hb = P.hy_bias[layer * 512 + c];
    const float w0a = cw[c], w0b = cw[1536 + c], w0c = cw[3072 + c], b0 = cb[c];
    unsigned short* yout = P.zT + (long)(512 + c) * NTOK + tokbase;
#pragma unroll
    for (int r = 0; r < R; ++r) {
      const int t0 = T0w + 16 * r + mm; const int blk = t0 + 16;
#pragma unroll
      for (int g4 = 0; g4 < 4; ++g4) {
        const int t = t0 * 32 + 8 * g4 + 4 * h;
        u32x2 uv = *(const u32x2*)(U + bb * UB + blk * 64 + ((g4 ^ ((blk >> 2) & 3)) << 4) + 8 * h);
        const unsigned short* xp = x0r + (long)bb * L + t;
        u32x2 xv = *(const u32x2*)xp;
        float xs[6];
        xs[0] = t > 0 ? bf2f(xp[-1]) : 0.f; xs[5] = (t + 4 < L) ? bf2f(xp[4]) : 0.f;
        xs[1] = lo2f(xv.x); xs[2] = hi2f(xv.x); xs[3] = lo2f(xv.y); xs[4] = hi2f(xv.y);
        float us[4] = {lo2f(uv.x), hi2f(uv.x), lo2f(uv.y), hi2f(uv.y)};
        float o[4];
#pragma unroll
        for (int e = 0; e < 4; ++e) {
          float x0c = w0a * xs[e] + w0b * xs[e + 1] + w0c * xs[e + 2] + b0;
          float y = acc[r][4 * g4 + e] + hb * us[e];
          o[e] = x0c * y;
        }
        *(u32x2*)(yout + (long)bb * L + t) = mk2(pack2(o[0], o[1]), pack2(o[2], o[3]));
      }
    }
  }
  __syncthreads();
}

__device__ void attn_unit(const Params& P, int layer, int a, char* lds) {
  float* rp = (float*)lds;
  const int tid = opaque_tid(), lane = tid & 63, wave = tid >> 6;
  const int hd = a & 7, rowg = a >> 3;
  int rows, r;
  if (rowg < 512) { rows = 128; r = rowg & 127; } else { rows = 64; r = (rowg - 512) & 63; }
  const int rowbase = rowg - r;
  const int r0 = min(max(r - 4, 0), rows - 8);
  for (int i = tid; i < 465; i += 256) rp[i] = P.rpb[(layer * 8 + hd) * 465 + i] * LOG2E;
  __syncthreads();
  const int c0 = wave * 16; const int kc0 = min(max(c0 - 8, 0), 32);
  const int qi = lane & 15, g = lane >> 4;
  const long qtok = (long)rowg * 64 + c0 + qi;
  const unsigned short* qptr = P.z2 + qtok * 1536 + hd * 64 + 8 * g;
  const bf16x8 Qf0 = *(const bf16x8*)qptr, Qf1 = *(const bf16x8*)(qptr + 32);
  f32x4 S[16];
  const long bandtok = (long)(rowbase + r0) * 64;
#pragma unroll
  for (int T = 0; T < 16; ++T) {
    const int kr = T >> 1, half = T & 1;
    const long ktok = bandtok + kr * 64 + kc0 + 16 * half + qi;
    const unsigned short* kp = P.z2 + ktok * 1536 + 512 + hd * 64 + 8 * g;
    const bf16x8 K0 = *(const bf16x8*)kp, K1 = *(const bf16x8*)(kp + 32);
    f32x4 s = {0.f, 0.f, 0.f, 0.f};
    s = mfma16(K0, Qf0, s); s = mfma16(K1, Qf1, s);
    S[T] = s;
  }
  const int qc = c0 + qi; const int cs = min(max(qc - 8, 0), 48);
  float mx = -1e30f;
#pragma unroll
  for (int T = 0; T < 16; ++T) {
    const int kr = T >> 1, half = T & 1;
    const int ro = r0 + kr - r + 7;
#pragma unroll
    for (int e = 0; e < 4; ++e) {
      const int kc = kc0 + 16 * half + 4 * g + e;
      const bool valid = (kc >= cs) && (kc < cs + 16);
      const int idx = valid ? (ro * 31 + kc - qc + 15) : 0;
      float v = valid ? (S[T][e] + rp[idx]) : -1e30f;
      S[T][e] = v; mx = fmaxf(mx, v);
    }
  }
  mx = fmaxf(mx, __shfl_xor(mx, 16)); mx = fmaxf(mx, __shfl_xor(mx, 32));
  float sum = 0.f;
#pragma unroll
  for (int T = 0; T < 16; ++T)
#pragma unroll
    for (int e = 0; e < 4; ++e) { float p = exp2f(S[T][e] - mx); S[T][e] = p; sum += p; }
  sum += __shfl_xor(sum, 16); sum += __shfl_xor(sum, 32);
  f32x4 O[4];
#pragma unroll
  for (int dt = 0; dt < 4; ++dt) O[dt] = (f32x4){0.f, 0.f, 0.f, 0.f};
#pragma unroll
  for (int kr = 0; kr < 8; ++kr) {
    union { unsigned u[4]; bf16x8 f; } pf;
    pf.u[0] = pack2(S[2 * kr][0], S[2 * kr][1]); pf.u[1] = pack2(S[2 * kr][2], S[2 * kr][3]);
    pf.u[2] = pack2(S[2 * kr + 1][0], S[2 * kr + 1][1]); pf.u[3] = pack2(S[2 * kr + 1][2], S[2 * kr + 1][3]);
    const long vt = bandtok + kr * 64 + kc0 + 4 * g;
#pragma unroll
    for (int dt = 0; dt < 4; ++dt) {
      const unsigned short* vp = P.zT + (long)(1536 + hd * 64 + 16 * dt + qi) * NTOK + vt;
      u32x2 v0 = *(const u32x2*)vp; u32x2 v1 = *(const u32x2*)(vp + 16);
      union { unsigned u[4]; bf16x8 f; } vf;
      vf.u[0] = v0.x; vf.u[1] = v0.y; vf.u[2] = v1.x; vf.u[3] = v1.y;
      O[dt] = mfma16(vf.f, pf.f, O[dt]);
    }
  }
  const float inv = 1.f / sum; float ss = 0.f;
#pragma unroll
  for (int dt = 0; dt < 4; ++dt) {
    float o[4];
#pragma unroll
    for (int e = 0; e < 4; ++e) { o[e] = O[dt][e] * inv; ss += o[e] * o[e]; }
    *(u32x2*)(P.z2 + qtok * 1536 + hd * 64 + 16 * dt + 4 * g) = mk2(pack2(o[0], o[1]), pack2(o[2], o[3]));
  }
  ss += __shfl_xor(ss, 16); ss += __shfl_xor(ss, 32);
  if (g == 0) P.ssqA[qtok * 8 + hd] = ss;
  __syncthreads();
}

__device__ void phase_p2(const Params& P, int layer, int bid, int nb, char* lds) {
  for (int u = bid; u < 2048; u += nb) {
    if (u < 1024) conv_unit<4>(P, layer, 0, u & 511, u >> 9, lds);
    else conv_unit<2>(P, layer, 1, (u - 1024) & 511, (u - 1024) >> 9, lds);
  }
  for (int a = bid; a < 6144; a += nb) attn_unit(P, layer, a, lds);
}

__device__ __forceinline__ u32x4 ldg16(const void* base, unsigned off) { return *(const u32x4*)((const char*)base + off); }

__device__ __forceinline__ void unpack8(u32x4 v, float* f) {
  f[0] = lo2f(v.x); f[1] = hi2f(v.x); f[2] = lo2f(v.y); f[3] = hi2f(v.y);
  f[4] = lo2f(v.z); f[5] = hi2f(v.z); f[6] = lo2f(v.w); f[7] = hi2f(v.w);
}

__device__ void p3_tile(const Params& P, int layer, int mt, int nt, char* lds) {
  const int tid = opaque_tid(), lane = tid & 63, wave = tid >> 6;
  const int tok0 = mt * 128, n0 = nt * 128;
  const unsigned short* wsrc = P.woutT + ((long)layer * 1024 + n0) * 1024;
  const float* xres = (layer == 0) ? ((tok0 < NPTOK) ? P.xp + (long)tok0 * 1024 : P.xs + (long)(tok0 - NPTOK) * 1024)
                                   : P.out + (long)tok0 * 1024;
  char* As = lds; char* Bs = lds + 20480;
  float* red = (float*)(lds + 36864); float* rh = (float*)(lds + 38912); float* ra = (float*)(lds + 39424);
  if (tid < 128) {
    const f32x4* s = (const f32x4*)(P.ssqA + (long)(tok0 + tid) * 8);
    f32x4 s0 = s[0], s1 = s[1];
    float t = s0.x + s0.y + s0.z + s0.w + s1.x + s1.y + s1.z + s1.w;
    ra[tid] = rsqrtf(t * (1.f / 512.f) + EPSV);
  }
  __syncthreads();
  const int wp = wave >> 1, wq = wave & 1;
  const int r8 = tid >> 3, ch = tid & 7;
  const int kr = tid >> 4, tc = tid & 15;
  f32x16 acc[2][2];
#pragma unroll
  for (int i = 0; i < 2; ++i)
#pragma unroll
    for (int j = 0; j < 2; ++j)
#pragma unroll
      for (int e = 0; e < 16; ++e) acc[i][j][e] = 0.f;
  u32x4 yv[4], gv[4], bv[4];
  const unsigned hy_off = (unsigned)(((512 + kr) * NTOK + tok0 + 8 * tc) * 2);
  const unsigned gt_off = hy_off + (unsigned)(1536u * NTOK * 2u);
  const unsigned at_off = (unsigned)(((tok0 + r8) * 1536 + 8 * ch) * 2);
  const unsigned b_off = (unsigned)((r8 * 1024 + ch * 8) * 2);
#pragma unroll
  for (int i = 0; i < 4; ++i) {
    yv[i] = ldg16(P.zT, hy_off + (unsigned)i * (16u * NTOK * 2u));
    gv[i] = ldg16(P.zT, gt_off + (unsigned)i * (16u * NTOK * 2u));
    bv[i] = ldg16(wsrc, b_off + (unsigned)i * 65536u);
  }
  {
    float ssh[8];
#pragma unroll
    for (int e = 0; e < 8; ++e) ssh[e] = 0.f;
    for (int ks = 0; ks < 8; ++ks) {
#pragma unroll
      for (int i = 0; i < 4; ++i) {
        float y[8], gg[8], a[8];
        unpack8(yv[i], y); unpack8(gv[i], gg);
#pragma unroll
        for (int e = 0; e < 8; ++e) { ssh[e] += y[e] * y[e]; a[e] = y[e] * silu_f(gg[e]); }
        *(u32x4*)(As + (kr + 16 * i) * 320 + tc * 16) = mk4(pack2(a[0], a[1]), pack2(a[2], a[3]), pack2(a[4], a[5]), pack2(a[6], a[7]));
        *(u32x4*)(Bs + swz_off(r8 + 32 * i, ch)) = bv[i];
      }
      __syncthreads();
      if (ks < 7) {
#pragma unroll
        for (int i = 0; i < 4; ++i) {
          yv[i] = ldg16(P.zT, hy_off + (unsigned)(ks + 1) * (64u * NTOK * 2u) + (unsigned)i * (16u * NTOK * 2u));
          gv[i] = ldg16(P.zT, gt_off + (unsigned)(ks + 1) * (64u * NTOK * 2u) + (unsigned)i * (16u * NTOK * 2u));
        }
      } else {
#pragma unroll
        for (int i = 0; i < 4; ++i) {
          yv[i] = ldg16(P.z2, at_off + (unsigned)i * (32u * 1536u * 2u));
          gv[i] = ldg16(P.z2, at_off + (unsigned)i * (32u * 1536u * 2u) + 2048u);
        }
      }
#pragma unroll
      for (int i = 0; i < 4; ++i) bv[i] = ldg16(wsrc, b_off + (unsigned)(ks + 1) * 128u + (unsigned)i * 65536u);
#pragma unroll
      for (int kk = 0; kk < 4; ++kk) {
        bf16x8 a[2], b[2];
#pragma unroll
        for (int i = 0; i < 2; ++i) {
          const int tb = 64 * wp + 32 * i;
          const int l16 = lane & 15;
          const int krow = 16 * kk + 8 * (lane >> 5) + (l16 >> 2);
          const int tcol = tb + 16 * ((lane >> 4) & 1) + 4 * (l16 & 3);
          lds_cptr ap = (lds_cptr)As + krow * 320 + tcol * 2;
          s16x4 lo = __builtin_bit_cast(s16x4, __builtin_amdgcn_ds_read_tr16_b64_v4i16((__attribute__((address_space(3))) v4i16_t*)ap));
          s16x4 hi = __builtin_bit_cast(s16x4, __builtin_amdgcn_ds_read_tr16_b64_v4i16((__attribute__((address_space(3))) v4i16_t*)(ap + 4 * 320)));
          a[i] = (bf16x8){lo[0], lo[1], lo[2], lo[3], hi[0], hi[1], hi[2], hi[3]};
        }
#pragma unroll
        for (int j = 0; j < 2; ++j) b[j] = *(const bf16x8*)(Bs + swz_off(64 * wq + 32 * j + (lane & 31), 2 * kk + (lane >> 5)));
#pragma unroll
        for (int i = 0; i < 2; ++i)
#pragma unroll
          for (int j = 0; j < 2; ++j) acc[i][j] = mfma32(a[i], b[j], acc[i][j]);
      }
      __syncthreads();
    }
#pragma unroll
    for (int e = 0; e < 8; ++e) {
      float s = ssh[e];
      s += __shfl_xor(s, 16); s += __shfl_xor(s, 32);
      if (lane < 16) red[wave * 128 + 8 * tc + e] = s;
    }
  }
  __syncthreads();
  if (tid < 128) rh[tid] = rsqrtf((red[tid] + red[128 + tid] + red[256 + tid] + red[384 + tid]) * (1.f / 512.f) + EPSV);
  __syncthreads();
#pragma unroll
  for (int i = 0; i < 2; ++i)
#pragma unroll
    for (int e = 0; e < 16; ++e) {
      const float sc = rh[64 * wp + 32 * i + (e & 3) + 8 * (e >> 2) + 4 * (lane >> 5)];
      acc[i][0][e] *= sc; acc[i][1][e] *= sc;
    }
  {
    float ra_r[4];
#pragma unroll
    for (int i = 0; i < 4; ++i) ra_r[i] = ra[r8 + 32 * i];
    for (int ks = 8; ks < 16; ++ks) {
#pragma unroll
      for (int i = 0; i < 4; ++i) {
        float y[8], gg[8], a[8];
        unpack8(yv[i], y); unpack8(gv[i], gg);
#pragma unroll
        for (int e = 0; e < 8; ++e) a[e] = y[e] * silu_f(gg[e]) * ra_r[i];
        *(u32x4*)(As + swz_off(r8 + 32 * i, ch)) = mk4(pack2(a[0], a[1]), pack2(a[2], a[3]), pack2(a[4], a[5]), pack2(a[6], a[7]));
        *(u32x4*)(Bs + swz_off(r8 + 32 * i, ch)) = bv[i];
      }
      __syncthreads();
      if (ks < 15) {
#pragma unroll
        for (int i = 0; i < 4; ++i) {
          yv[i] = ldg16(P.z2, at_off + (unsigned)(ks - 7) * 128u + (unsigned)i * (32u * 1536u * 2u));
          gv[i] = ldg16(P.z2, at_off + (unsigned)(ks - 7) * 128u + (unsigned)i * (32u * 1536u * 2u) + 2048u);
          bv[i] = ldg16(wsrc, b_off + (unsigned)(ks + 1) * 128u + (unsigned)i * 65536u);
        }
      }
#pragma unroll
      for (int kk = 0; kk < 4; ++kk) {
        bf16x8 a[2], b[2];
#pragma unroll
        for (int i = 0; i < 2; ++i) a[i] = *(const bf16x8*)(As + swz_off(64 * wp + 32 * i + (lane & 31), 2 * kk + (lane >> 5)));
#pragma unroll
        for (int j = 0; j < 2; ++j) b[j] = *(const bf16x8*)(Bs + swz_off(64 * wq + 32 * j + (lane & 31), 2 * kk + (lane >> 5)));
#pragma unroll
        for (int i = 0; i < 2; ++i)
#pragma unroll
          for (int j = 0; j < 2; ++j) acc[i][j] = mfma32(a[i], b[j], acc[i][j]);
      }
      __syncthreads();
    }
  }
#pragma unroll
  for (int i = 0; i < 2; ++i)
#pragma unroll
    for (int j = 0; j < 2; ++j) {
      const int n = n0 + 64 * wq + 32 * j + (lane & 31);
      const unsigned eoff = (unsigned)(((64 * wp + 32 * i + 4 * (lane >> 5)) * 1024 + n) * 4);
      float* outb = P.out + (long)tok0 * 1024;
#pragma unroll
      for (int g4 = 0; g4 < 4; ++g4) {
        float xr[4];
#pragma unroll
        for (int e = 0; e < 4; ++e) xr[e] = *(const float*)((const char*)xres + (eoff + (unsigned)(g4 * 8 + e) * 4096u));
#pragma unroll
        for (int e = 0; e < 4; ++e) *(float*)((char*)outb + (eoff + (unsigned)(g4 * 8 + e) * 4096u)) = xr[e] + acc[i][j][4 * g4 + e];
      }
    }
  __syncthreads();
}

__device__ void phase_p3(const Params& P, int layer, int bid, int nb, char* lds) {
  for (int v = bid; v < 3072; v += nb) {
    int wv = v >> 9, within = v & 511, x = within & 7, idx = within >> 3;
    int mt = wv * 64 + x * 8 + (idx >> 3);
    int nt = idx & 7;
    p3_tile(P, layer, mt, nt, lds);
  }
}

__device__ __forceinline__ void run_phase(const Params& P, int ph, int bid, int nb, char* lds) {
  switch (ph) {
    case 0: phase_prep(P, bid, nb, lds); break;
    case 1: phase_p1(P, 0, bid, nb, lds); break;
    case 2: phase_p2(P, 0, bid, nb, lds); break;
    case 3: phase_p3(P, 0, bid, nb, lds); break;
    case 4: phase_p1(P, 1, bid, nb, lds); break;
    case 5: phase_p2(P, 1, bid, nb, lds); break;
    case 6: phase_p3(P, 1, bid, nb, lds); break;
  }
}

#if MULTI
__global__ void __launch_bounds__(256, 2) phase_kernel(Params P, int ph) {
  __shared__ __attribute__((aligned(16))) char lds[LDS_BYTES];
  run_phase(P, ph, blockIdx.x, gridDim.x, lds);
}
#else
__global__ void __launch_bounds__(256, 2) mega_kernel(Params P) {
  __shared__ __attribute__((aligned(16))) char lds[LDS_BYTES];
  cg::grid_group grid = cg::this_grid();
  const int bid = blockIdx.x, nb = gridDim.x;
#pragma unroll 1
  for (int ph = 0; ph < 7; ++ph) {
    const int layer = ph >= 4 ? 1 : 0;
    const int sub = ph == 0 ? 0 : ((ph - 1) % 3 + 1);
    switch (sub) {
      case 0: phase_prep(P, bid, nb, lds); break;
      case 1: phase_p1(P, layer, bid, nb, lds); break;
      case 2: phase_p2(P, layer, bid, nb, lds); break;
      case 3: phase_p3(P, layer, bid, nb, lds); break;
    }
    if (ph < 6) grid.sync();
  }
}
#endif

extern "C" void kernel_launch(void* const* d_in, const int* in_sizes, int n_in, void* d_out, int out_size,
                              void* d_ws, size_t ws_size, hipStream_t stream) {
  Params P{};
  P.xp = (const float*)d_in[0]; P.xs = (const float*)d_in[1];
  P.norm_g = (const float*)d_in[2]; P.w_in = (const float*)d_in[3]; P.conv_w = (const float*)d_in[4];
  P.conv_b = (const float*)d_in[5]; P.f_w1 = (const float*)d_in[6]; P.f_b1 = (const float*)d_in[7];
  P.f_fr1 = (const float*)d_in[8]; P.f_w2 = (const float*)d_in[9]; P.f_b2 = (const float*)d_in[10];
  P.f_fr2 = (const float*)d_in[11]; P.f_w3 = (const float*)d_in[12]; P.hy_bias = (const float*)d_in[13];
  P.qn_g = (const float*)d_in[14]; P.kn_g = (const float*)d_in[15]; P.rpb = (const float*)d_in[16];
  P.on_hy = (const float*)d_in[17]; P.on_att = (const float*)d_in[18]; P.w_out = (const float*)d_in[19];
  P.out = (float*)d_out;
  char* ws = (char*)d_ws;
  size_t off = 0;
  P.zT = (unsigned short*)(ws + off); off += (size_t)2560 * NTOK * 2;
  P.z2 = (unsigned short*)(ws + off); off += (size_t)NTOK * 1536 * 2;
  P.filt = (unsigned short*)(ws + off); off += (size_t)2 * 512 * 24576 * 2;
  P.winT = (unsigned short*)(ws + off); off += (size_t)2 * 4096 * 1024 * 2;
  P.woutT = (unsigned short*)(ws + off); off += (size_t)2 * 1024 * 1024 * 2;
  P.ssqA = (float*)(ws + off); off += (size_t)NTOK * 8 * 4;
  if (off > ws_size) { fprintf(stderr, "workspace too small: need %zu have %zu\n", off, ws_size); return; }
#if MULTI
  for (int ph = 0; ph < 7; ++ph) phase_kernel<<<512, 256, 0, stream>>>(P, ph);
#else
  static int grid_blocks = 0;
  if (!grid_blocks) {
    int dev = 0, cus = 0, per_cu = 0;
    hipGetDevice(&dev);
    hipDeviceGetAttribute(&cus, hipDeviceAttributeMultiprocessorCount, dev);
    hipOccupancyMaxActiveBlocksPerMultiprocessor(&per_cu, mega_kernel, 256, 0);
    if (per_cu > 2) per_cu = 2;
    grid_blocks = cus * per_cu;
  }
  void* args[] = {&P};
  hipError_t e = hipLaunchCooperativeKernel((void*)mega_kernel, dim3(grid_blocks), dim3(256), args, 0, stream);
  if (e != hipSuccess) fprintf(stderr, "cooperative launch failed: %s (grid %d)\n", hipGetErrorString(e), grid_blocks);
#endif
}
```

```cpp
#include <hip/hip_runtime.h>
#include <hip/hip_cooperative_groups.h>
#include <stdint.h>
#include <stdio.h>
namespace cg = cooperative_groups;

#ifndef MULTI
#define MULTI 0
#endif

typedef __attribute__((ext_vector_type(8))) short bf16x8;
typedef __attribute__((ext_vector_type(4))) short s16x4;
typedef __attribute__((ext_vector_type(16))) float f32x16;
typedef __attribute__((ext_vector_type(4))) float f32x4;
typedef short v4i16_t __attribute__((ext_vector_type(4)));
typedef __attribute__((ext_vector_type(4))) unsigned int u32x4;
typedef __attribute__((ext_vector_type(2))) unsigned int u32x2;
typedef __attribute__((address_space(3))) const char* lds_cptr;

#define NTOK 49152
#define NPTOK 32768
#define EPSV 1e-6f
#define LOG2E 1.4426950408889634f
#define LDS_BYTES 69760
#ifndef PROG
#define PROG 0x6543210ull
#define NSTEPS 7
#endif

struct Params {
  const float* xp; const float* xs;
  const float* norm_g; const float* w_in; const float* conv_w; const float* conv_b;
  const float* f_w1; const float* f_b1; const float* f_fr1; const float* f_w2; const float* f_b2;
  const float* f_fr2; const float* f_w3; const float* hy_bias; const float* qn_g; const float* kn_g;
  const float* rpb; const float* on_hy; const float* on_att; const float* w_out;
  float* out;
  unsigned short* zT;
  unsigned short* z2;
  unsigned short* filt;
  unsigned short* winT;
  unsigned short* woutT;
  float* ssqA;
};

__device__ __forceinline__ int opaque_tid() { int t = threadIdx.x; asm volatile("" : "+v"(t)); return t; }
__device__ __forceinline__ unsigned short f2bf(float f) {
  unsigned int u = __float_as_uint(f);
  u += 0x7fffu + ((u >> 16) & 1u);
  return (unsigned short)(u >> 16);
}
__device__ __forceinline__ float bf2f(unsigned short h) { return __uint_as_float(((unsigned int)h) << 16); }
typedef __attribute__((ext_vector_type(2))) float f32x2_t;
typedef __attribute__((ext_vector_type(2))) __bf16 bf16x2_t;
__device__ __forceinline__ unsigned int pack2(float a, float b) { f32x2_t v = {a, b}; return __builtin_bit_cast(unsigned int, __builtin_convertvector(v, bf16x2_t)); }
__device__ __forceinline__ unsigned int pack2t(float a, float b) { return pack2(a, b); }
__device__ __forceinline__ float lo2f(unsigned int u) { return __uint_as_float(u << 16); }
__device__ __forceinline__ float hi2f(unsigned int u) { return __uint_as_float(u & 0xffff0000u); }
__device__ __forceinline__ float silu_f(float g) { return g / (1.f + __expf(-g)); }
__device__ __forceinline__ int swz_off(int row, int ch) { return row * 128 + ((ch ^ ((row >> 1) & 7)) << 4); }

__device__ __forceinline__ f32x16 mfma32(bf16x8 a, bf16x8 b, f32x16 c) { return __builtin_amdgcn_mfma_f32_32x32x16_bf16(a, b, c, 0, 0, 0); }
__device__ __forceinline__ f32x4 mfma16(bf16x8 a, bf16x8 b, f32x4 c) { return __builtin_amdgcn_mfma_f32_16x16x32_bf16(a, b, c, 0, 0, 0); }

__device__ __forceinline__ u32x4 mk4(unsigned a, unsigned b, unsigned c, unsigned d) { u32x4 r = {a, b, c, d}; return r; }
__device__ __forceinline__ u32x2 mk2(unsigned a, unsigned b) { u32x2 r = {a, b}; return r; }
__device__ __forceinline__ bf16x8 u4_to_frag(u32x4 v) {
  union { u32x4 u; bf16x8 f; } x; x.u = v; return x.f;
}

__device__ void filter_unit(const Params& P, int u, char* lds) {
  const int tid = opaque_tid(), lane = tid & 63;
  const int wave = __builtin_amdgcn_readfirstlane(tid >> 6);
  const int l = u / 192; const int rr = u % 192;
  const int set = rr < 128 ? 0 : 1; const int pch = set ? rr - 128 : rr;
  const int L = set ? 4096 : 8192;
  const int p = pch * 64 + lane;
  const float t01 = (float)p / (float)(L - 1);
  const float pl = (float)p / (float)L;
  float* zs = (float*)lds;
  float* h1s = zs + 33 * 64;
  char* Hq = lds + 24832;
  char* Ws = lds + 33024;
  if (wave == 0) {
    zs[lane] = t01;
#pragma unroll
    for (int k = 0; k < 16; ++k) {
      float fk = 1e-4f + (float)k * ((15.f - 1e-4f) / 15.f);
      float tr = fk * pl; tr -= floorf(tr);
      zs[(1 + k) * 64 + lane] = __builtin_amdgcn_cosf(tr);
      zs[(17 + k) * 64 + lane] = -__builtin_amdgcn_sinf(tr);
    }
  }
  __syncthreads();
  const float* w1 = P.f_w1 + l * 33 * 64; const float* b1 = P.f_b1 + l * 64; const float* fr1 = P.f_fr1 + l * 64;
  const float* w2 = P.f_w2 + l * 64 * 64; const float* b2 = P.f_b2 + l * 64; const float* fr2 = P.f_fr2 + l * 64;
  const float* w3 = P.f_w3 + l * 64 * 1024;
  const int j0 = wave * 16;
  {
    float acc[16];
#pragma unroll
    for (int j = 0; j < 16; ++j) acc[j] = b1[j0 + j];
#pragma unroll 3
    for (int i = 0; i < 33; ++i) {
      const float zv = zs[i * 64 + lane];
#pragma unroll
      for (int j = 0; j < 16; ++j) acc[j] += zv * w1[i * 64 + j0 + j];
    }
#pragma unroll
    for (int j = 0; j < 16; ++j) h1s[(j0 + j) * 64 + lane] = __builtin_amdgcn_sinf(fr1[j0 + j] * acc[j] * 0.15915494309189535f);
  }
  __syncthreads();
  {
    float acc[16];
#pragma unroll
    for (int j = 0; j < 16; ++j) acc[j] = b2[j0 + j];
#pragma unroll 4
    for (int i = 0; i < 64; ++i) {
      const float hv = h1s[i * 64 + lane];
#pragma unroll
      for (int j = 0; j < 16; ++j) acc[j] += hv * w2[i * 64 + j0 + j];
    }
    float hh[16];
#pragma unroll
    for (int j = 0; j < 16; ++j) hh[j] = __builtin_amdgcn_sinf(fr2[j0 + j] * acc[j] * 0.15915494309189535f);
    *(u32x4*)(Hq + swz_off(lane, 2 * wave)) = mk4(pack2t(hh[0], hh[1]), pack2t(hh[2], hh[3]), pack2t(hh[4], hh[5]), pack2t(hh[6], hh[7]));
    *(u32x4*)(Hq + swz_off(lane, 2 * wave + 1)) = mk4(pack2t(hh[8], hh[9]), pack2t(hh[10], hh[11]), pack2t(hh[12], hh[13]), pack2t(hh[14], hh[15]));
  }
  const float mind = -3.0701134573253943f, maxd = -15.350567286626972f;
  const int setoff = set ? 16384 : 0;
  const int qpos0 = pch * 64 + (lane & 31);
  for (int nc = 0; nc < 8; ++nc) {
    const int n0 = nc * 128;
    __syncthreads();
#pragma unroll
    for (int i = 0; i < 4; ++i) {
      const int id = tid + 256 * i; const int krow = id >> 4, c8 = id & 15;
      const float* src = w3 + krow * 1024 + n0 + 8 * c8;
      f32x4 a0 = *(const f32x4*)src, a1 = *(const f32x4*)(src + 4);
      *(u32x4*)(Ws + krow * 320 + c8 * 16) = mk4(pack2(a0.x, a0.y), pack2(a0.z, a0.w), pack2(a1.x, a1.y), pack2(a1.z, a1.w));
    }
    __syncthreads();
    f32x16 acc[2];
#pragma unroll
    for (int j = 0; j < 2; ++j) {
#pragma unroll
      for (int e = 0; e < 16; ++e) acc[j][e] = 0.f;
    }
#pragma unroll
    for (int kk = 0; kk < 4; ++kk) {
      const int l16 = lane & 15;
      const int krow = 16 * kk + 8 * (lane >> 5) + (l16 >> 2);
      const int ncol = 32 * wave + 16 * ((lane >> 4) & 1) + 4 * (l16 & 3);
      lds_cptr ap = (lds_cptr)Ws + krow * 320 + ncol * 2;
      s16x4 lo = __builtin_bit_cast(s16x4, __builtin_amdgcn_ds_read_tr16_b64_v4i16((__attribute__((address_space(3))) v4i16_t*)ap));
      s16x4 hi = __builtin_bit_cast(s16x4, __builtin_amdgcn_ds_read_tr16_b64_v4i16((__attribute__((address_space(3))) v4i16_t*)(ap + 4 * 320)));
      bf16x8 a = (bf16x8){lo[0], lo[1], lo[2], lo[3], hi[0], hi[1], hi[2], hi[3]};
#pragma unroll
      for (int j = 0; j < 2; ++j) {
        bf16x8 b = *(const bf16x8*)(Hq + swz_off(32 * j + (lane & 31), 2 * kk + (lane >> 5)));
        acc[j] = mfma32(a, b, acc[j]);
      }
    }
#pragma unroll
    for (int j = 0; j < 2; ++j) {
      const int pos = qpos0 + 32 * j;
      const float tq = (float)pos / (float)(L - 1);
#pragma unroll
      for (int e = 0; e < 16; ++e) {
        const int col = n0 + 32 * wave + (e & 3) + 8 * (e >> 2) + 4 * (lane >> 5);
        const float delta = fabsf(mind + (float)col * ((maxd - mind) / 1023.f));
        const float val = acc[j][e] * __expf(-tq * delta);
        const int c = col & 511;
        unsigned short* dst = P.filt + ((long)(l * 512 + c)) * 24576 + setoff;
        if (col < 512) dst[L - pos] = f2bf(val);
        else { if (pos > 0) dst[L + pos] = f2bf(val); else dst[0] = 0; }
      }
    }
  }
  __syncthreads();
}

__device__ void phase_prep(const Params& P, int bid, int nb, char* lds) {
  const int tid = opaque_tid();
  const long gt = (long)bid * 256 + tid, gs = (long)nb * 256;
  for (long i = gt; i < 2L * 128 * 4096; i += gs) {
    int n = (int)(i & 4095); int kc = (int)((i >> 12) & 127); int l = (int)(i >> 19);
    const float* w = P.w_in + ((long)l * 1024 + kc * 8) * 4096 + n;
    const float* g = P.norm_g + l * 1024 + kc * 8;
    unsigned int o[4];
#pragma unroll
    for (int j = 0; j < 4; ++j) o[j] = pack2(w[(long)(2 * j) * 4096] * g[2 * j], w[(long)(2 * j + 1) * 4096] * g[2 * j + 1]);
    *(u32x4*)(P.winT + ((long)l * 4096 + n) * 1024 + kc * 8) = mk4(o[0], o[1], o[2], o[3]);
  }
  for (long i = gt; i < 2L * 128 * 1024; i += gs) {
    int n = (int)(i & 1023); int kc = (int)((i >> 10) & 127); int l = (int)(i >> 17);
    const float* w = P.w_out + ((long)l * 1024 + kc * 8) * 1024 + n;
    const float* g = (kc < 64) ? (P.on_hy + l * 512 + kc * 8) : (P.on_att + l * 512 + (kc - 64) * 8);
    unsigned int o[4];
#pragma unroll
    for (int j = 0; j < 4; ++j) o[j] = pack2(w[(long)(2 * j) * 1024] * g[2 * j], w[(long)(2 * j + 1) * 1024] * g[2 * j + 1]);
    *(u32x4*)(P.woutT + ((long)l * 1024 + n) * 1024 + kc * 8) = mk4(o[0], o[1], o[2], o[3]);
  }
  for (int u = bid; u < 384; u += nb) filter_unit(P, u, lds);
}

__device__ __forceinline__ u32x4 ldg16(const void* base, unsigned off) { return *(const u32x4*)((const char*)base + off); }

__device__ __forceinline__ void unpack8(u32x4 v, float* f) {
  f[0] = lo2f(v.x); f[1] = hi2f(v.x); f[2] = lo2f(v.y); f[3] = hi2f(v.y);
  f[4] = lo2f(v.z); f[5] = hi2f(v.z); f[6] = lo2f(v.w); f[7] = hi2f(v.w);
}

__device__ void p1_tile(const Params& P, int layer, int mt, int nt, char* lds, int variant) {
  const int tid = opaque_tid(), lane = tid & 63, wave = tid >> 6;
  const int tok0 = mt * 128, n0 = nt * 128;
  bool swap; int dst0; int mode = 0;
  const bool gate = (n0 >= 1536 && n0 < 2048) || (n0 >= 3584);
  if (n0 < 1536) { swap = false; dst0 = n0; }
  else if (n0 < 2048) { swap = false; dst0 = 2048 + (n0 - 1536); }
  else if (n0 < 2560) { swap = true; dst0 = n0 - 2048; mode = 1; }
  else if (n0 < 3072) { swap = true; dst0 = 512 + (n0 - 2560); mode = 2; }
  else if (n0 < 3584) { swap = false; dst0 = 1536 + (n0 - 3072); }
  else { swap = true; dst0 = 1024 + (n0 - 3584); }
  const float* xsrc = (layer == 0) ? ((tok0 < NPTOK) ? P.xp + (long)tok0 * 1024 : P.xs + (long)(tok0 - NPTOK) * 1024)
                                   : P.out + (long)tok0 * 1024;
  const unsigned short* wsrc = P.winT + ((long)layer * 4096 + n0) * 1024;
  char* S = lds; float* rs = (float*)(lds + 65536);
  const int wp = wave >> 1, wq = wave & 1;
  f32x16 acc[2][2];
#pragma unroll
  for (int i = 0; i < 2; ++i)
#pragma unroll
    for (int j = 0; j < 2; ++j)
#pragma unroll
      for (int e = 0; e < 16; ++e) acc[i][j][e] = 0.f;
  const int r8 = tid >> 3, ch = tid & 7;
  const int r16 = tid >> 4, c4 = tid & 15;
  f32x4 av[8]; u32x4 bv[4]; float ssq[8];
#pragma unroll
  for (int i = 0; i < 8; ++i) ssq[i] = 0.f;
  const unsigned a_off = (unsigned)((r16 * 1024 + c4 * 4) * 4);
  const unsigned b_off = (unsigned)((r8 * 1024 + ch * 8) * 2);
#define P1_LOAD(ks_) do { \
    _Pragma("unroll") for (int i = 0; i < 8; ++i) av[i] = *(const f32x4*)((const char*)xsrc + (a_off + (unsigned)i * 65536u + (unsigned)(ks_) * 256u)); \
    _Pragma("unroll") for (int i = 0; i < 4; ++i) bv[i] = ldg16(wsrc, b_off + (unsigned)i * 65536u + (unsigned)(ks_) * 128u); } while (0)
#define P1_STORE(buf_) do { \
    char* As_ = lds + (buf_) * 32768; char* Bs_ = As_ + 16384; \
    _Pragma("unroll") for (int i = 0; i < 8; ++i) { \
      f32x4 a0 = av[i]; \
      ssq[i] += a0.x * a0.x + a0.y * a0.y + a0.z * a0.z + a0.w * a0.w; \
      const int row_ = r16 + 16 * i; \
      *(u32x2*)(As_ + row_ * 128 + (((c4 >> 1) ^ ((row_ >> 1) & 7)) << 4) + (c4 & 1) * 8) = mk2(pack2(a0.x, a0.y), pack2(a0.z, a0.w)); } \
    _Pragma("unroll") for (int i = 0; i < 4; ++i) *(u32x4*)(Bs_ + swz_off(r8 + 32 * i, ch)) = bv[i]; } while (0)
  P1_LOAD(0);
  P1_STORE(0);
  P1_LOAD(1);
  __syncthreads();
  for (int ks = 0; ks < 16; ++ks) {
    const int cur = ks & 1;
    if (ks + 1 < 16) P1_STORE(cur ^ 1);
    if (ks + 2 < 16 && !(variant & 1)) P1_LOAD(ks + 2);
    __builtin_amdgcn_sched_barrier(0);
    const char* As = lds + cur * 32768; const char* Bs = As + 16384;
    const char* Pb = swap ? Bs : As; const char* Qb = swap ? As : Bs;
#pragma unroll
    for (int kk = 0; kk < 4; ++kk) {
      bf16x8 a[2], b[2];
#pragma unroll
      for (int i = 0; i < 2; ++i) a[i] = *(const bf16x8*)(Pb + swz_off(64 * wp + 32 * i + (lane & 31), 2 * kk + (lane >> 5)));
#pragma unroll
      for (int j = 0; j < 2; ++j) b[j] = *(const bf16x8*)(Qb + swz_off(64 * wq + 32 * j + (lane & 31), 2 * kk + (lane >> 5)));
#pragma unroll
      for (int i = 0; i < 2; ++i)
#pragma unroll
        for (int j = 0; j < 2; ++j) acc[i][j] = mfma32(a[i], b[j], acc[i][j]);
    }
    __syncthreads();
  }
#undef P1_LOAD
#undef P1_STORE
#pragma unroll
  for (int i = 0; i < 8; ++i) {
    float s_ = ssq[i];
    s_ += __shfl_xor(s_, 1); s_ += __shfl_xor(s_, 2); s_ += __shfl_xor(s_, 4); s_ += __shfl_xor(s_, 8);
    if (c4 == 0) rs[r16 + 16 * i] = rsqrtf(s_ * (1.f / 1024.f) + EPSV);
  }
  __syncthreads();
#pragma unroll
  for (int i = 0; i < 2; ++i)
#pragma unroll
    for (int j = 0; j < 2; ++j) {
      const int q = 64 * wq + 32 * j + (lane & 31);
#pragma unroll
      for (int g4 = 0; g4 < 4; ++g4) {
        const int p = 64 * wp + 32 * i + 8 * g4 + 4 * (lane >> 5);
        float v[4];
#pragma unroll
        for (int e = 0; e < 4; ++e) v[e] = acc[i][j][4 * g4 + e] * (swap ? rs[q] : rs[p + e]);
        if (gate) {
#pragma unroll
          for (int e = 0; e < 4; ++e) v[e] = v[e] * __builtin_amdgcn_rcpf(1.f + __expf(-v[e]));
        }
        *(u32x2*)(S + q * 272 + p * 2) = mk2(pack2(v[0], v[1]), pack2(v[2], v[3]));
      }
    }
  __syncthreads();
#pragma unroll
  for (int it = 0; it < 8; ++it) {
    const int id = tid + 256 * it; const int row = id >> 4, c16 = id & 15;
    u32x4 v = *(const u32x4*)(S + row * 272 + c16 * 16);
    if (variant & 2) continue;
    if (!swap) {
      *(u32x4*)(P.zT + (long)(dst0 + row) * NTOK + tok0 + c16 * 8) = v;
    } else {
      if (mode) {
        float f[8];
        f[0] = lo2f(v.x); f[1] = hi2f(v.x); f[2] = lo2f(v.y); f[3] = hi2f(v.y);
        f[4] = lo2f(v.z); f[5] = hi2f(v.z); f[6] = lo2f(v.w); f[7] = hi2f(v.w);
        float ss = 0.f;
#pragma unroll
        for (int e = 0; e < 8; ++e) ss += f[e] * f[e];
        ss += __shfl_xor(ss, 1); ss += __shfl_xor(ss, 2); ss += __shfl_xor(ss, 4);
        float sc = rsqrtf(ss * (1.f / 64.f) + EPSV);
        if (mode == 1) sc *= 0.125f * LOG2E;
        const float* g = (mode == 1 ? P.qn_g : P.kn_g) + layer * 64 + (c16 & 7) * 8;
#pragma unroll
        for (int e = 0; e < 8; ++e) f[e] *= sc * g[e];
        v = mk4(pack2(f[0], f[1]), pack2(f[2], f[3]), pack2(f[4], f[5]), pack2(f[6], f[7]));
      }
      *(u32x4*)(P.z2 + (long)(tok0 + row) * 1536 + dst0 + c16 * 8) = v;
    }
  }
  __syncthreads();
}

__device__ void phase_p1(const Params& P, int layer, int bid, int nb, char* lds, int variant) {
  for (int v = bid; v < 12288; v += nb) {
    int wv = v >> 9, within = v & 511, x = within & 7, idx = within >> 3;
    int mt = wv * 16 + (x >> 2) * 8 + (idx >> 3);
    int nt = (x & 3) * 8 + (idx & 7);
    p1_tile(P, layer, mt, nt, lds, variant);
  }
}

template <int R>
__device__ void conv_unit(const Params& P, int layer, int set, int c, int bp, char* lds) {
  constexpr int L = 2048 * R, NB = L / 32, UB = (NB + 32) * 64;
  char* U = lds; char* F = lds + 2 * UB;
  const int tid = opaque_tid(), lane = tid & 63, wave = tid >> 6;
  const long tokbase = (long)(set ? NPTOK : 0) + (long)(2 * bp) * L;
  const unsigned short* x0r = P.zT + (long)c * NTOK + tokbase;
  const unsigned short* x1r = P.zT + (long)(512 + c) * NTOK + tokbase;
  const unsigned short* vr = P.zT + (long)(1024 + c) * NTOK + tokbase;
  const float* cw = P.conv_w + layer * 3 * 1536; const float* cb = P.conv_b + layer * 1536;
  {
    const float w1a = cw[512 + c], w1b = cw[1536 + 512 + c], w1c = cw[3072 + 512 + c], b1 = cb[512 + c];
    const float wva = cw[1024 + c], wvb = cw[1536 + 1024 + c], wvc = cw[3072 + 1024 + c], bvv = cb[1024 + c];
    {
      int bb = tid >> 7; int rem = tid & 127; int side = rem >> 6; int o = rem & 63;
      *(u32x4*)(U + bb * UB + (side ? (NB + 16) * 64 : 0) + o * 16) = mk4(0, 0, 0, 0);
    }
    for (int id = tid; id < 2 * L / 8; id += 256) {
      const int bb = id / (L / 8); const int t8 = (id % (L / 8)) * 8;
      const unsigned short* a = x1r + (long)bb * L + t8; const unsigned short* b = vr + (long)bb * L + t8;
      u32x4 xa = *(const u32x4*)a; u32x4 xb = *(const u32x4*)b;
      float xs[10], vs[10];
      xs[0] = t8 > 0 ? bf2f(a[-1]) : 0.f; xs[9] = (t8 + 8 < L) ? bf2f(a[8]) : 0.f;
      vs[0] = t8 > 0 ? bf2f(b[-1]) : 0.f; vs[9] = (t8 + 8 < L) ? bf2f(b[8]) : 0.f;
      xs[1] = lo2f(xa.x); xs[2] = hi2f(xa.x); xs[3] = lo2f(xa.y); xs[4] = hi2f(xa.y);
      xs[5] = lo2f(xa.z); xs[6] = hi2f(xa.z); xs[7] = lo2f(xa.w); xs[8] = hi2f(xa.w);
      vs[1] = lo2f(xb.x); vs[2] = hi2f(xb.x); vs[3] = lo2f(xb.y); vs[4] = hi2f(xb.y);
      vs[5] = lo2f(xb.z); vs[6] = hi2f(xb.z); vs[7] = lo2f(xb.w); vs[8] = hi2f(xb.w);
      float uu[8];
#pragma unroll
      for (int e = 0; e < 8; ++e) {
        float x1c = w1a * xs[e] + w1b * xs[e + 1] + w1c * xs[e + 2] + b1;
        float vc = wva * vs[e] + wvb * vs[e + 1] + wvc * vs[e + 2] + bvv;
        uu[e] = x1c * vc;
      }
      const int blk = (t8 >> 5) + 16; const int chunk = (t8 >> 3) & 3;
      *(u32x4*)(U + bb * UB + blk * 64 + ((chunk ^ ((blk >> 2) & 3)) << 4)) =
          mk4(pack2(uu[0], uu[1]), pack2(uu[2], uu[3]), pack2(uu[4], uu[5]), pack2(uu[6], uu[7]));
    }
    const unsigned short* fsrc = P.filt + ((long)(layer * 512 + c)) * 24576 + (set ? 16384 : 0);
    for (int id = tid; id < 2 * L / 8; id += 256) *(u32x4*)(F + id * 16) = *(const u32x4*)(fsrc + id * 8);
    if (tid == 0) *(u32x4*)(F + 2 * L * 2) = mk4(0, 0, 0, 0);
  }
  __syncthreads();

  const int T0w = wave * (NB / 4);
  const int ii = lane & 31, h = lane >> 5;
  const int bb = (lane >> 4) & 1, mm = lane & 15;
  f32x16 acc[R];
#pragma unroll
  for (int r = 0; r < R; ++r)
#pragma unroll
    for (int e = 0; e < 16; ++e) acc[r][e] = 0.f;
  bf16x8 Ar[R][2];

#define LOAD_A(dst, dd) do { \
    _Pragma("unroll") for (int kk_ = 0; kk_ < 2; ++kk_) { \
      const int ms_ = L - 32 * (dd) - ii + 16 * kk_ + 8 * h; \
      const unsigned sh_ = (unsigned)(ms_ & 1) * 16u; \
      const unsigned* fp_ = (const unsigned*)F + (ms_ >> 1); \
      unsigned d0_ = fp_[0], d1_ = fp_[1], d2_ = fp_[2], d3_ = fp_[3], d4_ = fp_[4]; \
      union { unsigned u[4]; bf16x8 f; } x_; \
      x_.u[0] = __builtin_amdgcn_alignbit(d1_, d0_, sh_); x_.u[1] = __builtin_amdgcn_alignbit(d2_, d1_, sh_); \
      x_.u[2] = __builtin_amdgcn_alignbit(d3_, d2_, sh_); x_.u[3] = __builtin_amdgcn_alignbit(d4_, d3_, sh_); \
      (dst)[kk_] = x_.f; } } while (0)

  constexpr int NSTEP = NB / 16 + 1;
  constexpr int NQ = (NSTEP + R - 1) / R;
  for (int e = 0; e < 16; ++e) {
    const int sb0 = -15 + e;
    const int D0 = T0w - sb0;
#pragma unroll
    for (int s = 1; s < R; ++s) LOAD_A(Ar[s], D0 + 16 * s);
    for (int Q = 0; Q < NQ; ++Q) {
#pragma unroll
      for (int u = 0; u < R; ++u) {
        const int q = Q * R + u; const int sb = sb0 + 16 * q;
        if (sb < NB) {
          LOAD_A(Ar[(R - u) % R], D0 - 16 * q);
          const int blk = sb + mm + 16;
          bf16x8 Bf[2];
#pragma unroll
          for (int kk = 0; kk < 2; ++kk)
            Bf[kk] = *(const bf16x8*)(U + bb * UB + blk * 64 + (((2 * kk + h) ^ ((blk >> 2) & 3)) << 4));
#pragma unroll
          for (int r = 0; r < R; ++r) {
            acc[r] = mfma32(Ar[(r - u + R) % R][0], Bf[0], acc[r]);
            acc[r] = mfma32(Ar[(r - u + R) % R][1], Bf[1], acc[r]);
          }
        }
      }
    }
  }
#undef LOAD_A
  {
    const float hb = P.hy_bias[layer * 512 + c];
    const float w0a = cw[c], w0b = cw[1536 + c], w0c = cw[3072 + c], b0 = cb[c];
    unsigned short* yout = P.zT + (long)(512 + c) * NTOK + tokbase;
    unsigned short* ygout = P.zT + (long)(1024 + c) * NTOK + tokbase;
    const unsigned short* sgr = P.zT + (long)(2048 + c) * NTOK + tokbase;
#pragma unroll
    for (int r = 0; r < R; ++r) {
      const int t0 = T0w + 16 * r + mm; const int blk = t0 + 16;
#pragma unroll
      for (int g4 = 0; g4 < 4; ++g4) {
        const int t = t0 * 32 + 8 * g4 + 4 * h;
        u32x2 uv = *(const u32x2*)(U + bb * UB + blk * 64 + ((g4 ^ ((blk >> 2) & 3)) << 4) + 8 * h);
        const unsigned short* xp = x0r + (long)bb * L + t;
        u32x2 xv = *(const u32x2*)xp;
        float xs[6];
        xs[0] = t > 0 ? bf2f(xp[-1]) : 0.f; xs[5] = (t + 4 < L) ? bf2f(xp[4]) : 0.f;
        xs[1] = lo2f(xv.x); xs[2] = hi2f(xv.x); xs[3] = lo2f(xv.y); xs[4] = hi2f(xv.y);
        float us[4] = {lo2f(uv.x), hi2f(uv.x), lo2f(uv.y), hi2f(uv.y)};
        float o[4];
#pragma unroll
        for (int e = 0; e < 4; ++e) {
          float x0c = w0a * xs[e] + w0b * xs[e + 1] + w0c * xs[e + 2] + b0;
          float y = acc[r][4 * g4 + e] + hb * us[e];
          o[e] = x0c * y;
        }
        *(u32x2*)(yout + (long)bb * L + t) = mk2(pack2(o[0], o[1]), pack2(o[2], o[3]));
        const u32x2 sgv = *(const u32x2*)(sgr + (long)bb * L + t);
        *(u32x2*)(ygout + (long)bb * L + t) = mk2(pack2(o[0] * lo2f(sgv.x), o[1] * hi2f(sgv.x)), pack2(o[2] * lo2f(sgv.y), o[3] * hi2f(sgv.y)));
      }
    }
  }
  __syncthreads();
}

__device__ void attn_unit(const Params& P, int layer, int a, char* lds) {
  float* rp = (float*)lds;
  const int tid = opaque_tid(), lane = tid & 63, wave = tid >> 6;
  const int hd = a & 7, rowg = a >> 3;
  int rows, r;
  if (rowg < 512) { rows = 128; r = rowg & 127; } else { rows = 64; r = (rowg - 512) & 63; }
  const int rowbase = rowg - r;
  const int r0 = min(max(r - 4, 0), rows - 8);
  for (int i = tid; i < 465; i += 256) rp[i] = P.rpb[(layer * 8 + hd) * 465 + i] * LOG2E;
  __syncthreads();
  const int c0 = wave * 16; const int kc0 = min(max(c0 - 8, 0), 32);
  const int qi = lane & 15, g = lane >> 4;
  const long qtok = (long)rowg * 64 + c0 + qi;
  const unsigned short* qptr = P.z2 + qtok * 1536 + hd * 64 + 8 * g;
  const bf16x8 Qf0 = *(const bf16x8*)qptr, Qf1 = *(const bf16x8*)(qptr + 32);
  f32x4 S[16];
  const long bandtok = (long)(rowbase + r0) * 64;
#pragma unroll
  for (int T = 0; T < 16; ++T) {
    const int kr = T >> 1, half = T & 1;
    const long ktok = bandtok + kr * 64 + kc0 + 16 * half + qi;
    const unsigned short* kp = P.z2 + ktok * 1536 + 512 + hd * 64 + 8 * g;
    const bf16x8 K0 = *(const bf16x8*)kp, K1 = *(const bf16x8*)(kp + 32);
    f32x4 s = {0.f, 0.f, 0.f, 0.f};
    s = mfma16(K0, Qf0, s); s = mfma16(K1, Qf1, s);
    S[T] = s;
  }
  const int qc = c0 + qi; const int cs = min(max(qc - 8, 0), 48);
  float mx = -1e30f;
#pragma unroll
  for (int T = 0; T < 16; ++T) {
    const int kr = T >> 1, half = T & 1;
    const int ro = r0 + kr - r + 7;
#pragma unroll
    for (int e = 0; e < 4; ++e) {
      const int kc = kc0 + 16 * half + 4 * g + e;
      const bool valid = (kc >= cs) && (kc < cs + 16);
      const int idx = valid ? (ro * 31 + kc - qc + 15) : 0;
      float v = valid ? (S[T][e] + rp[idx]) : -1e30f;
      S[T][e] = v; mx = fmaxf(mx, v);
    }
  }
  mx = fmaxf(mx, __shfl_xor(mx, 16)); mx = fmaxf(mx, __shfl_xor(mx, 32));
  float sum = 0.f;
#pragma unroll
  for (int T = 0; T < 16; ++T)
#pragma unroll
    for (int e = 0; e < 4; ++e) { float p = exp2f(S[T][e] - mx); S[T][e] = p; sum += p; }
  sum += __shfl_xor(sum, 16); sum += __shfl_xor(sum, 32);
  f32x4 O[4];
#pragma unroll
  for (int dt = 0; dt < 4; ++dt) O[dt] = (f32x4){0.f, 0.f, 0.f, 0.f};
#pragma unroll
  for (int kr = 0; kr < 8; ++kr) {
    union { unsigned u[4]; bf16x8 f; } pf;
    pf.u[0] = pack2(S[2 * kr][0], S[2 * kr][1]); pf.u[1] = pack2(S[2 * kr][2], S[2 * kr][3]);
    pf.u[2] = pack2(S[2 * kr + 1][0], S[2 * kr + 1][1]); pf.u[3] = pack2(S[2 * kr + 1][2], S[2 * kr + 1][3]);
    const long vt = bandtok + kr * 64 + kc0 + 4 * g;
#pragma unroll
    for (int dt = 0; dt < 4; ++dt) {
      const unsigned short* vp = P.zT + (long)(1536 + hd * 64 + 16 * dt + qi) * NTOK + vt;
      u32x2 v0 = *(const u32x2*)vp; u32x2 v1 = *(const u32x2*)(vp + 16);
      union { unsigned u[4]; bf16x8 f; } vf;
      vf.u[0] = v0.x; vf.u[1] = v0.y; vf.u[2] = v1.x; vf.u[3] = v1.y;
      O[dt] = mfma16(vf.f, pf.f, O[dt]);
    }
  }
  const float inv = 1.f / sum; float ss = 0.f;
#pragma unroll
  for (int dt = 0; dt < 4; ++dt) {
    float o[4];
#pragma unroll
    for (int e = 0; e < 4; ++e) { o[e] = O[dt][e] * inv; ss += o[e] * o[e]; }
    const u32x2 sgv = *(const u32x2*)(P.z2 + qtok * 1536 + 1024 + hd * 64 + 16 * dt + 4 * g);
    *(u32x2*)(P.z2 + qtok * 1536 + hd * 64 + 16 * dt + 4 * g) = mk2(pack2(o[0] * lo2f(sgv.x), o[1] * hi2f(sgv.x)), pack2(o[2] * lo2f(sgv.y), o[3] * hi2f(sgv.y)));
  }
  ss += __shfl_xor(ss, 16); ss += __shfl_xor(ss, 32);
  if (g == 0) P.ssqA[qtok * 8 + hd] = ss;
  __syncthreads();
}

__device__ void phase_p2(const Params& P, int layer, int bid, int nb, char* lds, int what) {
  if (what & 1) for (int u = bid; u < 2048; u += nb) {
    if (u < 1024) conv_unit<4>(P, layer, 0, u & 511, u >> 9, lds);
    else conv_unit<2>(P, layer, 1, (u - 1024) & 511, (u - 1024) >> 9, lds);
  }
  if (what & 2) for (int a = bid; a < 6144; a += nb) attn_unit(P, layer, a, lds);
}

__device__ void p3_tile(const Params& P, int layer, int mt, int nt, char* lds) {
  const int tid = opaque_tid(), lane = tid & 63, wave = tid >> 6;
  const int tok0 = mt * 128, n0 = nt * 128;
  const unsigned short* wsrc = P.woutT + ((long)layer * 1024 + n0) * 1024;
  const float* xres = (layer == 0) ? ((tok0 < NPTOK) ? P.xp + (long)tok0 * 1024 : P.xs + (long)(tok0 - NPTOK) * 1024)
                                   : P.out + (long)tok0 * 1024;
  char* As = lds; char* Bs = lds + 20480;
  float* red = (float*)(lds + 36864); float* rh = (float*)(lds + 38912); float* ra = (float*)(lds + 39424);
  if (tid < 128) {
    const f32x4* sp = (const f32x4*)(P.ssqA + (long)(tok0 + tid) * 8);
    f32x4 s0 = sp[0], s1 = sp[1];
    float t = s0.x + s0.y + s0.z + s0.w + s1.x + s1.y + s1.z + s1.w;
    ra[tid] = rsqrtf(t * (1.f / 512.f) + EPSV);
  }
  const int wp = wave >> 1, wq = wave & 1;
  const int r8 = tid >> 3, ch = tid & 7;
  const int kr = tid >> 4, tc = tid & 15;
  f32x16 acc[2][2];
#pragma unroll
  for (int i = 0; i < 2; ++i)
#pragma unroll
    for (int j = 0; j < 2; ++j)
#pragma unroll
      for (int e = 0; e < 16; ++e) acc[i][j][e] = 0.f;
  u32x4 yv[4], gv[4], bv[4];
  const unsigned hy_off = (unsigned)(((512 + kr) * NTOK + tok0 + 8 * tc) * 2);
  const unsigned yg_off = hy_off + (unsigned)(512u * NTOK * 2u);
  const unsigned at_off = (unsigned)(((tok0 + r8) * 1536 + 8 * ch) * 2);
  const unsigned b_off = (unsigned)((r8 * 1024 + ch * 8) * 2);
#pragma unroll
  for (int i = 0; i < 4; ++i) {
    yv[i] = ldg16(P.zT, hy_off + (unsigned)i * (16u * NTOK * 2u));
    gv[i] = ldg16(P.zT, yg_off + (unsigned)i * (16u * NTOK * 2u));
    bv[i] = ldg16(wsrc, b_off + (unsigned)i * 65536u);
  }
  {
    float ssh[8];
#pragma unroll
    for (int e = 0; e < 8; ++e) ssh[e] = 0.f;
    for (int ks = 0; ks < 8; ++ks) {
#pragma unroll
      for (int i = 0; i < 4; ++i) {
        float y[8];
        unpack8(yv[i], y);
#pragma unroll
        for (int e = 0; e < 8; ++e) ssh[e] += y[e] * y[e];
        *(u32x4*)(As + (kr + 16 * i) * 320 + tc * 16) = gv[i];
        *(u32x4*)(Bs + swz_off(r8 + 32 * i, ch)) = bv[i];
      }
      __syncthreads();
      if (ks < 7) {
#pragma unroll
        for (int i = 0; i < 4; ++i) {
          yv[i] = ldg16(P.zT, hy_off + (unsigned)(ks + 1) * (64u * NTOK * 2u) + (unsigned)i * (16u * NTOK * 2u));
          gv[i] = ldg16(P.zT, yg_off + (unsigned)(ks + 1) * (64u * NTOK * 2u) + (unsigned)i * (16u * NTOK * 2u));
        }
      } else {
#pragma unroll
        for (int i = 0; i < 4; ++i) gv[i] = ldg16(P.z2, at_off + (unsigned)i * (32u * 1536u * 2u));
      }
#pragma unroll
      for (int i = 0; i < 4; ++i) bv[i] = ldg16(wsrc, b_off + (unsigned)(ks + 1) * 128u + (unsigned)i * 65536u);
#pragma unroll
      for (int kk = 0; kk < 4; ++kk) {
        bf16x8 a[2], b[2];
#pragma unroll
        for (int i = 0; i < 2; ++i) {
          const int tb = 64 * wp + 32 * i;
          const int l16 = lane & 15;
          const int krow = 16 * kk + 8 * (lane >> 5) + (l16 >> 2);
          const int tcol = tb + 16 * ((lane >> 4) & 1) + 4 * (l16 & 3);
          lds_cptr ap = (lds_cptr)As + krow * 320 + tcol * 2;
          s16x4 lo = __builtin_bit_cast(s16x4, __builtin_amdgcn_ds_read_tr16_b64_v4i16((__attribute__((address_space(3))) v4i16_t*)ap));
          s16x4 hi = __builtin_bit_cast(s16x4, __builtin_amdgcn_ds_read_tr16_b64_v4i16((__attribute__((address_space(3))) v4i16_t*)(ap + 4 * 320)));
          a[i] = (bf16x8){lo[0], lo[1], lo[2], lo[3], hi[0], hi[1], hi[2], hi[3]};
        }
#pragma unroll
        for (int j = 0; j < 2; ++j) b[j] = *(const bf16x8*)(Bs + swz_off(64 * wq + 32 * j + (lane & 31), 2 * kk + (lane >> 5)));
#pragma unroll
        for (int i = 0; i < 2; ++i)
#pragma unroll
          for (int j = 0; j < 2; ++j) acc[i][j] = mfma32(a[i], b[j], acc[i][j]);
      }
      __syncthreads();
    }
#pragma unroll
    for (int e = 0; e < 8; ++e) {
      float s_ = ssh[e];
      s_ += __shfl_xor(s_, 16); s_ += __shfl_xor(s_, 32);
      if (lane < 16) red[wave * 128 + 8 * tc + e] = s_;
    }
  }
  __syncthreads();
  if (tid < 128) rh[tid] = rsqrtf((red[tid] + red[128 + tid] + red[256 + tid] + red[384 + tid]) * (1.f / 512.f) + EPSV) / ra[tid];
  __syncthreads();
#pragma unroll
  for (int i = 0; i < 2; ++i)
#pragma unroll
    for (int e = 0; e < 16; ++e) {
      const float sc = rh[64 * wp + 32 * i + (e & 3) + 8 * (e >> 2) + 4 * (lane >> 5)];
      acc[i][0][e] *= sc; acc[i][1][e] *= sc;
    }
  for (int ks = 8; ks < 16; ++ks) {
#pragma unroll
    for (int i = 0; i < 4; ++i) {
      *(u32x4*)(As + swz_off(r8 + 32 * i, ch)) = gv[i];
      *(u32x4*)(Bs + swz_off(r8 + 32 * i, ch)) = bv[i];
    }
    __syncthreads();
    if (ks < 15) {
#pragma unroll
      for (int i = 0; i < 4; ++i) {
        gv[i] = ldg16(P.z2, at_off + (unsigned)(ks - 7) * 128u + (unsigned)i * (32u * 1536u * 2u));
        bv[i] = ldg16(wsrc, b_off + (unsigned)(ks + 1) * 128u + (unsigned)i * 65536u);
      }
    }
#pragma unroll
    for (int kk = 0; kk < 4; ++kk) {
      bf16x8 a[2], b[2];
#pragma unroll
      for (int i = 0; i < 2; ++i) a[i] = *(const bf16x8*)(As + swz_off(64 * wp + 32 * i + (lane & 31), 2 * kk + (lane >> 5)));
#pragma unroll
      for (int j = 0; j < 2; ++j) b[j] = *(const bf16x8*)(Bs + swz_off(64 * wq + 32 * j + (lane & 31), 2 * kk + (lane >> 5)));
#pragma unroll
      for (int i = 0; i < 2; ++i)
#pragma unroll
        for (int j = 0; j < 2; ++j) acc[i][j] = mfma32(a[i], b[j], acc[i][j]);
    }
    __syncthreads();
  }
#pragma unroll
  for (int i = 0; i < 2; ++i)
#pragma unroll
    for (int j = 0; j < 2; ++j) {
      const int n = n0 + 64 * wq + 32 * j + (lane & 31);
      const unsigned eoff = (unsigned)(((64 * wp + 32 * i + 4 * (lane >> 5)) * 1024 + n) * 4);
      float* outb = P.out + (long)tok0 * 1024;
#pragma unroll
      for (int g4 = 0; g4 < 4; ++g4) {
        float xr[4];
#pragma unroll
        for (int e = 0; e < 4; ++e) xr[e] = *(const float*)((const char*)xres + (eoff + (unsigned)(g4 * 8 + e) * 4096u));
#pragma unroll
        for (int e = 0; e < 4; ++e)
          *(float*)((char*)outb + (eoff + (unsigned)(g4 * 8 + e) * 4096u)) =
              xr[e] + acc[i][j][4 * g4 + e] * ra[64 * wp + 32 * i + 8 * g4 + 4 * (lane >> 5) + e];
      }
    }
  __syncthreads();
}

__device__ void phase_p3(const Params& P, int layer, int bid, int nb, char* lds) {
  for (int v = bid; v < 3072; v += nb) {
    int wv = v >> 9, within = v & 511, x = within & 7, idx = within >> 3;
    int mt = wv * 64 + x * 8 + (idx >> 3);
    int nt = idx & 7;
    p3_tile(P, layer, mt, nt, lds);
  }
}

__device__ __forceinline__ void run_phase(const Params& P, int ph, int bid, int nb, char* lds) {
  switch (ph) {
    case 0: phase_prep(P, bid, nb, lds); break;
    case 1: phase_p1(P, 0, bid, nb, lds, 0); break;
    case 2: phase_p2(P, 0, bid, nb, lds, 3); break;
    case 3: phase_p3(P, 0, bid, nb, lds); break;
    case 4: phase_p1(P, 1, bid, nb, lds, 0); break;
    case 5: phase_p2(P, 1, bid, nb, lds, 3); break;
    case 6: phase_p3(P, 1, bid, nb, lds); break;
  }
}

#if MULTI
__global__ void __launch_bounds__(256, 2) phase_kernel(Params P, int ph) {
  __shared__ __attribute__((aligned(16))) char lds[LDS_BYTES];
  run_phase(P, ph, blockIdx.x, gridDim.x, lds);
}
#else
__global__ void __launch_bounds__(256, 2) mega_kernel(Params P) {
  __shared__ __attribute__((aligned(16))) char lds[LDS_BYTES];
  cg::grid_group grid = cg::this_grid();
  const int bid = blockIdx.x, nb = gridDim.x;
#pragma unroll 1
  for (int st = 0; st < NSTEPS; ++st) {
    const int ph = (int)((PROG >> (4 * st)) & 15ull);
    const int layer = (ph >= 4 && ph <= 6) ? 1 : 0;
    const int sub = ph == 0 ? 0 : (ph <= 6 ? ((ph - 1) % 3 + 1) : ph - 3);
    switch (sub) {
      case 0: phase_prep(P, bid, nb, lds); break;
      case 1: phase_p1(P, layer, bid, nb, lds, 0); break;
      case 6: case 7: case 8: phase_p1(P, 0, bid, nb, lds, sub - 5); break;
      case 2: phase_p2(P, layer, bid, nb, lds, 3); break;
      case 3: phase_p3(P, layer, bid, nb, lds); break;
      case 4: phase_p2(P, layer, bid, nb, lds, 1); break;
      case 5: phase_p2(P, layer, bid, nb, lds, 2); break;
    }
    if (st < NSTEPS - 1) grid.sync();
  }
}
#endif

extern "C" void kernel_launch(void* const* d_in, const int* in_sizes, int n_in, void* d_out, int out_size,
                              void* d_ws, size_t ws_size, hipStream_t stream) {
  Params P{};
  P.xp = (const float*)d_in[0]; P.xs = (const float*)d_in[1];
  P.norm_g = (const float*)d_in[2]; P.w_in = (const float*)d_in[3]; P.conv_w = (const float*)d_in[4];
  P.conv_b = (const float*)d_in[5]; P.f_w1 = (const float*)d_in[6]; P.f_b1 = (const float*)d_in[7];
  P.f_fr1 = (const float*)d_in[8]; P.f_w2 = (const float*)d_in[9]; P.f_b2 = (const float*)d_in[10];
  P.f_fr2 = (const float*)d_in[11]; P.f_w3 = (const float*)d_in[12]; P.hy_bias = (const float*)d_in[13];
  P.qn_g = (const float*)d_in[14]; P.kn_g = (const float*)d_in[15]; P.rpb = (const float*)d_in[16];
  P.on_hy = (const float*)d_in[17]; P.on_att = (const float*)d_in[18]; P.w_out = (const float*)d_in[19];
  P.out = (float*)d_out;
  char* ws = (char*)d_ws;
  size_t off = 0;
  P.zT = (unsigned short*)(ws + off); off += (size_t)2560 * NTOK * 2;
  P.z2 = (unsigned short*)(ws + off); off += (size_t)NTOK * 1536 * 2;
  P.filt = (unsigned short*)(ws + off); off += (size_t)2 * 512 * 24576 * 2;
  P.winT = (unsigned short*)(ws + off); off += (size_t)2 * 4096 * 1024 * 2;
  P.woutT = (unsigned short*)(ws + off); off += (size_t)2 * 1024 * 1024 * 2;
  P.ssqA = (float*)(ws + off); off += (size_t)NTOK * 8 * 4;
  if (off > ws_size) { fprintf(stderr, "workspace too small: need %zu have %zu\n", off, ws_size); return; }
#if MULTI
  for (int ph = 0; ph < 7; ++ph) phase_kernel<<<512, 256, 0, stream>>>(P, ph);
#else
  static int grid_blocks = 0;
  if (!grid_blocks) {
    int dev = 0, cus = 0, per_cu = 0;
    hipGetDevice(&dev);
    hipDeviceGetAttribute(&cus, hipDeviceAttributeMultiprocessorCount, dev);
    hipOccupancyMaxActiveBlocksPerMultiprocessor(&per_cu, mega_kernel, 256, 0);
    if (per_cu > 2) per_cu = 2;
    grid_blocks = cus * per_cu;
  }
  void* args[] = {&P};
  hipError_t e = hipLaunchCooperativeKernel((void*)mega_kernel, dim3(grid_blocks), dim3(256), args, 0, stream);
  if (e != hipSuccess) fprintf(stderr, "cooperative launch failed: %s (grid %d)\n", hipGetErrorString(e), grid_blocks);
#endif
}
```

```cpp
#include <hip/hip_runtime.h>
#include <hip/hip_cooperative_groups.h>
#include <stdint.h>
#include <stdio.h>
namespace cg = cooperative_groups;

#ifndef MULTI
#define MULTI 0
#endif

typedef __attribute__((ext_vector_type(8))) short bf16x8;
typedef __attribute__((ext_vector_type(4))) short s16x4;
typedef __attribute__((ext_vector_type(16))) float f32x16;
typedef __attribute__((ext_vector_type(4))) float f32x4;
typedef short v4i16_t __attribute__((ext_vector_type(4)));
typedef __attribute__((ext_vector_type(4))) unsigned int u32x4;
typedef __attribute__((ext_vector_type(2))) unsigned int u32x2;
typedef __attribute__((address_space(3))) const char* lds_cptr;

#define NTOK 49152
#define NPTOK 32768
#define EPSV 1e-6f
#define LOG2E 1.4426950408889634f
#define LDS_BYTES 69760
#ifndef PROG
#define PROG 0x6543210ull
#define NSTEPS 7
#endif

struct Params {
  const float* xp; const float* xs;
  const float* norm_g; const float* w_in; const float* conv_w; const float* conv_b;
  const float* f_w1; const float* f_b1; const float* f_fr1; const float* f_w2; const float* f_b2;
  const float* f_fr2; const float* f_w3; const float* hy_bias; const float* qn_g; const float* kn_g;
  const float* rpb; const float* on_hy; const float* on_att; const float* w_out;
  float* out;
  unsigned short* zT;
  unsigned short* z2;
  unsigned short* filt;
  unsigned short* winT;
  unsigned short* woutT;
  float* ssqA;
  unsigned short* xb1;
  float* rstd1;
};

__device__ __forceinline__ int opaque_tid() { int t = threadIdx.x; asm volatile("" : "+v"(t)); return t; }
__device__ __forceinline__ unsigned short f2bf(float f) {
  unsigned int u = __float_as_uint(f);
  u += 0x7fffu + ((u >> 16) & 1u);
  return (unsigned short)(u >> 16);
}
__device__ __forceinline__ float bf2f(unsigned short h) { return __uint_as_float(((unsigned int)h) << 16); }
typedef __attribute__((ext_vector_type(2))) float f32x2_t;
typedef __attribute__((ext_vector_type(2))) __bf16 bf16x2_t;
__device__ __forceinline__ unsigned int pack2(float a, float b) { f32x2_t v = {a, b}; return __builtin_bit_cast(unsigned int, __builtin_convertvector(v, bf16x2_t)); }
__device__ __forceinline__ unsigned int pack2t(float a, float b) { return pack2(a, b); }
__device__ __forceinline__ float lo2f(unsigned int u) { return __uint_as_float(u << 16); }
__device__ __forceinline__ float hi2f(unsigned int u) { return __uint_as_float(u & 0xffff0000u); }
__device__ __forceinline__ float silu_f(float g) { return g / (1.f + __expf(-g)); }
__device__ __forceinline__ int swz_off(int row, int ch) { return row * 128 + ((ch ^ ((row >> 1) & 7)) << 4); }

__device__ __forceinline__ f32x16 mfma32(bf16x8 a, bf16x8 b, f32x16 c) { return __builtin_amdgcn_mfma_f32_32x32x16_bf16(a, b, c, 0, 0, 0); }
__device__ __forceinline__ f32x4 mfma16(bf16x8 a, bf16x8 b, f32x4 c) { return __builtin_amdgcn_mfma_f32_16x16x32_bf16(a, b, c, 0, 0, 0); }

__device__ __forceinline__ u32x4 mk4(unsigned a, unsigned b, unsigned c, unsigned d) { u32x4 r = {a, b, c, d}; return r; }
__device__ __forceinline__ u32x2 mk2(unsigned a, unsigned b) { u32x2 r = {a, b}; return r; }
__device__ __forceinline__ bf16x8 u4_to_frag(u32x4 v) {
  union { u32x4 u; bf16x8 f; } x; x.u = v; return x.f;
}

__device__ void filter_unit(const Params& P, int u, char* lds) {
  const int tid = opaque_tid(), lane = tid & 63;
  const int wave = __builtin_amdgcn_readfirstlane(tid >> 6);
  const int l = u / 192; const int rr = u % 192;
  const int set = rr < 128 ? 0 : 1; const int pch = set ? rr - 128 : rr;
  const int L = set ? 4096 : 8192;
  const int p = pch * 64 + lane;
  const float t01 = (float)p / (float)(L - 1);
  const float pl = (float)p / (float)L;
  float* zs = (float*)lds;
  float* h1s = zs + 33 * 64;
  char* Hq = lds + 24832;
  char* Ws = lds + 33024;
  if (wave == 0) {
    zs[lane] = t01;
#pragma unroll
    for (int k = 0; k < 16; ++k) {
      float fk = 1e-4f + (float)k * ((15.f - 1e-4f) / 15.f);
      float tr = fk * pl; tr -= floorf(tr);
      zs[(1 + k) * 64 + lane] = __builtin_amdgcn_cosf(tr);
      zs[(17 + k) * 64 + lane] = -__builtin_amdgcn_sinf(tr);
    }
  }
  __syncthreads();
  const float* w1 = P.f_w1 + l * 33 * 64; const float* b1 = P.f_b1 + l * 64; const float* fr1 = P.f_fr1 + l * 64;
  const float* w2 = P.f_w2 + l * 64 * 64; const float* b2 = P.f_b2 + l * 64; const float* fr2 = P.f_fr2 + l * 64;
  const float* w3 = P.f_w3 + l * 64 * 1024;
  const int j0 = wave * 16;
  {
    float acc[16];
#pragma unroll
    for (int j = 0; j < 16; ++j) acc[j] = b1[j0 + j];
#pragma unroll 3
    for (int i = 0; i < 33; ++i) {
      const float zv = zs[i * 64 + lane];
#pragma unroll
      for (int j = 0; j < 16; ++j) acc[j] += zv * w1[i * 64 + j0 + j];
    }
#pragma unroll
    for (int j = 0; j < 16; ++j) h1s[(j0 + j) * 64 + lane] = __builtin_amdgcn_sinf(fr1[j0 + j] * acc[j] * 0.15915494309189535f);
  }
  __syncthreads();
  {
    float acc[16];
#pragma unroll
    for (int j = 0; j < 16; ++j) acc[j] = b2[j0 + j];
#pragma unroll 4
    for (int i = 0; i < 64; ++i) {
      const float hv = h1s[i * 64 + lane];
#pragma unroll
      for (int j = 0; j < 16; ++j) acc[j] += hv * w2[i * 64 + j0 + j];
    }
    float hh[16];
#pragma unroll
    for (int j = 0; j < 16; ++j) hh[j] = __builtin_amdgcn_sinf(fr2[j0 + j] * acc[j] * 0.15915494309189535f);
    *(u32x4*)(Hq + swz_off(lane, 2 * wave)) = mk4(pack2t(hh[0], hh[1]), pack2t(hh[2], hh[3]), pack2t(hh[4], hh[5]), pack2t(hh[6], hh[7]));
    *(u32x4*)(Hq + swz_off(lane, 2 * wave + 1)) = mk4(pack2t(hh[8], hh[9]), pack2t(hh[10], hh[11]), pack2t(hh[12], hh[13]), pack2t(hh[14], hh[15]));
  }
  const float mind = -3.0701134573253943f, maxd = -15.350567286626972f;
  const int setoff = set ? 16384 : 0;
  const int qpos0 = pch * 64 + (lane & 31);
  for (int nc = 0; nc < 8; ++nc) {
    const int n0 = nc * 128;
    __syncthreads();
#pragma unroll
    for (int i = 0; i < 4; ++i) {
      const int id = tid + 256 * i; const int krow = id >> 4, c8 = id & 15;
      const float* src = w3 + krow * 1024 + n0 + 8 * c8;
      f32x4 a0 = *(const f32x4*)src, a1 = *(const f32x4*)(src + 4);
      *(u32x4*)(Ws + krow * 320 + c8 * 16) = mk4(pack2(a0.x, a0.y), pack2(a0.z, a0.w), pack2(a1.x, a1.y), pack2(a1.z, a1.w));
    }
    __syncthreads();
    f32x16 acc[2];
#pragma unroll
    for (int j = 0; j < 2; ++j) {
#pragma unroll
      for (int e = 0; e < 16; ++e) acc[j][e] = 0.f;
    }
#pragma unroll
    for (int kk = 0; kk < 4; ++kk) {
      const int l16 = lane & 15;
      const int krow = 16 * kk + 8 * (lane >> 5) + (l16 >> 2);
      const int ncol = 32 * wave + 16 * ((lane >> 4) & 1) + 4 * (l16 & 3);
      lds_cptr ap = (lds_cptr)Ws + krow * 320 + ncol * 2;
      s16x4 lo = __builtin_bit_cast(s16x4, __builtin_amdgcn_ds_read_tr16_b64_v4i16((__attribute__((address_space(3))) v4i16_t*)ap));
      s16x4 hi = __builtin_bit_cast(s16x4, __builtin_amdgcn_ds_read_tr16_b64_v4i16((__attribute__((address_space(3))) v4i16_t*)(ap + 4 * 320)));
      bf16x8 a = (bf16x8){lo[0], lo[1], lo[2], lo[3], hi[0], hi[1], hi[2], hi[3]};
#pragma unroll
      for (int j = 0; j < 2; ++j) {
        bf16x8 b = *(const bf16x8*)(Hq + swz_off(32 * j + (lane & 31), 2 * kk + (lane >> 5)));
        acc[j] = mfma32(a, b, acc[j]);
      }
    }
#pragma unroll
    for (int j = 0; j < 2; ++j) {
      const int pos = qpos0 + 32 * j;
      const float tq = (float)pos / (float)(L - 1);
#pragma unroll
      for (int e = 0; e < 16; ++e) {
        const int col = n0 + 32 * wave + (e & 3) + 8 * (e >> 2) + 4 * (lane >> 5);
        const float delta = fabsf(mind + (float)col * ((maxd - mind) / 1023.f));
        const float val = acc[j][e] * __expf(-tq * delta);
        const int c = col & 511;
        unsigned short* dst = P.filt + ((long)(l * 512 + c)) * 24576 + setoff;
        if (col < 512) dst[L - pos] = f2bf(val);
        else { if (pos > 0) dst[L + pos] = f2bf(val); else dst[0] = 0; }
      }
    }
  }
  __syncthreads();
}

__device__ void phase_prep(const Params& P, int bid, int nb, char* lds) {
  const int tid = opaque_tid();
  const long gt = (long)bid * 256 + tid, gs = (long)nb * 256;
  for (long i = gt; i < 2L * 128 * 4096; i += gs) {
    int n = (int)(i & 4095); int kc = (int)((i >> 12) & 127); int l = (int)(i >> 19);
    const float* w = P.w_in + ((long)l * 1024 + kc * 8) * 4096 + n;
    const float* g = P.norm_g + l * 1024 + kc * 8;
    unsigned int o[4];
#pragma unroll
    for (int j = 0; j < 4; ++j) o[j] = pack2(w[(long)(2 * j) * 4096] * g[2 * j], w[(long)(2 * j + 1) * 4096] * g[2 * j + 1]);
    *(u32x4*)(P.winT + ((long)l * 4096 + n) * 1024 + kc * 8) = mk4(o[0], o[1], o[2], o[3]);
  }
  for (long i = gt; i < 2L * 128 * 1024; i += gs) {
    int n = (int)(i & 1023); int kc = (int)((i >> 10) & 127); int l = (int)(i >> 17);
    const float* w = P.w_out + ((long)l * 1024 + kc * 8) * 1024 + n;
    const float* g = (kc < 64) ? (P.on_hy + l * 512 + kc * 8) : (P.on_att + l * 512 + (kc - 64) * 8);
    unsigned int o[4];
#pragma unroll
    for (int j = 0; j < 4; ++j) o[j] = pack2(w[(long)(2 * j) * 1024] * g[2 * j], w[(long)(2 * j + 1) * 1024] * g[2 * j + 1]);
    *(u32x4*)(P.woutT + ((long)l * 1024 + n) * 1024 + kc * 8) = mk4(o[0], o[1], o[2], o[3]);
  }
  {
    const int lane = tid & 63; const int gw = bid * 4 + (tid >> 6);
    for (int row = gw; row < NTOK; row += nb * 4) {
      const float* src = (row < NPTOK) ? P.xp + (long)row * 1024 : P.xs + (long)(row - NPTOK) * 1024;
      unsigned short* dst = P.xb1 + (long)row * 1024;
      float ss = 0.f;
#pragma unroll
      for (int i = 0; i < 4; ++i) {
        const f32x4 a = *(const f32x4*)(src + (i * 64 + lane) * 4);
        ss += a.x * a.x + a.y * a.y + a.z * a.z + a.w * a.w;
        *(u32x2*)(dst + (i * 64 + lane) * 4) = mk2(pack2(a.x, a.y), pack2(a.z, a.w));
      }
      ss += __shfl_xor(ss, 32); ss += __shfl_xor(ss, 16); ss += __shfl_xor(ss, 8);
      ss += __shfl_xor(ss, 4); ss += __shfl_xor(ss, 2); ss += __shfl_xor(ss, 1);
      if (lane == 0) P.rstd1[row] = rsqrtf(ss * (1.f / 1024.f) + EPSV);
    }
  }
  for (int u = bid; u < 384; u += nb) filter_unit(P, u, lds);
}

__device__ __forceinline__ u32x4 ldg16(const void* base, unsigned off) { return *(const u32x4*)((const char*)base + off); }

__device__ __forceinline__ void unpack8(u32x4 v, float* f) {
  f[0] = lo2f(v.x); f[1] = hi2f(v.x); f[2] = lo2f(v.y); f[3] = hi2f(v.y);
  f[4] = lo2f(v.z); f[5] = hi2f(v.z); f[6] = lo2f(v.w); f[7] = hi2f(v.w);
}

__device__ void p1_tile(const Params& P, int layer, int mt, int nt, char* lds, int variant) {
  const int tid = opaque_tid(), lane = tid & 63, wave = tid >> 6;
  const int tok0 = mt * 128, n0 = nt * 128;
  bool swap; int dst0; int mode = 0;
  const bool gate = (n0 >= 1536 && n0 < 2048) || (n0 >= 3584);
  if (n0 < 1536) { swap = false; dst0 = n0; }
  else if (n0 < 2048) { swap = false; dst0 = 2048 + (n0 - 1536); }
  else if (n0 < 2560) { swap = true; dst0 = n0 - 2048; mode = 1; }
  else if (n0 < 3072) { swap = true; dst0 = 512 + (n0 - 2560); mode = 2; }
  else if (n0 < 3584) { swap = false; dst0 = 1536 + (n0 - 3072); }
  else { swap = true; dst0 = 1024 + (n0 - 3584); }
  const float* xsrc = (layer == 0) ? ((tok0 < NPTOK) ? P.xp + (long)tok0 * 1024 : P.xs + (long)(tok0 - NPTOK) * 1024)
                                   : P.out + (long)tok0 * 1024;
  const unsigned short* wsrc = P.winT + ((long)layer * 4096 + n0) * 1024;
  char* S = lds; float* rs = (float*)(lds + 65536);
  const int wp = wave >> 1, wq = wave & 1;
  f32x16 acc[2][2];
#pragma unroll
  for (int i = 0; i < 2; ++i)
#pragma unroll
    for (int j = 0; j < 2; ++j)
#pragma unroll
      for (int e = 0; e < 16; ++e) acc[i][j][e] = 0.f;
  const int r8 = tid >> 3, ch = tid & 7;
  const int r16 = tid >> 4, c4 = tid & 15;
  f32x4 av[8]; u32x4 bv[4]; float ssq[8];
#pragma unroll
  for (int i = 0; i < 8; ++i) ssq[i] = 0.f;
  const unsigned a_off = (unsigned)((r16 * 1024 + c4 * 4) * 4);
  const unsigned b_off = (unsigned)((r8 * 1024 + ch * 8) * 2);
#define P1_LOAD(ks_) do { \
    _Pragma("unroll") for (int i = 0; i < 8; ++i) av[i] = *(const f32x4*)((const char*)xsrc + (a_off + (unsigned)i * 65536u + (unsigned)(ks_) * 256u)); \
    _Pragma("unroll") for (int i = 0; i < 4; ++i) bv[i] = ldg16(wsrc, b_off + (unsigned)i * 65536u + (unsigned)(ks_) * 128u); } while (0)
#define P1_STORE(buf_) do { \
    char* As_ = lds + (buf_) * 32768; char* Bs_ = As_ + 16384; \
    _Pragma("unroll") for (int i = 0; i < 8; ++i) { \
      f32x4 a0 = av[i]; \
      ssq[i] += a0.x * a0.x + a0.y * a0.y + a0.z * a0.z + a0.w * a0.w; \
      const int row_ = r16 + 16 * i; \
      *(u32x2*)(As_ + row_ * 128 + (((c4 >> 1) ^ ((row_ >> 1) & 7)) << 4) + (c4 & 1) * 8) = mk2(pack2(a0.x, a0.y), pack2(a0.z, a0.w)); } \
    _Pragma("unroll") for (int i = 0; i < 4; ++i) *(u32x4*)(Bs_ + swz_off(r8 + 32 * i, ch)) = bv[i]; } while (0)
  if (layer == 0) {
    const unsigned short* asrc = P.xb1 + (long)tok0 * 1024;
    unsigned goff[4], loff[4];
#pragma unroll
    for (int i = 0; i < 4; ++i) {
      const int m = wave * 4 + i; const int row = 8 * m + (lane >> 3); const int cc = (lane & 7) ^ ((row >> 1) & 7);
      goff[i] = (unsigned)(row * 2048 + cc * 16); loff[i] = (unsigned)(m * 1024 + lane * 16);
    }
#define P1_DMA(ks_, buf_) do { _Pragma("unroll") for (int i = 0; i < 4; ++i) { \
      __builtin_amdgcn_global_load_lds((const unsigned*)((const char*)asrc + goff[i] + (unsigned)(ks_) * 128u), (unsigned*)(lds + (buf_) * 32768 + loff[i]), 16, 0, 0); \
      __builtin_amdgcn_global_load_lds((const unsigned*)((const char*)wsrc + goff[i] + (unsigned)(ks_) * 128u), (unsigned*)(lds + (buf_) * 32768 + 16384 + loff[i]), 16, 0, 0); } } while (0)
    P1_DMA(0, 0);
    if (tid < 128) rs[tid] = P.rstd1[tok0 + tid];
    for (int ks = 0; ks < 16; ++ks) {
      const int cur = ks & 1;
      __syncthreads();
      if (ks + 1 < 16) P1_DMA(ks + 1, cur ^ 1);
      const char* As = lds + cur * 32768; const char* Bs = As + 16384;
      const char* Pb = swap ? Bs : As; const char* Qb = swap ? As : Bs;
#pragma unroll
      for (int kk = 0; kk < 4; ++kk) {
        bf16x8 a[2], b[2];
#pragma unroll
        for (int i = 0; i < 2; ++i) a[i] = *(const bf16x8*)(Pb + swz_off(64 * wp + 32 * i + (lane & 31), 2 * kk + (lane >> 5)));
#pragma unroll
        for (int j = 0; j < 2; ++j) b[j] = *(const bf16x8*)(Qb + swz_off(64 * wq + 32 * j + (lane & 31), 2 * kk + (lane >> 5)));
#pragma unroll
        for (int i = 0; i < 2; ++i)
#pragma unroll
          for (int j = 0; j < 2; ++j) acc[i][j] = mfma32(a[i], b[j], acc[i][j]);
      }
    }
#undef P1_DMA
    __syncthreads();
  } else {
  P1_LOAD(0);
  P1_STORE(0);
  P1_LOAD(1);
  __syncthreads();
  for (int ks = 0; ks < 16; ++ks) {
    const int cur = ks & 1;
    if (ks + 1 < 16) P1_STORE(cur ^ 1);
    if (ks + 2 < 16 && !(variant & 1)) P1_LOAD(ks + 2);
    __builtin_amdgcn_sched_barrier(0);
    const char* As = lds + cur * 32768; const char* Bs = As + 16384;
    const char* Pb = swap ? Bs : As; const char* Qb = swap ? As : Bs;
#pragma unroll
    for (int kk = 0; kk < 4; ++kk) {
      bf16x8 a[2], b[2];
#pragma unroll
      for (int i = 0; i < 2; ++i) a[i] = *(const bf16x8*)(Pb + swz_off(64 * wp + 32 * i + (lane & 31), 2 * kk + (lane >> 5)));
#pragma unroll
      for (int j = 0; j < 2; ++j) b[j] = *(const bf16x8*)(Qb + swz_off(64 * wq + 32 * j + (lane & 31), 2 * kk + (lane >> 5)));
#pragma unroll
      for (int i = 0; i < 2; ++i)
#pragma unroll
        for (int j = 0; j < 2; ++j) acc[i][j] = mfma32(a[i], b[j], acc[i][j]);
    }
    __syncthreads();
  }
#undef P1_LOAD
#undef P1_STORE
#pragma unroll
  for (int i = 0; i < 8; ++i) {
    float s_ = ssq[i];
    s_ += __shfl_xor(s_, 1); s_ += __shfl_xor(s_, 2); s_ += __shfl_xor(s_, 4); s_ += __shfl_xor(s_, 8);
    if (c4 == 0) rs[r16 + 16 * i] = rsqrtf(s_ * (1.f / 1024.f) + EPSV);
  }
  __syncthreads();
  }
#pragma unroll
  for (int i = 0; i < 2; ++i)
#pragma unroll
    for (int j = 0; j < 2; ++j) {
      const int q = 64 * wq + 32 * j + (lane & 31);
#pragma unroll
      for (int g4 = 0; g4 < 4; ++g4) {
        const int p = 64 * wp + 32 * i + 8 * g4 + 4 * (lane >> 5);
        float v[4];
#pragma unroll
        for (int e = 0; e < 4; ++e) v[e] = acc[i][j][4 * g4 + e] * (swap ? rs[q] : rs[p + e]);
        if (gate) {
#pragma unroll
          for (int e = 0; e < 4; ++e) v[e] = v[e] * __builtin_amdgcn_rcpf(1.f + __expf(-v[e]));
        }
        *(u32x2*)(S + q * 272 + p * 2) = mk2(pack2(v[0], v[1]), pack2(v[2], v[3]));
      }
    }
  __syncthreads();
#pragma unroll
  for (int it = 0; it < 8; ++it) {
    const int id = tid + 256 * it; const int row = id >> 4, c16 = id & 15;
    u32x4 v = *(const u32x4*)(S + row * 272 + c16 * 16);
    if (variant & 2) continue;
    if (!swap) {
      *(u32x4*)(P.zT + (long)(dst0 + row) * NTOK + tok0 + c16 * 8) = v;
    } else {
      if (mode) {
        float f[8];
        f[0] = lo2f(v.x); f[1] = hi2f(v.x); f[2] = lo2f(v.y); f[3] = hi2f(v.y);
        f[4] = lo2f(v.z); f[5] = hi2f(v.z); f[6] = lo2f(v.w); f[7] = hi2f(v.w);
        float ss = 0.f;
#pragma unroll
        for (int e = 0; e < 8; ++e) ss += f[e] * f[e];
        ss += __shfl_xor(ss, 1); ss += __shfl_xor(ss, 2); ss += __shfl_xor(ss, 4);
        float sc = rsqrtf(ss * (1.f / 64.f) + EPSV);
        if (mode == 1) sc *= 0.125f * LOG2E;
        const float* g = (mode == 1 ? P.qn_g : P.kn_g) + layer * 64 + (c16 & 7) * 8;
#pragma unroll
        for (int e = 0; e < 8; ++e) f[e] *= sc * g[e];
        v = mk4(pack2(f[0], f[1]), pack2(f[2], f[3]), pack2(f[4], f[5]), pack2(f[6], f[7]));
      }
      *(u32x4*)(P.z2 + (long)(tok0 + row) * 1536 + dst0 + c16 * 8) = v;
    }
  }
  __syncthreads();
}

__device__ void phase_p1(const Params& P, int layer, int bid, int nb, char* lds, int variant) {
  for (int v = bid; v < 12288; v += nb) {
    int wv = v >> 9, within = v & 511, x = within & 7, idx = within >> 3;
    int mt = wv * 16 + (x >> 2) * 8 + (idx >> 3);
    int nt = (x & 3) * 8 + (idx & 7);
    p1_tile(P, layer, mt, nt, lds, variant);
  }
}

template <int L, int NBP>
__device__ void conv_unit(const Params& P, int layer, int set, int c, int bp0, char* lds) {
  constexpr int NB = L / 32, UB = (NB + 32) * 64, WPB = 4 / NBP, NSTEP = NB / 16 + 1;
  static_assert(NB / WPB == 64, "each wave owns 64 output blocks (4 N-tiles)");
  char* U = lds; char* F = lds + NBP * 2 * UB;
  const int tid = opaque_tid(), lane = tid & 63, wave = tid >> 6;
  const long setbase = (long)(set ? NPTOK : 0) + (long)(2 * bp0) * L;
  const unsigned short* x0r = P.zT + (long)c * NTOK + setbase;
  const unsigned short* x1r = P.zT + (long)(512 + c) * NTOK + setbase;
  const unsigned short* vr = P.zT + (long)(1024 + c) * NTOK + setbase;
  const float* cw = P.conv_w + layer * 3 * 1536; const float* cb = P.conv_b + layer * 1536;
  {
    const float w1a = cw[512 + c], w1b = cw[1536 + 512 + c], w1c = cw[3072 + 512 + c], b1 = cb[512 + c];
    const float wva = cw[1024 + c], wvb = cw[1536 + 1024 + c], wvc = cw[3072 + 1024 + c], bvv = cb[1024 + c];
#pragma unroll
    for (int pp = 0; pp < NBP; ++pp) {
      const int id = tid + 256 * pp; const int pb = id >> 7; const int rem = id & 127; const int side = rem >> 6; const int o = rem & 63;
      *(u32x4*)(U + pb * UB + (side ? (NB + 16) * 64 : 0) + o * 16) = mk4(0, 0, 0, 0);
    }
    for (int id = tid; id < NBP * 2 * L / 8; id += 256) {
      const int pb = id / (L / 8); const int t8 = (id % (L / 8)) * 8;
      const unsigned short* a = x1r + (long)pb * L + t8; const unsigned short* b = vr + (long)pb * L + t8;
      u32x4 xa = *(const u32x4*)a; u32x4 xb = *(const u32x4*)b;
      float xs[10], vs[10];
      xs[0] = t8 > 0 ? bf2f(a[-1]) : 0.f; xs[9] = (t8 + 8 < L) ? bf2f(a[8]) : 0.f;
      vs[0] = t8 > 0 ? bf2f(b[-1]) : 0.f; vs[9] = (t8 + 8 < L) ? bf2f(b[8]) : 0.f;
      unpack8(xa, xs + 1); unpack8(xb, vs + 1);
      float uu[8];
#pragma unroll
      for (int e = 0; e < 8; ++e) {
        float x1c = w1a * xs[e] + w1b * xs[e + 1] + w1c * xs[e + 2] + b1;
        float vc = wva * vs[e] + wvb * vs[e + 1] + wvc * vs[e + 2] + bvv;
        uu[e] = x1c * vc;
      }
      const int blk = (t8 >> 5) + 16; const int chunk = (t8 >> 3) & 3;
      *(u32x4*)(U + pb * UB + blk * 64 + ((chunk ^ ((blk >> 2) & 3)) << 4)) =
          mk4(pack2(uu[0], uu[1]), pack2(uu[2], uu[3]), pack2(uu[4], uu[5]), pack2(uu[6], uu[7]));
    }
    const unsigned short* fsrc = P.filt + ((long)(layer * 512 + c)) * 24576 + (set ? 16384 : 0);
    for (int id = tid; id < 2 * L / 8; id += 256) *(u32x4*)(F + id * 16) = *(const u32x4*)(fsrc + id * 8);
    if (tid < 8) *(u32x4*)(F + 2 * L * 2 + tid * 16) = mk4(0, 0, 0, 0);
  }
  __syncthreads();

  const int pw = wave / WPB;
  const int T0w = (wave % WPB) * 64;
  const int ii = lane & 31, h = lane >> 5;
  const int bb = (lane >> 4) & 1, mm = lane & 15;
  const char* Uw = U + (pw * 2 + bb) * UB;
  const int base0 = L - ii + 8 * h;
  const int wdw = base0 >> 1; const unsigned sh = (unsigned)(base0 & 1) * 16u;
  f32x16 acc[4];
#pragma unroll
  for (int r = 0; r < 4; ++r)
#pragma unroll
    for (int e = 0; e < 16; ++e) acc[r][e] = 0.f;
  bf16x8 Ar[4][2];
  unsigned raw[2][5];

#define LOADA_RAW(ptr_) do { const unsigned* fp_ = (const unsigned*)(ptr_); \
    _Pragma("unroll") for (int j_ = 0; j_ < 5; ++j_) { raw[0][j_] = fp_[j_]; raw[1][j_] = fp_[8 + j_]; } } while (0)
#define FIXA(dst_) do { _Pragma("unroll") for (int k_ = 0; k_ < 2; ++k_) { union { unsigned u[4]; bf16x8 f; } x_; \
    _Pragma("unroll") for (int j_ = 0; j_ < 4; ++j_) x_.u[j_] = __builtin_amdgcn_alignbit(raw[k_][j_ + 1], raw[k_][j_], sh); \
    (dst_)[k_] = x_.f; } } while (0)
#define LOADB(dst_, q_) do { (dst_)[0] = *(const bf16x8*)(ub0 + 1024 * (q_)); (dst_)[1] = *(const bf16x8*)(ub1 + 1024 * (q_)); } while (0)
#define MMAS(u_, B_) do { _Pragma("unroll") for (int r_ = 0; r_ < 4; ++r_) { \
    acc[r_] = mfma32(Ar[(r_ - (u_) + 4) & 3][0], (B_)[0], acc[r_]); \
    acc[r_] = mfma32(Ar[(r_ - (u_) + 4) & 3][1], (B_)[1], acc[r_]); } } while (0)

  for (int e = 0; e < 16; ++e) {
    const int sb0 = e - 15;
    const int D0 = T0w - sb0;
    const char* fa = F + 4 * wdw - 64 * D0;
    const int blk0 = sb0 + mm + 16; const int swz = (blk0 >> 2) & 3;
    const char* ub0 = Uw + blk0 * 64 + ((h ^ swz) << 4);
    const char* ub1 = Uw + blk0 * 64 + (((2 + h) ^ swz) << 4);
#pragma unroll
    for (int s_ = 1; s_ < 4; ++s_) { LOADA_RAW(fa - 1024 * s_); FIXA(Ar[s_]); }
    bf16x8 Bc[2], Bn[2];
    LOADA_RAW(fa); LOADB(Bc, 0);
    for (int Q = 0; Q < (NSTEP - 1) / 4; ++Q) {
      const char* fq = fa + 4096 * Q;
      const int q0 = 4 * Q;
      FIXA(Ar[0]); LOADA_RAW(fq + 1024); LOADB(Bn, q0 + 1); __builtin_amdgcn_sched_barrier(0);
      MMAS(0, Bc); __builtin_amdgcn_sched_barrier(0);
      FIXA(Ar[3]); LOADA_RAW(fq + 2048); LOADB(Bc, q0 + 2); __builtin_amdgcn_sched_barrier(0);
      MMAS(1, Bn); __builtin_amdgcn_sched_barrier(0);
      FIXA(Ar[2]); LOADA_RAW(fq + 3072); LOADB(Bn, q0 + 3); __builtin_amdgcn_sched_barrier(0);
      MMAS(2, Bc); __builtin_amdgcn_sched_barrier(0);
      FIXA(Ar[1]); LOADA_RAW(fq + 4096); LOADB(Bc, q0 + 4); __builtin_amdgcn_sched_barrier(0);
      MMAS(3, Bn); __builtin_amdgcn_sched_barrier(0);
    }
    FIXA(Ar[0]);
    MMAS(0, Bc);
  }
#undef LOADA_RAW
#undef FIXA
#undef LOADB
#undef MMAS
  {
    const float hb = P.hy_bias[layer * 512 + c];
    const float w0a = cw[c], w0b = cw[1536 + c], w0c = cw[3072 + c], b0 = cb[c];
    const long boff = (long)(pw * 2 + bb) * L;
    unsigned short* yout = P.zT + (long)(512 + c) * NTOK + setbase + boff;
    unsigned short* ygout = P.zT + (long)(1024 + c) * NTOK + setbase + boff;
    const unsigned short* sgr = P.zT + (long)(2048 + c) * NTOK + setbase + boff;
    const unsigned short* x0b = x0r + boff;
#pragma unroll
    for (int r = 0; r < 4; ++r) {
      const int t0 = T0w + 16 * r + mm; const int blk = t0 + 16;
#pragma unroll
      for (int g4 = 0; g4 < 4; ++g4) {
        const int t = t0 * 32 + 8 * g4 + 4 * h;
        u32x2 uv = *(const u32x2*)(Uw + blk * 64 + ((g4 ^ ((blk >> 2) & 3)) << 4) + 8 * h);
        const unsigned short* xp = x0b + t;
        u32x2 xv = *(const u32x2*)xp;
        float xs[6];
        xs[0] = t > 0 ? bf2f(xp[-1]) : 0.f; xs[5] = (t + 4 < L) ? bf2f(xp[4]) : 0.f;
        xs[1] = lo2f(xv.x); xs[2] = hi2f(xv.x); xs[3] = lo2f(xv.y); xs[4] = hi2f(xv.y);
        float us[4] = {lo2f(uv.x), hi2f(uv.x), lo2f(uv.y), hi2f(uv.y)};
        float o[4];
#pragma unroll
        for (int e = 0; e < 4; ++e) {
          float x0c = w0a * xs[e] + w0b * xs[e + 1] + w0c * xs[e + 2] + b0;
          float y = acc[r][4 * g4 + e] + hb * us[e];
          o[e] = x0c * y;
        }
        *(u32x2*)(yout + t) = mk2(pack2(o[0], o[1]), pack2(o[2], o[3]));
        const u32x2 sgv = *(const u32x2*)(sgr + t);
        *(u32x2*)(ygout + t) = mk2(pack2(o[0] * lo2f(sgv.x), o[1] * hi2f(sgv.x)), pack2(o[2] * lo2f(sgv.y), o[3] * hi2f(sgv.y)));
      }
    }
  }
  __syncthreads();
}

__device__ void attn_unit(const Params& P, int layer, int a, char* lds) {
  float* rp = (float*)lds;
  const int tid = opaque_tid(), lane = tid & 63, wave = tid >> 6;
  const int hd = a & 7, rowg = a >> 3;
  int rows, r;
  if (rowg < 512) { rows = 128; r = rowg & 127; } else { rows = 64; r = (rowg - 512) & 63; }
  const int rowbase = rowg - r;
  const int r0 = min(max(r - 4, 0), rows - 8);
  for (int i = tid; i < 465; i += 256) rp[i] = P.rpb[(layer * 8 + hd) * 465 + i] * LOG2E;
  __syncthreads();
  const int c0 = wave * 16; const int kc0 = min(max(c0 - 8, 0), 32);
  const int qi = lane & 15, g = lane >> 4;
  const long qtok = (long)rowg * 64 + c0 + qi;
  const unsigned short* qptr = P.z2 + qtok * 1536 + hd * 64 + 8 * g;
  const bf16x8 Qf0 = *(const bf16x8*)qptr, Qf1 = *(const bf16x8*)(qptr + 32);
  f32x4 S[16];
  const long bandtok = (long)(rowbase + r0) * 64;
#pragma unroll
  for (int T = 0; T < 16; ++T) {
    const int kr = T >> 1, half = T & 1;
    const long ktok = bandtok + kr * 64 + kc0 + 16 * half + qi;
    const unsigned short* kp = P.z2 + ktok * 1536 + 512 + hd * 64 + 8 * g;
    const bf16x8 K0 = *(const bf16x8*)kp, K1 = *(const bf16x8*)(kp + 32);
    f32x4 s = {0.f, 0.f, 0.f, 0.f};
    s = mfma16(K0, Qf0, s); s = mfma16(K1, Qf1, s);
    S[T] = s;
  }
  const int qc = c0 + qi; const int cs = min(max(qc - 8, 0), 48);
  float mx = -1e30f;
#pragma unroll
  for (int T = 0; T < 16; ++T) {
    const int kr = T >> 1, half = T & 1;
    const int ro = r0 + kr - r + 7;
#pragma unroll
    for (int e = 0; e < 4; ++e) {
      const int kc = kc0 + 16 * half + 4 * g + e;
      const bool valid = (kc >= cs) && (kc < cs + 16);
      const int idx = valid ? (ro * 31 + kc - qc + 15) : 0;
      float v = valid ? (S[T][e] + rp[idx]) : -1e30f;
      S[T][e] = v; mx = fmaxf(mx, v);
    }
  }
  mx = fmaxf(mx, __shfl_xor(mx, 16)); mx = fmaxf(mx, __shfl_xor(mx, 32));
  float sum = 0.f;
#pragma unroll
  for (int T = 0; T < 16; ++T)
#pragma unroll
    for (int e = 0; e < 4; ++e) { float p = exp2f(S[T][e] - mx); S[T][e] = p; sum += p; }
  sum += __shfl_xor(sum, 16); sum += __shfl_xor(sum, 32);
  f32x4 O[4];
#pragma unroll
  for (int dt = 0; dt < 4; ++dt) O[dt] = (f32x4){0.f, 0.f, 0.f, 0.f};
#pragma unroll
  for (int kr = 0; kr < 8; ++kr) {
    union { unsigned u[4]; bf16x8 f; } pf;
    pf.u[0] = pack2(S[2 * kr][0], S[2 * kr][1]); pf.u[1] = pack2(S[2 * kr][2], S[2 * kr][3]);
    pf.u[2] = pack2(S[2 * kr + 1][0], S[2 * kr + 1][1]); pf.u[3] = pack2(S[2 * kr + 1][2], S[2 * kr + 1][3]);
    const long vt = bandtok + kr * 64 + kc0 + 4 * g;
#pragma unroll
    for (int dt = 0; dt < 4; ++dt) {
      const unsigned short* vp = P.zT + (long)(1536 + hd * 64 + 16 * dt + qi) * NTOK + vt;
      u32x2 v0 = *(const u32x2*)vp; u32x2 v1 = *(const u32x2*)(vp + 16);
      union { unsigned u[4]; bf16x8 f; } vf;
      vf.u[0] = v0.x; vf.u[1] = v0.y; vf.u[2] = v1.x; vf.u[3] = v1.y;
      O[dt] = mfma16(vf.f, pf.f, O[dt]);
    }
  }
  const float inv = 1.f / sum; float ss = 0.f;
#pragma unroll
  for (int dt = 0; dt < 4; ++dt) {
    float o[4];
#pragma unroll
    for (int e = 0; e < 4; ++e) { o[e] = O[dt][e] * inv; ss += o[e] * o[e]; }
    const u32x2 sgv = *(const u32x2*)(P.z2 + qtok * 1536 + 1024 + hd * 64 + 16 * dt + 4 * g);
    *(u32x2*)(P.z2 + qtok * 1536 + hd * 64 + 16 * dt + 4 * g) = mk2(pack2(o[0] * lo2f(sgv.x), o[1] * hi2f(sgv.x)), pack2(o[2] * lo2f(sgv.y), o[3] * hi2f(sgv.y)));
  }
  ss += __shfl_xor(ss, 16); ss += __shfl_xor(ss, 32);
  if (g == 0) P.ssqA[qtok * 8 + hd] = ss;
  __syncthreads();
}

__device__ void phase_p2(const Params& P, int layer, int bid, int nb, char* lds, int what) {
  const bool attn_first = (what == 3) && (bid >= (nb >> 1));
  if (attn_first) for (int a = bid; a < 6144; a += nb) attn_unit(P, layer, a, lds);
  if (what & 1) for (int u = bid; u < 1536; u += nb) {
    if (u < 1024) conv_unit<8192, 1>(P, layer, 0, u & 511, u >> 9, lds);
    else conv_unit<4096, 2>(P, layer, 1, u - 1024, 0, lds);
  }
  if ((what & 2) && !attn_first) for (int a = bid; a < 6144; a += nb) attn_unit(P, layer, a, lds);
}

__device__ void p3_tile(const Params& P, int layer, int mt, int nt, char* lds) {
  const int tid = opaque_tid(), lane = tid & 63, wave = tid >> 6;
  const int tok0 = mt * 128, n0 = nt * 128;
  const unsigned short* wsrc = P.woutT + ((long)layer * 1024 + n0) * 1024;
  const float* xres = (layer == 0) ? ((tok0 < NPTOK) ? P.xp + (long)tok0 * 1024 : P.xs + (long)(tok0 - NPTOK) * 1024)
                                   : P.out + (long)tok0 * 1024;
  char* As = lds; char* Bs = lds + 20480;
  float* red = (float*)(lds + 36864); float* rh = (float*)(lds + 38912); float* ra = (float*)(lds + 39424);
  if (tid < 128) {
    const f32x4* sp = (const f32x4*)(P.ssqA + (long)(tok0 + tid) * 8);
    f32x4 s0 = sp[0], s1 = sp[1];
    float t = s0.x + s0.y + s0.z + s0.w + s1.x + s1.y + s1.z + s1.w;
    ra[tid] = rsqrtf(t * (1.f / 512.f) + EPSV);
  }
  const int wp = wave >> 1, wq = wave & 1;
  const int r8 = tid >> 3, ch = tid & 7;
  const int kr = tid >> 4, tc = tid & 15;
  f32x16 acc[2][2];
#pragma unroll
  for (int i = 0; i < 2; ++i)
#pragma unroll
    for (int j = 0; j < 2; ++j)
#pragma unroll
      for (int e = 0; e < 16; ++e) acc[i][j][e] = 0.f;
  u32x4 yv[4], gv[4], bv[4];
  const unsigned hy_off = (unsigned)(((512 + kr) * NTOK + tok0 + 8 * tc) * 2);
  const unsigned yg_off = hy_off + (unsigned)(512u * NTOK * 2u);
  const unsigned at_off = (unsigned)(((tok0 + r8) * 1536 + 8 * ch) * 2);
  const unsigned b_off = (unsigned)((r8 * 1024 + ch * 8) * 2);
#pragma unroll
  for (int i = 0; i < 4; ++i) {
    yv[i] = ldg16(P.zT, hy_off + (unsigned)i * (16u * NTOK * 2u));
    gv[i] = ldg16(P.zT, yg_off + (unsigned)i * (16u * NTOK * 2u));
    bv[i] = ldg16(wsrc, b_off + (unsigned)i * 65536u);
  }
  {
    float ssh[8];
#pragma unroll
    for (int e = 0; e < 8; ++e) ssh[e] = 0.f;
    for (int ks = 0; ks < 8; ++ks) {
#pragma unroll
      for (int i = 0; i < 4; ++i) {
        float y[8];
        unpack8(yv[i], y);
#pragma unroll
        for (int e = 0; e < 8; ++e) ssh[e] += y[e] * y[e];
        *(u32x4*)(As + (kr + 16 * i) * 320 + tc * 16) = gv[i];
        *(u32x4*)(Bs + swz_off(r8 + 32 * i, ch)) = bv[i];
      }
      __syncthreads();
      if (ks < 7) {
#pragma unroll
        for (int i = 0; i < 4; ++i) {
          yv[i] = ldg16(P.zT, hy_off + (unsigned)(ks + 1) * (64u * NTOK * 2u) + (unsigned)i * (16u * NTOK * 2u));
          gv[i] = ldg16(P.zT, yg_off + (unsigned)(ks + 1) * (64u * NTOK * 2u) + (unsigned)i * (16u * NTOK * 2u));
        }
      } else {
#pragma unroll
        for (int i = 0; i < 4; ++i) gv[i] = ldg16(P.z2, at_off + (unsigned)i * (32u * 1536u * 2u));
      }
#pragma unroll
      for (int i = 0; i < 4; ++i) bv[i] = ldg16(wsrc, b_off + (unsigned)(ks + 1) * 128u + (unsigned)i * 65536u);
#pragma unroll
      for (int kk = 0; kk < 4; ++kk) {
        bf16x8 a[2], b[2];
#pragma unroll
        for (int i = 0; i < 2; ++i) {
          const int tb = 64 * wp + 32 * i;
          const int l16 = lane & 15;
          const int krow = 16 * kk + 8 * (lane >> 5) + (l16 >> 2);
          const int tcol = tb + 16 * ((lane >> 4) & 1) + 4 * (l16 & 3);
          lds_cptr ap = (lds_cptr)As + krow * 320 + tcol * 2;
          s16x4 lo = __builtin_bit_cast(s16x4, __builtin_amdgcn_ds_read_tr16_b64_v4i16((__attribute__((address_space(3))) v4i16_t*)ap));
          s16x4 hi = __builtin_bit_cast(s16x4, __builtin_amdgcn_ds_read_tr16_b64_v4i16((__attribute__((address_space(3))) v4i16_t*)(ap + 4 * 320)));
          a[i] = (bf16x8){lo[0], lo[1], lo[2], lo[3], hi[0], hi[1], hi[2], hi[3]};
        }
#pragma unroll
        for (int j = 0; j < 2; ++j) b[j] = *(const bf16x8*)(Bs + swz_off(64 * wq + 32 * j + (lane & 31), 2 * kk + (lane >> 5)));
#pragma unroll
        for (int i = 0; i < 2; ++i)
#pragma unroll
          for (int j = 0; j < 2; ++j) acc[i][j] = mfma32(a[i], b[j], acc[i][j]);
      }
      __syncthreads();
    }
#pragma unroll
    for (int e = 0; e < 8; ++e) {
      float s_ = ssh[e];
      s_ += __shfl_xor(s_, 16); s_ += __shfl_xor(s_, 32);
      if (lane < 16) red[wave * 128 + 8 * tc + e] = s_;
    }
  }
  __syncthreads();
  if (tid < 128) rh[tid] = rsqrtf((red[tid] + red[128 + tid] + red[256 + tid] + red[384 + tid]) * (1.f / 512.f) + EPSV) / ra[tid];
  __syncthreads();
#pragma unroll
  for (int i = 0; i < 2; ++i)
#pragma unroll
    for (int e = 0; e < 16; ++e) {
      const float sc = rh[64 * wp + 32 * i + (e & 3) + 8 * (e >> 2) + 4 * (lane >> 5)];
      acc[i][0][e] *= sc; acc[i][1][e] *= sc;
    }
  for (int ks = 8; ks < 16; ++ks) {
#pragma unroll
    for (int i = 0; i < 4; ++i) {
      *(u32x4*)(As + swz_off(r8 + 32 * i, ch)) = gv[i];
      *(u32x4*)(Bs + swz_off(r8 + 32 * i, ch)) = bv[i];
    }
    __syncthreads();
    if (ks < 15) {
#pragma unroll
      for (int i = 0; i < 4; ++i) {
        gv[i] = ldg16(P.z2, at_off + (unsigned)(ks - 7) * 128u + (unsigned)i * (32u * 1536u * 2u));
        bv[i] = ldg16(wsrc, b_off + (unsigned)(ks + 1) * 128u + (unsigned)i * 65536u);
      }
    }
#pragma unroll
    for (int kk = 0; kk < 4; ++kk) {
      bf16x8 a[2], b[2];
#pragma unroll
      for (int i = 0; i < 2; ++i) a[i] = *(const bf16x8*)(As + swz_off(64 * wp + 32 * i + (lane & 31), 2 * kk + (lane >> 5)));
#pragma unroll
      for (int j = 0; j < 2; ++j) b[j] = *(const bf16x8*)(Bs + swz_off(64 * wq + 32 * j + (lane & 31), 2 * kk + (lane >> 5)));
#pragma unroll
      for (int i = 0; i < 2; ++i)
#pragma unroll
        for (int j = 0; j < 2; ++j) acc[i][j] = mfma32(a[i], b[j], acc[i][j]);
    }
    __syncthreads();
  }
#pragma unroll
  for (int i = 0; i < 2; ++i)
#pragma unroll
    for (int j = 0; j < 2; ++j) {
      const int n = n0 + 64 * wq + 32 * j + (lane & 31);
      const unsigned eoff = (unsigned)(((64 * wp + 32 * i + 4 * (lane >> 5)) * 1024 + n) * 4);
      float* outb = P.out + (long)tok0 * 1024;
#pragma unroll
      for (int g4 = 0; g4 < 4; ++g4) {
        float xr[4];
#pragma unroll
        for (int e = 0; e < 4; ++e) xr[e] = *(const float*)((const char*)xres + (eoff + (unsigned)(g4 * 8 + e) * 4096u));
#pragma unroll
        for (int e = 0; e < 4; ++e)
          *(float*)((char*)outb + (eoff + (unsigned)(g4 * 8 + e) * 4096u)) =
              xr[e] + acc[i][j][4 * g4 + e] * ra[64 * wp + 32 * i + 8 * g4 + 4 * (lane >> 5) + e];
      }
    }
  __syncthreads();
}

__device__ void phase_p3(const Params& P, int layer, int bid, int nb, char* lds) {
  for (int v = bid; v < 3072; v += nb) {
    int wv = v >> 9, within = v & 511, x = within & 7, idx = within >> 3;
    int mt = wv * 64 + x * 8 + (idx >> 3);
    int nt = idx & 7;
    p3_tile(P, layer, mt, nt, lds);
  }
}

__device__ __forceinline__ void run_phase(const Params& P, int ph, int bid, int nb, char* lds) {
  switch (ph) {
    case 0: phase_prep(P, bid, nb, lds); break;
    case 1: phase_p1(P, 0, bid, nb, lds, 0); break;
    case 2: phase_p2(P, 0, bid, nb, lds, 3); break;
    case 3: phase_p3(P, 0, bid, nb, lds); break;
    case 4: phase_p1(P, 1, bid, nb, lds, 0); break;
    case 5: phase_p2(P, 1, bid, nb, lds, 3); break;
    case 6: phase_p3(P, 1, bid, nb, lds); break;
  }
}

#if MULTI
__global__ void __launch_bounds__(256, 2) phase_kernel(Params P, int ph) {
  __shared__ __attribute__((aligned(16))) char lds[LDS_BYTES];
  run_phase(P, ph, blockIdx.x, gridDim.x, lds);
}
#else
__global__ void __launch_bounds__(256, 2) mega_kernel(Params P) {
  __shared__ __attribute__((aligned(16))) char lds[LDS_BYTES];
  cg::grid_group grid = cg::this_grid();
  const int bid = blockIdx.x, nb = gridDim.x;
#pragma unroll 1
  for (int st = 0; st < NSTEPS; ++st) {
    const int ph = (int)((PROG >> (4 * st)) & 15ull);
    const int layer = (ph >= 4 && ph <= 6) ? 1 : 0;
    const int sub = ph == 0 ? 0 : (ph <= 6 ? ((ph - 1) % 3 + 1) : ph - 3);
    switch (sub) {
      case 0: phase_prep(P, bid, nb, lds); break;
      case 1: phase_p1(P, layer, bid, nb, lds, 0); break;
      case 6: case 7: case 8: phase_p1(P, 0, bid, nb, lds, sub - 5); break;
      case 2: phase_p2(P, layer, bid, nb, lds, 3); break;
      case 3: phase_p3(P, layer, bid, nb, lds); break;
      case 4: phase_p2(P, layer, bid, nb, lds, 1); break;
      case 5: phase_p2(P, layer, bid, nb, lds, 2); break;
    }
    if (st < NSTEPS - 1) grid.sync();
  }
}
#endif

extern "C" void kernel_launch(void* const* d_in, const int* in_sizes, int n_in, void* d_out, int out_size,
                              void* d_ws, size_t ws_size, hipStream_t stream) {
  Params P{};
  P.xp = (const float*)d_in[0]; P.xs = (const float*)d_in[1];
  P.norm_g = (const float*)d_in[2]; P.w_in = (const float*)d_in[3]; P.conv_w = (const float*)d_in[4];
  P.conv_b = (const float*)d_in[5]; P.f_w1 = (const float*)d_in[6]; P.f_b1 = (const float*)d_in[7];
  P.f_fr1 = (const float*)d_in[8]; P.f_w2 = (const float*)d_in[9]; P.f_b2 = (const float*)d_in[10];
  P.f_fr2 = (const float*)d_in[11]; P.f_w3 = (const float*)d_in[12]; P.hy_bias = (const float*)d_in[13];
  P.qn_g = (const float*)d_in[14]; P.kn_g = (const float*)d_in[15]; P.rpb = (const float*)d_in[16];
  P.on_hy = (const float*)d_in[17]; P.on_att = (const float*)d_in[18]; P.w_out = (const float*)d_in[19];
  P.out = (float*)d_out;
  char* ws = (char*)d_ws;
  size_t off = 0;
  P.zT = (unsigned short*)(ws + off); off += (size_t)2560 * NTOK * 2;
  P.z2 = (unsigned short*)(ws + off); off += (size_t)NTOK * 1536 * 2;
  P.filt = (unsigned short*)(ws + off); off += (size_t)2 * 512 * 24576 * 2;
  P.winT = (unsigned short*)(ws + off); off += (size_t)2 * 4096 * 1024 * 2;
  P.woutT = (unsigned short*)(ws + off); off += (size_t)2 * 1024 * 1024 * 2;
  P.ssqA = (float*)(ws + off); off += (size_t)NTOK * 8 * 4;
  P.rstd1 = (float*)(ws + off); off += (size_t)NTOK * 4;
  P.xb1 = (unsigned short*)d_out;
  if (off > ws_size) { fprintf(stderr, "workspace too small: need %zu have %zu\n", off, ws_size); return; }
#if MULTI
  for (int ph = 0; ph < 7; ++ph) phase_kernel<<<512, 256, 0, stream>>>(P, ph);
#else
  static int grid_blocks = 0;
  if (!grid_blocks) {
    int dev = 0, cus = 0, per_cu = 0;
    hipGetDevice(&dev);
    hipDeviceGetAttribute(&cus, hipDeviceAttributeMultiprocessorCount, dev);
    hipOccupancyMaxActiveBlocksPerMultiprocessor(&per_cu, mega_kernel, 256, 0);
    if (per_cu > 2) per_cu = 2;
    grid_blocks = cus * per_cu;
  }
  void* args[] = {&P};
  hipError_t e = hipLaunchCooperativeKernel((void*)mega_kernel, dim3(grid_blocks), dim3(256), args, 0, stream);
  if (e != hipSuccess) fprintf(stderr, "cooperative launch failed: %s (grid %d)\n", hipGetErrorString(e), grid_blocks);
#endif
}
```

```cpp
#include <hip/hip_runtime.h>
#include <hip/hip_cooperative_groups.h>
#include <stdint.h>
#include <stdio.h>
namespace cg = cooperative_groups;

#ifndef MULTI
#define MULTI 0
#endif

typedef __attribute__((ext_vector_type(8))) short bf16x8;
typedef __attribute__((ext_vector_type(4))) short s16x4;
typedef __attribute__((ext_vector_type(16))) float f32x16;
typedef __attribute__((ext_vector_type(4))) float f32x4;
typedef short v4i16_t __attribute__((ext_vector_type(4)));
typedef __attribute__((ext_vector_type(4))) unsigned int u32x4;
typedef __attribute__((ext_vector_type(2))) unsigned int u32x2;
typedef __attribute__((address_space(3))) const char* lds_cptr;

#define NTOK 49152
#define NPTOK 32768
#define EPSV 1e-6f
#define LOG2E 1.4426950408889634f
#define LDS_BYTES 69760
#ifndef PROG
#define PROG 0x6543210ull
#define NSTEPS 7
#endif

struct Params {
  const float* xp; const float* xs;
  const float* norm_g; const float* w_in; const float* conv_w; const float* conv_b;
  const float* f_w1; const float* f_b1; const float* f_fr1; const float* f_w2; const float* f_b2;
  const float* f_fr2; const float* f_w3; const float* hy_bias; const float* qn_g; const float* kn_g;
  const float* rpb; const float* on_hy; const float* on_att; const float* w_out;
  float* out;
  unsigned short* zT;
  unsigned short* z2;
  unsigned short* filt;
  unsigned short* winT;
  unsigned short* woutT;
  float* ssqA;
  unsigned short* xb1;
  float* rstd1;
  unsigned* bar;
};

__device__ __forceinline__ int opaque_tid() { int t = threadIdx.x; asm volatile("" : "+v"(t)); return t; }
__device__ __forceinline__ unsigned short f2bf(float f) {
  unsigned int u = __float_as_uint(f);
  u += 0x7fffu + ((u >> 16) & 1u);
  return (unsigned short)(u >> 16);
}
__device__ __forceinline__ float bf2f(unsigned short h) { return __uint_as_float(((unsigned int)h) << 16); }
typedef __attribute__((ext_vector_type(2))) float f32x2_t;
typedef __attribute__((ext_vector_type(2))) __bf16 bf16x2_t;
__device__ __forceinline__ unsigned int pack2(float a, float b) { f32x2_t v = {a, b}; return __builtin_bit_cast(unsigned int, __builtin_convertvector(v, bf16x2_t)); }
__device__ __forceinline__ unsigned int pack2t(float a, float b) { return pack2(a, b); }
__device__ __forceinline__ float lo2f(unsigned int u) { return __uint_as_float(u << 16); }
__device__ __forceinline__ float hi2f(unsigned int u) { return __uint_as_float(u & 0xffff0000u); }
__device__ __forceinline__ float silu_f(float g) { return g / (1.f + __expf(-g)); }
__device__ __forceinline__ int swz_off(int row, int ch) { return row * 128 + ((ch ^ ((row >> 1) & 7)) << 4); }

__device__ __forceinline__ f32x16 mfma32(bf16x8 a, bf16x8 b, f32x16 c) { return __builtin_amdgcn_mfma_f32_32x32x16_bf16(a, b, c, 0, 0, 0); }
__device__ __forceinline__ f32x4 mfma16(bf16x8 a, bf16x8 b, f32x4 c) { return __builtin_amdgcn_mfma_f32_16x16x32_bf16(a, b, c, 0, 0, 0); }

__device__ __forceinline__ u32x4 mk4(unsigned a, unsigned b, unsigned c, unsigned d) { u32x4 r = {a, b, c, d}; return r; }
__device__ __forceinline__ u32x2 mk2(unsigned a, unsigned b) { u32x2 r = {a, b}; return r; }
__device__ __forceinline__ bf16x8 u4_to_frag(u32x4 v) {
  union { u32x4 u; bf16x8 f; } x; x.u = v; return x.f;
}

__device__ void filter_unit(const Params& P, int u, char* lds) {
  const int tid = opaque_tid(), lane = tid & 63;
  const int wave = __builtin_amdgcn_readfirstlane(tid >> 6);
  const int l = u / 192; const int rr = u % 192;
  const int set = rr < 128 ? 0 : 1; const int pch = set ? rr - 128 : rr;
  const int L = set ? 4096 : 8192;
  const int p = pch * 64 + lane;
  const float t01 = (float)p / (float)(L - 1);
  const float pl = (float)p / (float)L;
  float* zs = (float*)lds;
  float* h1s = zs + 33 * 64;
  char* Hq = lds + 24832;
  char* Ws = lds + 33024;
  if (wave == 0) {
    zs[lane] = t01;
#pragma unroll
    for (int k = 0; k < 16; ++k) {
      float fk = 1e-4f + (float)k * ((15.f - 1e-4f) / 15.f);
      float tr = fk * pl; tr -= floorf(tr);
      zs[(1 + k) * 64 + lane] = __builtin_amdgcn_cosf(tr);
      zs[(17 + k) * 64 + lane] = -__builtin_amdgcn_sinf(tr);
    }
  }
  __syncthreads();
  const float* w1 = P.f_w1 + l * 33 * 64; const float* b1 = P.f_b1 + l * 64; const float* fr1 = P.f_fr1 + l * 64;
  const float* w2 = P.f_w2 + l * 64 * 64; const float* b2 = P.f_b2 + l * 64; const float* fr2 = P.f_fr2 + l * 64;
  const float* w3 = P.f_w3 + l * 64 * 1024;
  const int j0 = wave * 16;
  {
    float acc[16];
#pragma unroll
    for (int j = 0; j < 16; ++j) acc[j] = b1[j0 + j];
#pragma unroll 3
    for (int i = 0; i < 33; ++i) {
      const float zv = zs[i * 64 + lane];
#pragma unroll
      for (int j = 0; j < 16; ++j) acc[j] += zv * w1[i * 64 + j0 + j];
    }
#pragma unroll
    for (int j = 0; j < 16; ++j) h1s[(j0 + j) * 64 + lane] = __builtin_amdgcn_sinf(fr1[j0 + j] * acc[j] * 0.15915494309189535f);
  }
  __syncthreads();
  {
    float acc[16];
#pragma unroll
    for (int j = 0; j < 16; ++j) acc[j] = b2[j0 + j];
#pragma unroll 4
    for (int i = 0; i < 64; ++i) {
      const float hv = h1s[i * 64 + lane];
#pragma unroll
      for (int j = 0; j < 16; ++j) acc[j] += hv * w2[i * 64 + j0 + j];
    }
    float hh[16];
#pragma unroll
    for (int j = 0; j < 16; ++j) hh[j] = __builtin_amdgcn_sinf(fr2[j0 + j] * acc[j] * 0.15915494309189535f);
    *(u32x4*)(Hq + swz_off(lane, 2 * wave)) = mk4(pack2t(hh[0], hh[1]), pack2t(hh[2], hh[3]), pack2t(hh[4], hh[5]), pack2t(hh[6], hh[7]));
    *(u32x4*)(Hq + swz_off(lane, 2 * wave + 1)) = mk4(pack2t(hh[8], hh[9]), pack2t(hh[10], hh[11]), pack2t(hh[12], hh[13]), pack2t(hh[14], hh[15]));
  }
  const float mind = -3.0701134573253943f, maxd = -15.350567286626972f;
  const int setoff = set ? 16384 : 0;
  const int qpos0 = pch * 64 + (lane & 31);
  for (int nc = 0; nc < 8; ++nc) {
    const int n0 = nc * 128;
    __syncthreads();
#pragma unroll
    for (int i = 0; i < 4; ++i) {
      const int id = tid + 256 * i; const int krow = id >> 4, c8 = id & 15;
      const float* src = w3 + krow * 1024 + n0 + 8 * c8;
      f32x4 a0 = *(const f32x4*)src, a1 = *(const f32x4*)(src + 4);
      *(u32x4*)(Ws + krow * 320 + c8 * 16) = mk4(pack2(a0.x, a0.y), pack2(a0.z, a0.w), pack2(a1.x, a1.y), pack2(a1.z, a1.w));
    }
    __syncthreads();
    f32x16 acc[2];
#pragma unroll
    for (int j = 0; j < 2; ++j) {
#pragma unroll
      for (int e = 0; e < 16; ++e) acc[j][e] = 0.f;
    }
#pragma unroll
    for (int kk = 0; kk < 4; ++kk) {
      const int l16 = lane & 15;
      const int krow = 16 * kk + 8 * (lane >> 5) + (l16 >> 2);
      const int ncol = 32 * wave + 16 * ((lane >> 4) & 1) + 4 * (l16 & 3);
      lds_cptr ap = (lds_cptr)Ws + krow * 320 + ncol * 2;
      s16x4 lo = __builtin_bit_cast(s16x4, __builtin_amdgcn_ds_read_tr16_b64_v4i16((__attribute__((address_space(3))) v4i16_t*)ap));
      s16x4 hi = __builtin_bit_cast(s16x4, __builtin_amdgcn_ds_read_tr16_b64_v4i16((__attribute__((address_space(3))) v4i16_t*)(ap + 4 * 320)));
      bf16x8 a = (bf16x8){lo[0], lo[1], lo[2], lo[3], hi[0], hi[1], hi[2], hi[3]};
#pragma unroll
      for (int j = 0; j < 2; ++j) {
        bf16x8 b = *(const bf16x8*)(Hq + swz_off(32 * j + (lane & 31), 2 * kk + (lane >> 5)));
        acc[j] = mfma32(a, b, acc[j]);
      }
    }
#pragma unroll
    for (int j = 0; j < 2; ++j) {
      const int pos = qpos0 + 32 * j;
      const float tq = (float)pos / (float)(L - 1);
#pragma unroll
      for (int e = 0; e < 16; ++e) {
        const int col = n0 + 32 * wave + (e & 3) + 8 * (e >> 2) + 4 * (lane >> 5);
        const float delta = fabsf(mind + (float)col * ((maxd - mind) / 1023.f));
        const float val = acc[j][e] * __expf(-tq * delta);
        const int c = col & 511;
        unsigned short* dst = P.filt + ((long)(l * 512 + c)) * 24576 + setoff;
        if (col < 512) dst[L - pos] = f2bf(val);
        else { if (pos > 0) dst[L + pos] = f2bf(val); else dst[0] = 0; }
      }
    }
  }
  __syncthreads();
}

__device__ void phase_prep(const Params& P, int bid, int nb, char* lds) {
  const int tid = opaque_tid();
  const long gt = (long)bid * 256 + tid, gs = (long)nb * 256;
  for (long i = gt; i < 2L * 128 * 4096; i += gs) {
    int n = (int)(i & 4095); int kc = (int)((i >> 12) & 127); int l = (int)(i >> 19);
    const float* w = P.w_in + ((long)l * 1024 + kc * 8) * 4096 + n;
    const float* g = P.norm_g + l * 1024 + kc * 8;
    unsigned int o[4];
#pragma unroll
    for (int j = 0; j < 4; ++j) o[j] = pack2(w[(long)(2 * j) * 4096] * g[2 * j], w[(long)(2 * j + 1) * 4096] * g[2 * j + 1]);
    *(u32x4*)(P.winT + ((long)l * 4096 + n) * 1024 + kc * 8) = mk4(o[0], o[1], o[2], o[3]);
  }
  for (long i = gt; i < 2L * 128 * 1024; i += gs) {
    int n = (int)(i & 1023); int kc = (int)((i >> 10) & 127); int l = (int)(i >> 17);
    const float* w = P.w_out + ((long)l * 1024 + kc * 8) * 1024 + n;
    const float* g = (kc < 64) ? (P.on_hy + l * 512 + kc * 8) : (P.on_att + l * 512 + (kc - 64) * 8);
    unsigned int o[4];
#pragma unroll
    for (int j = 0; j < 4; ++j) o[j] = pack2(w[(long)(2 * j) * 1024] * g[2 * j], w[(long)(2 * j + 1) * 1024] * g[2 * j + 1]);
    *(u32x4*)(P.woutT + ((long)l * 1024 + n) * 1024 + kc * 8) = mk4(o[0], o[1], o[2], o[3]);
  }
  {
    const int lane = tid & 63; const int gw = bid * 4 + (tid >> 6);
    for (int row = gw; row < NTOK; row += nb * 4) {
      const float* src = (row < NPTOK) ? P.xp + (long)row * 1024 : P.xs + (long)(row - NPTOK) * 1024;
      unsigned short* dst = P.xb1 + (long)row * 1024;
      float ss = 0.f;
#pragma unroll
      for (int i = 0; i < 4; ++i) {
        const f32x4 a = *(const f32x4*)(src + (i * 64 + lane) * 4);
        ss += a.x * a.x + a.y * a.y + a.z * a.z + a.w * a.w;
        *(u32x2*)(dst + (i * 64 + lane) * 4) = mk2(pack2(a.x, a.y), pack2(a.z, a.w));
      }
      ss += __shfl_xor(ss, 32); ss += __shfl_xor(ss, 16); ss += __shfl_xor(ss, 8);
      ss += __shfl_xor(ss, 4); ss += __shfl_xor(ss, 2); ss += __shfl_xor(ss, 1);
      if (lane == 0) P.rstd1[row] = rsqrtf(ss * (1.f / 1024.f) + EPSV);
    }
  }
  for (int u = bid; u < 384; u += nb) filter_unit(P, u, lds);
}

__device__ __forceinline__ u32x4 ldg16(const void* base, unsigned off) { return *(const u32x4*)((const char*)base + off); }

__device__ __forceinline__ void unpack8(u32x4 v, float* f) {
  f[0] = lo2f(v.x); f[1] = hi2f(v.x); f[2] = lo2f(v.y); f[3] = hi2f(v.y);
  f[4] = lo2f(v.z); f[5] = hi2f(v.z); f[6] = lo2f(v.w); f[7] = hi2f(v.w);
}

__device__ void p1_tile(const Params& P, int layer, int mt, int nt, char* lds, int variant) {
  const int tid = opaque_tid(), lane = tid & 63, wave = tid >> 6;
  const int tok0 = mt * 128, n0 = nt * 128;
  bool swap; int dst0; int mode = 0;
  const bool gate = (n0 >= 1536 && n0 < 2048) || (n0 >= 3584);
  if (n0 < 1536) { swap = false; dst0 = n0; }
  else if (n0 < 2048) { swap = false; dst0 = 2048 + (n0 - 1536); }
  else if (n0 < 2560) { swap = true; dst0 = n0 - 2048; mode = 1; }
  else if (n0 < 3072) { swap = true; dst0 = 512 + (n0 - 2560); mode = 2; }
  else if (n0 < 3584) { swap = false; dst0 = 1536 + (n0 - 3072); }
  else { swap = true; dst0 = 1024 + (n0 - 3584); }
  const float* xsrc = (layer == 0) ? ((tok0 < NPTOK) ? P.xp + (long)tok0 * 1024 : P.xs + (long)(tok0 - NPTOK) * 1024)
                                   : P.out + (long)tok0 * 1024;
  const unsigned short* wsrc = P.winT + ((long)layer * 4096 + n0) * 1024;
  char* S = lds; float* rs = (float*)(lds + 65536);
  const int wp = wave >> 1, wq = wave & 1;
  f32x16 acc[2][2];
#pragma unroll
  for (int i = 0; i < 2; ++i)
#pragma unroll
    for (int j = 0; j < 2; ++j)
#pragma unroll
      for (int e = 0; e < 16; ++e) acc[i][j][e] = 0.f;
  const int r8 = tid >> 3, ch = tid & 7;
  const int r16 = tid >> 4, c4 = tid & 15;
  f32x4 av[8]; u32x4 bv[4]; float ssq[8];
#pragma unroll
  for (int i = 0; i < 8; ++i) ssq[i] = 0.f;
  const unsigned a_off = (unsigned)((r16 * 1024 + c4 * 4) * 4);
  const unsigned b_off = (unsigned)((r8 * 1024 + ch * 8) * 2);
#define P1_LOAD(ks_) do { \
    _Pragma("unroll") for (int i = 0; i < 8; ++i) av[i] = *(const f32x4*)((const char*)xsrc + (a_off + (unsigned)i * 65536u + (unsigned)(ks_) * 256u)); \
    _Pragma("unroll") for (int i = 0; i < 4; ++i) bv[i] = ldg16(wsrc, b_off + (unsigned)i * 65536u + (unsigned)(ks_) * 128u); } while (0)
#define P1_STORE(buf_) do { \
    char* As_ = lds + (buf_) * 32768; char* Bs_ = As_ + 16384; \
    _Pragma("unroll") for (int i = 0; i < 8; ++i) { \
      f32x4 a0 = av[i]; \
      ssq[i] += a0.x * a0.x + a0.y * a0.y + a0.z * a0.z + a0.w * a0.w; \
      const int row_ = r16 + 16 * i; \
      *(u32x2*)(As_ + row_ * 128 + (((c4 >> 1) ^ ((row_ >> 1) & 7)) << 4) + (c4 & 1) * 8) = mk2(pack2(a0.x, a0.y), pack2(a0.z, a0.w)); } \
    _Pragma("unroll") for (int i = 0; i < 4; ++i) *(u32x4*)(Bs_ + swz_off(r8 + 32 * i, ch)) = bv[i]; } while (0)
  if (layer == 0) {
    const unsigned short* asrc = P.xb1 + (long)tok0 * 1024;
    unsigned goff[4], loff[4];
#pragma unroll
    for (int i = 0; i < 4; ++i) {
      const int m = wave * 4 + i; const int row = 8 * m + (lane >> 3); const int cc = (lane & 7) ^ ((row >> 1) & 7);
      goff[i] = (unsigned)(row * 2048 + cc * 16); loff[i] = (unsigned)(m * 1024 + lane * 16);
    }
#define P1_DMA(ks_, buf_) do { _Pragma("unroll") for (int i = 0; i < 4; ++i) { \
      __builtin_amdgcn_global_load_lds((const unsigned*)((const char*)asrc + goff[i] + (unsigned)(ks_) * 128u), (unsigned*)(lds + (buf_) * 32768 + loff[i]), 16, 0, 0); \
      __builtin_amdgcn_global_load_lds((const unsigned*)((const char*)wsrc + goff[i] + (unsigned)(ks_) * 128u), (unsigned*)(lds + (buf_) * 32768 + 16384 + loff[i]), 16, 0, 0); } } while (0)
    P1_DMA(0, 0);
    if (tid < 128) rs[tid] = P.rstd1[tok0 + tid];
    for (int ks = 0; ks < 16; ++ks) {
      const int cur = ks & 1;
      __syncthreads();
      if (ks + 1 < 16) P1_DMA(ks + 1, cur ^ 1);
      const char* As = lds + cur * 32768; const char* Bs = As + 16384;
      const char* Pb = swap ? Bs : As; const char* Qb = swap ? As : Bs;
#pragma unroll
      for (int kk = 0; kk < 4; ++kk) {
        bf16x8 a[2], b[2];
#pragma unroll
        for (int i = 0; i < 2; ++i) a[i] = *(const bf16x8*)(Pb + swz_off(64 * wp + 32 * i + (lane & 31), 2 * kk + (lane >> 5)));
#pragma unroll
        for (int j = 0; j < 2; ++j) b[j] = *(const bf16x8*)(Qb + swz_off(64 * wq + 32 * j + (lane & 31), 2 * kk + (lane >> 5)));
#pragma unroll
        for (int i = 0; i < 2; ++i)
#pragma unroll
          for (int j = 0; j < 2; ++j) acc[i][j] = mfma32(a[i], b[j], acc[i][j]);
      }
    }
#undef P1_DMA
    __syncthreads();
  } else {
  P1_LOAD(0);
  P1_STORE(0);
  P1_LOAD(1);
  __syncthreads();
  for (int ks = 0; ks < 16; ++ks) {
    const int cur = ks & 1;
    if (ks + 1 < 16) P1_STORE(cur ^ 1);
    if (ks + 2 < 16 && !(variant & 1)) P1_LOAD(ks + 2);
    __builtin_amdgcn_sched_barrier(0);
    const char* As = lds + cur * 32768; const char* Bs = As + 16384;
    const char* Pb = swap ? Bs : As; const char* Qb = swap ? As : Bs;
#pragma unroll
    for (int kk = 0; kk < 4; ++kk) {
      bf16x8 a[2], b[2];
#pragma unroll
      for (int i = 0; i < 2; ++i) a[i] = *(const bf16x8*)(Pb + swz_off(64 * wp + 32 * i + (lane & 31), 2 * kk + (lane >> 5)));
#pragma unroll
      for (int j = 0; j < 2; ++j) b[j] = *(const bf16x8*)(Qb + swz_off(64 * wq + 32 * j + (lane & 31), 2 * kk + (lane >> 5)));
#pragma unroll
      for (int i = 0; i < 2; ++i)
#pragma unroll
        for (int j = 0; j < 2; ++j) acc[i][j] = mfma32(a[i], b[j], acc[i][j]);
    }
    __syncthreads();
  }
#undef P1_LOAD
#undef P1_STORE
#pragma unroll
  for (int i = 0; i < 8; ++i) {
    float s_ = ssq[i];
    s_ += __shfl_xor(s_, 1); s_ += __shfl_xor(s_, 2); s_ += __shfl_xor(s_, 4); s_ += __shfl_xor(s_, 8);
    if (c4 == 0) rs[r16 + 16 * i] = rsqrtf(s_ * (1.f / 1024.f) + EPSV);
  }
  __syncthreads();
  }
#pragma unroll
  for (int i = 0; i < 2; ++i)
#pragma unroll
    for (int j = 0; j < 2; ++j) {
      const int q = 64 * wq + 32 * j + (lane & 31);
#pragma unroll
      for (int g4 = 0; g4 < 4; ++g4) {
        const int p = 64 * wp + 32 * i + 8 * g4 + 4 * (lane >> 5);
        float v[4];
#pragma unroll
        for (int e = 0; e < 4; ++e) v[e] = acc[i][j][4 * g4 + e] * (swap ? rs[q] : rs[p + e]);
        if (gate) {
#pragma unroll
          for (int e = 0; e < 4; ++e) v[e] = v[e] * __builtin_amdgcn_rcpf(1.f + __expf(-v[e]));
        }
        *(u32x2*)(S + q * 272 + p * 2) = mk2(pack2(v[0], v[1]), pack2(v[2], v[3]));
      }
    }
  __syncthreads();
#pragma unroll
  for (int it = 0; it < 8; ++it) {
    const int id = tid + 256 * it; const int row = id >> 4, c16 = id & 15;
    u32x4 v = *(const u32x4*)(S + row * 272 + c16 * 16);
    if (variant & 2) continue;
    if (!swap) {
      *(u32x4*)(P.zT + (long)(dst0 + row) * NTOK + tok0 + c16 * 8) = v;
    } else {
      if (mode) {
        float f[8];
        f[0] = lo2f(v.x); f[1] = hi2f(v.x); f[2] = lo2f(v.y); f[3] = hi2f(v.y);
        f[4] = lo2f(v.z); f[5] = hi2f(v.z); f[6] = lo2f(v.w); f[7] = hi2f(v.w);
        float ss = 0.f;
#pragma unroll
        for (int e = 0; e < 8; ++e) ss += f[e] * f[e];
        ss += __shfl_xor(ss, 1); ss += __shfl_xor(ss, 2); ss += __shfl_xor(ss, 4);
        float sc = rsqrtf(ss * (1.f / 64.f) + EPSV);
        if (mode == 1) sc *= 0.125f * LOG2E;
        const float* g = (mode == 1 ? P.qn_g : P.kn_g) + layer * 64 + (c16 & 7) * 8;
#pragma unroll
        for (int e = 0; e < 8; ++e) f[e] *= sc * g[e];
        v = mk4(pack2(f[0], f[1]), pack2(f[2], f[3]), pack2(f[4], f[5]), pack2(f[6], f[7]));
      }
      *(u32x4*)(P.z2 + (long)(tok0 + row) * 1536 + dst0 + c16 * 8) = v;
    }
  }
  __syncthreads();
}

__device__ void phase_p1(const Params& P, int layer, int bid, int nb, char* lds, int variant) {
  for (int v = bid; v < 12288; v += nb) {
    int wv = v >> 9, within = v & 511, x = within & 7, idx = within >> 3;
    int mt = wv * 16 + (x >> 2) * 8 + (idx >> 3);
    int nt = (x & 3) * 8 + (idx & 7);
    p1_tile(P, layer, mt, nt, lds, variant);
  }
}

template <int L, int NBP>
__device__ void conv_unit(const Params& P, int layer, int set, int c, int bp0, char* lds) {
  constexpr int NB = L / 32, UB = (NB + 32) * 64, WPB = 4 / NBP, NSTEP = NB / 16 + 1;
  static_assert(NB / WPB == 64, "each wave owns 64 output blocks (4 N-tiles)");
  char* U = lds; char* F = lds + NBP * 2 * UB;
  const int tid = opaque_tid(), lane = tid & 63, wave = tid >> 6;
  const long setbase = (long)(set ? NPTOK : 0) + (long)(2 * bp0) * L;
  const unsigned short* x0r = P.zT + (long)c * NTOK + setbase;
  const unsigned short* x1r = P.zT + (long)(512 + c) * NTOK + setbase;
  const unsigned short* vr = P.zT + (long)(1024 + c) * NTOK + setbase;
  const float* cw = P.conv_w + layer * 3 * 1536; const float* cb = P.conv_b + layer * 1536;
  {
    const float w1a = cw[512 + c], w1b = cw[1536 + 512 + c], w1c = cw[3072 + 512 + c], b1 = cb[512 + c];
    const float wva = cw[1024 + c], wvb = cw[1536 + 1024 + c], wvc = cw[3072 + 1024 + c], bvv = cb[1024 + c];
#pragma unroll
    for (int pp = 0; pp < NBP; ++pp) {
      const int id = tid + 256 * pp; const int pb = id >> 7; const int rem = id & 127; const int side = rem >> 6; const int o = rem & 63;
      *(u32x4*)(U + pb * UB + (side ? (NB + 16) * 64 : 0) + o * 16) = mk4(0, 0, 0, 0);
    }
    for (int id = tid; id < NBP * 2 * L / 8; id += 256) {
      const int pb = id / (L / 8); const int t8 = (id % (L / 8)) * 8;
      const unsigned short* a = x1r + (long)pb * L + t8; const unsigned short* b = vr + (long)pb * L + t8;
      u32x4 xa = *(const u32x4*)a; u32x4 xb = *(const u32x4*)b;
      float xs[10], vs[10];
      xs[0] = t8 > 0 ? bf2f(a[-1]) : 0.f; xs[9] = (t8 + 8 < L) ? bf2f(a[8]) : 0.f;
      vs[0] = t8 > 0 ? bf2f(b[-1]) : 0.f; vs[9] = (t8 + 8 < L) ? bf2f(b[8]) : 0.f;
      unpack8(xa, xs + 1); unpack8(xb, vs + 1);
      float uu[8];
#pragma unroll
      for (int e = 0; e < 8; ++e) {
        float x1c = w1a * xs[e] + w1b * xs[e + 1] + w1c * xs[e + 2] + b1;
        float vc = wva * vs[e] + wvb * vs[e + 1] + wvc * vs[e + 2] + bvv;
        uu[e] = x1c * vc;
      }
      const int blk = (t8 >> 5) + 16; const int chunk = (t8 >> 3) & 3;
      *(u32x4*)(U + pb * UB + blk * 64 + ((chunk ^ ((blk >> 2) & 3)) << 4)) =
          mk4(pack2(uu[0], uu[1]), pack2(uu[2], uu[3]), pack2(uu[4], uu[5]), pack2(uu[6], uu[7]));
    }
    const unsigned short* fsrc = P.filt + ((long)(layer * 512 + c)) * 24576 + (set ? 16384 : 0);
    for (int id = tid; id < 2 * L / 8; id += 256) *(u32x4*)(F + id * 16) = *(const u32x4*)(fsrc + id * 8);
    if (tid < 8) *(u32x4*)(F + 2 * L * 2 + tid * 16) = mk4(0, 0, 0, 0);
  }
  __syncthreads();

  const int pw = wave / WPB;
  const int T0w = (wave % WPB) * 64;
  const int ii = lane & 31, h = lane >> 5;
  const int bb = (lane >> 4) & 1, mm = lane & 15;
  const char* Uw = U + (pw * 2 + bb) * UB;
  const int base0 = L - ii + 8 * h;
  const int wdw = base0 >> 1; const unsigned sh = (unsigned)(base0 & 1) * 16u;
  f32x16 acc[4];
#pragma unroll
  for (int r = 0; r < 4; ++r)
#pragma unroll
    for (int e = 0; e < 16; ++e) acc[r][e] = 0.f;
  bf16x8 Ar[4][2];
  unsigned raw[2][5];

#define LOADA_RAW(ptr_) do { const unsigned* fp_ = (const unsigned*)(ptr_); \
    _Pragma("unroll") for (int j_ = 0; j_ < 5; ++j_) { raw[0][j_] = fp_[j_]; raw[1][j_] = fp_[8 + j_]; } } while (0)
#define FIXA(dst_) do { _Pragma("unroll") for (int k_ = 0; k_ < 2; ++k_) { union { unsigned u[4]; bf16x8 f; } x_; \
    _Pragma("unroll") for (int j_ = 0; j_ < 4; ++j_) x_.u[j_] = __builtin_amdgcn_alignbit(raw[k_][j_ + 1], raw[k_][j_], sh); \
    (dst_)[k_] = x_.f; } } while (0)
#define LOADB(dst_, q_) do { (dst_)[0] = *(const bf16x8*)(ub0 + 1024 * (q_)); (dst_)[1] = *(const bf16x8*)(ub1 + 1024 * (q_)); } while (0)
#define MMAS(u_, B_) do { _Pragma("unroll") for (int r_ = 0; r_ < 4; ++r_) { \
    acc[r_] = mfma32(Ar[(r_ - (u_) + 4) & 3][0], (B_)[0], acc[r_]); \
    acc[r_] = mfma32(Ar[(r_ - (u_) + 4) & 3][1], (B_)[1], acc[r_]); } } while (0)

  for (int e = 0; e < 16; ++e) {
    const int sb0 = e - 15;
    const int D0 = T0w - sb0;
    const char* fa = F + 4 * wdw - 64 * D0;
    const int blk0 = sb0 + mm + 16; const int swz = (blk0 >> 2) & 3;
    const char* ub0 = Uw + blk0 * 64 + ((h ^ swz) << 4);
    const char* ub1 = Uw + blk0 * 64 + (((2 + h) ^ swz) << 4);
#pragma unroll
    for (int s_ = 1; s_ < 4; ++s_) { LOADA_RAW(fa - 1024 * s_); FIXA(Ar[s_]); }
    bf16x8 Bc[2], Bn[2];
    LOADA_RAW(fa); LOADB(Bc, 0);
    for (int Q = 0; Q < (NSTEP - 1) / 4; ++Q) {
      const char* fq = fa + 4096 * Q;
      const int q0 = 4 * Q;
      FIXA(Ar[0]); LOADA_RAW(fq + 1024); LOADB(Bn, q0 + 1); __builtin_amdgcn_sched_barrier(0);
      MMAS(0, Bc); __builtin_amdgcn_sched_barrier(0);
      FIXA(Ar[3]); LOADA_RAW(fq + 2048); LOADB(Bc, q0 + 2); __builtin_amdgcn_sched_barrier(0);
      MMAS(1, Bn); __builtin_amdgcn_sched_barrier(0);
      FIXA(Ar[2]); LOADA_RAW(fq + 3072); LOADB(Bn, q0 + 3); __builtin_amdgcn_sched_barrier(0);
      MMAS(2, Bc); __builtin_amdgcn_sched_barrier(0);
      FIXA(Ar[1]); LOADA_RAW(fq + 4096); LOADB(Bc, q0 + 4); __builtin_amdgcn_sched_barrier(0);
      MMAS(3, Bn); __builtin_amdgcn_sched_barrier(0);
    }
    FIXA(Ar[0]);
    MMAS(0, Bc);
  }
#undef LOADA_RAW
#undef FIXA
#undef LOADB
#undef MMAS
  {
    const float hb = P.hy_bias[layer * 512 + c];
    const float w0a = cw[c], w0b = cw[1536 + c], w0c = cw[3072 + c], b0 = cb[c];
    const long boff = (long)(pw * 2 + bb) * L;
    unsigned short* yout = P.zT + (long)(512 + c) * NTOK + setbase + boff;
    unsigned short* ygout = P.zT + (long)(1024 + c) * NTOK + setbase + boff;
    const unsigned short* sgr = P.zT + (long)(2048 + c) * NTOK + setbase + boff;
    const unsigned short* x0b = x0r + boff;
#pragma unroll
    for (int r = 0; r < 4; ++r) {
      const int t0 = T0w + 16 * r + mm; const int blk = t0 + 16;
#pragma unroll
      for (int g4 = 0; g4 < 4; ++g4) {
        const int t = t0 * 32 + 8 * g4 + 4 * h;
        u32x2 uv = *(const u32x2*)(Uw + blk * 64 + ((g4 ^ ((blk >> 2) & 3)) << 4) + 8 * h);
        const unsigned short* xp = x0b + t;
        u32x2 xv = *(const u32x2*)xp;
        float xs[6];
        xs[0] = t > 0 ? bf2f(xp[-1]) : 0.f; xs[5] = (t + 4 < L) ? bf2f(xp[4]) : 0.f;
        xs[1] = lo2f(xv.x); xs[2] = hi2f(xv.x); xs[3] = lo2f(xv.y); xs[4] = hi2f(xv.y);
        float us[4] = {lo2f(uv.x), hi2f(uv.x), lo2f(uv.y), hi2f(uv.y)};
        float o[4];
#pragma unroll
        for (int e = 0; e < 4; ++e) {
          float x0c = w0a * xs[e] + w0b * xs[e + 1] + w0c * xs[e + 2] + b0;
          float y = acc[r][4 * g4 + e] + hb * us[e];
          o[e] = x0c * y;
        }
        *(u32x2*)(yout + t) = mk2(pack2(o[0], o[1]), pack2(o[2], o[3]));
        const u32x2 sgv = *(const u32x2*)(sgr + t);
        *(u32x2*)(ygout + t) = mk2(pack2(o[0] * lo2f(sgv.x), o[1] * hi2f(sgv.x)), pack2(o[2] * lo2f(sgv.y), o[3] * hi2f(sgv.y)));
      }
    }
  }
  __syncthreads();
}

__device__ void attn_unit(const Params& P, int layer, int a, char* lds) {
  float* rp = (float*)lds;
  const int tid = opaque_tid(), lane = tid & 63, wave = tid >> 6;
  const int hd = a & 7, rowg = a >> 3;
  int rows, r;
  if (rowg < 512) { rows = 128; r = rowg & 127; } else { rows = 64; r = (rowg - 512) & 63; }
  const int rowbase = rowg - r;
  const int r0 = min(max(r - 4, 0), rows - 8);
  for (int i = tid; i < 465; i += 256) rp[i] = P.rpb[(layer * 8 + hd) * 465 + i] * LOG2E;
  __syncthreads();
  const int c0 = wave * 16; const int kc0 = min(max(c0 - 8, 0), 32);
  const int qi = lane & 15, g = lane >> 4;
  const long qtok = (long)rowg * 64 + c0 + qi;
  const unsigned short* qptr = P.z2 + qtok * 1536 + hd * 64 + 8 * g;
  const bf16x8 Qf0 = *(const bf16x8*)qptr, Qf1 = *(const bf16x8*)(qptr + 32);
  f32x4 S[16];
  const long bandtok = (long)(rowbase + r0) * 64;
#pragma unroll
  for (int T = 0; T < 16; ++T) {
    const int kr = T >> 1, half = T & 1;
    const long ktok = bandtok + kr * 64 + kc0 + 16 * half + qi;
    const unsigned short* kp = P.z2 + ktok * 1536 + 512 + hd * 64 + 8 * g;
    const bf16x8 K0 = *(const bf16x8*)kp, K1 = *(const bf16x8*)(kp + 32);
    f32x4 s = {0.f, 0.f, 0.f, 0.f};
    s = mfma16(K0, Qf0, s); s = mfma16(K1, Qf1, s);
    S[T] = s;
  }
  const int qc = c0 + qi; const int cs = min(max(qc - 8, 0), 48);
  float mx = -1e30f;
#pragma unroll
  for (int T = 0; T < 16; ++T) {
    const int kr = T >> 1, half = T & 1;
    const int ro = r0 + kr - r + 7;
#pragma unroll
    for (int e = 0; e < 4; ++e) {
      const int kc = kc0 + 16 * half + 4 * g + e;
      const bool valid = (kc >= cs) && (kc < cs + 16);
      const int idx = valid ? (ro * 31 + kc - qc + 15) : 0;
      float v = valid ? (S[T][e] + rp[idx]) : -1e30f;
      S[T][e] = v; mx = fmaxf(mx, v);
    }
  }
  mx = fmaxf(mx, __shfl_xor(mx, 16)); mx = fmaxf(mx, __shfl_xor(mx, 32));
  float sum = 0.f;
#pragma unroll
  for (int T = 0; T < 16; ++T)
#pragma unroll
    for (int e = 0; e < 4; ++e) { float p = exp2f(S[T][e] - mx); S[T][e] = p; sum += p; }
  sum += __shfl_xor(sum, 16); sum += __shfl_xor(sum, 32);
  f32x4 O[4];
#pragma unroll
  for (int dt = 0; dt < 4; ++dt) O[dt] = (f32x4){0.f, 0.f, 0.f, 0.f};
#pragma unroll
  for (int kr = 0; kr < 8; ++kr) {
    union { unsigned u[4]; bf16x8 f; } pf;
    pf.u[0] = pack2(S[2 * kr][0], S[2 * kr][1]); pf.u[1] = pack2(S[2 * kr][2], S[2 * kr][3]);
    pf.u[2] = pack2(S[2 * kr + 1][0], S[2 * kr + 1][1]); pf.u[3] = pack2(S[2 * kr + 1][2], S[2 * kr + 1][3]);
    const long vt = bandtok + kr * 64 + kc0 + 4 * g;
#pragma unroll
    for (int dt = 0; dt < 4; ++dt) {
      const unsigned short* vp = P.zT + (long)(1536 + hd * 64 + 16 * dt + qi) * NTOK + vt;
      u32x2 v0 = *(const u32x2*)vp; u32x2 v1 = *(const u32x2*)(vp + 16);
      union { unsigned u[4]; bf16x8 f; } vf;
      vf.u[0] = v0.x; vf.u[1] = v0.y; vf.u[2] = v1.x; vf.u[3] = v1.y;
      O[dt] = mfma16(vf.f, pf.f, O[dt]);
    }
  }
  const float inv = 1.f / sum; float ss = 0.f;
#pragma unroll
  for (int dt = 0; dt < 4; ++dt) {
    float o[4];
#pragma unroll
    for (int e = 0; e < 4; ++e) { o[e] = O[dt][e] * inv; ss += o[e] * o[e]; }
    const u32x2 sgv = *(const u32x2*)(P.z2 + qtok * 1536 + 1024 + hd * 64 + 16 * dt + 4 * g);
    *(u32x2*)(P.z2 + qtok * 1536 + hd * 64 + 16 * dt + 4 * g) = mk2(pack2(o[0] * lo2f(sgv.x), o[1] * hi2f(sgv.x)), pack2(o[2] * lo2f(sgv.y), o[3] * hi2f(sgv.y)));
  }
  ss += __shfl_xor(ss, 16); ss += __shfl_xor(ss, 32);
  if (g == 0) P.ssqA[qtok * 8 + hd] = ss;
  __syncthreads();
}

__device__ void phase_p2(const Params& P, int layer, int bid, int nb, char* lds, int what) {
  const bool attn_first = (what == 3) && (bid >= (nb >> 1));
  if (attn_first) for (int a = bid; a < 6144; a += nb) attn_unit(P, layer, a, lds);
  if (what & 1) for (int u = bid; u < 1536; u += nb) {
    if (u < 1024) conv_unit<8192, 1>(P, layer, 0, u & 511, u >> 9, lds);
    else conv_unit<4096, 2>(P, layer, 1, u - 1024, 0, lds);
  }
  if ((what & 2) && !attn_first) for (int a = bid; a < 6144; a += nb) attn_unit(P, layer, a, lds);
}

__device__ void p3_tile(const Params& P, int layer, int mt, int nt, char* lds) {
  const int tid = opaque_tid(), lane = tid & 63, wave = tid >> 6;
  const int tok0 = mt * 128, n0 = nt * 128;
  const unsigned short* wsrc = P.woutT + ((long)layer * 1024 + n0) * 1024;
  const float* xres = (layer == 0) ? ((tok0 < NPTOK) ? P.xp + (long)tok0 * 1024 : P.xs + (long)(tok0 - NPTOK) * 1024)
                                   : P.out + (long)tok0 * 1024;
  char* As = lds; char* Bs = lds + 20480;
  float* red = (float*)(lds + 36864); float* rh = (float*)(lds + 38912); float* ra = (float*)(lds + 39424);
  if (tid < 128) {
    const f32x4* sp = (const f32x4*)(P.ssqA + (long)(tok0 + tid) * 8);
    f32x4 s0 = sp[0], s1 = sp[1];
    float t = s0.x + s0.y + s0.z + s0.w + s1.x + s1.y + s1.z + s1.w;
    ra[tid] = rsqrtf(t * (1.f / 512.f) + EPSV);
  }
  const int wp = wave >> 1, wq = wave & 1;
  const int r8 = tid >> 3, ch = tid & 7;
  const int kr = tid >> 4, tc = tid & 15;
  f32x16 acc[2][2];
#pragma unroll
  for (int i = 0; i < 2; ++i)
#pragma unroll
    for (int j = 0; j < 2; ++j)
#pragma unroll
      for (int e = 0; e < 16; ++e) acc[i][j][e] = 0.f;
  u32x4 yv[4], gv[4], bv[4];
  const unsigned hy_off = (unsigned)(((512 + kr) * NTOK + tok0 + 8 * tc) * 2);
  const unsigned yg_off = hy_off + (unsigned)(512u * NTOK * 2u);
  const unsigned at_off = (unsigned)(((tok0 + r8) * 1536 + 8 * ch) * 2);
  const unsigned b_off = (unsigned)((r8 * 1024 + ch * 8) * 2);
#pragma unroll
  for (int i = 0; i < 4; ++i) {
    yv[i] = ldg16(P.zT, hy_off + (unsigned)i * (16u * NTOK * 2u));
    gv[i] = ldg16(P.zT, yg_off + (unsigned)i * (16u * NTOK * 2u));
    bv[i] = ldg16(wsrc, b_off + (unsigned)i * 65536u);
  }
  {
    float ssh[8];
#pragma unroll
    for (int e = 0; e < 8; ++e) ssh[e] = 0.f;
    for (int ks = 0; ks < 8; ++ks) {
#pragma unroll
      for (int i = 0; i < 4; ++i) {
        float y[8];
        unpack8(yv[i], y);
#pragma unroll
        for (int e = 0; e < 8; ++e) ssh[e] += y[e] * y[e];
        *(u32x4*)(As + (kr + 16 * i) * 320 + tc * 16) = gv[i];
        *(u32x4*)(Bs + swz_off(r8 + 32 * i, ch)) = bv[i];
      }
      __syncthreads();
      if (ks < 7) {
#pragma unroll
        for (int i = 0; i < 4; ++i) {
          yv[i] = ldg16(P.zT, hy_off + (unsigned)(ks + 1) * (64u * NTOK * 2u) + (unsigned)i * (16u * NTOK * 2u));
          gv[i] = ldg16(P.zT, yg_off + (unsigned)(ks + 1) * (64u * NTOK * 2u) + (unsigned)i * (16u * NTOK * 2u));
        }
      } else {
#pragma unroll
        for (int i = 0; i < 4; ++i) gv[i] = ldg16(P.z2, at_off + (unsigned)i * (32u * 1536u * 2u));
      }
#pragma unroll
      for (int i = 0; i < 4; ++i) bv[i] = ldg16(wsrc, b_off + (unsigned)(ks + 1) * 128u + (unsigned)i * 65536u);
#pragma unroll
      for (int kk = 0; kk < 4; ++kk) {
        bf16x8 a[2], b[2];
#pragma unroll
        for (int i = 0; i < 2; ++i) {
          const int tb = 64 * wp + 32 * i;
          const int l16 = lane & 15;
          const int krow = 16 * kk + 8 * (lane >> 5) + (l16 >> 2);
          const int tcol = tb + 16 * ((lane >> 4) & 1) + 4 * (l16 & 3);
          lds_cptr ap = (lds_cptr)As + krow * 320 + tcol * 2;
          s16x4 lo = __builtin_bit_cast(s16x4, __builtin_amdgcn_ds_read_tr16_b64_v4i16((__attribute__((address_space(3))) v4i16_t*)ap));
          s16x4 hi = __builtin_bit_cast(s16x4, __builtin_amdgcn_ds_read_tr16_b64_v4i16((__attribute__((address_space(3))) v4i16_t*)(ap + 4 * 320)));
          a[i] = (bf16x8){lo[0], lo[1], lo[2], lo[3], hi[0], hi[1], hi[2], hi[3]};
        }
#pragma unroll
        for (int j = 0; j < 2; ++j) b[j] = *(const bf16x8*)(Bs + swz_off(64 * wq + 32 * j + (lane & 31), 2 * kk + (lane >> 5)));
#pragma unroll
        for (int i = 0; i < 2; ++i)
#pragma unroll
          for (int j = 0; j < 2; ++j) acc[i][j] = mfma32(a[i], b[j], acc[i][j]);
      }
      __syncthreads();
    }
#pragma unroll
    for (int e = 0; e < 8; ++e) {
      float s_ = ssh[e];
      s_ += __shfl_xor(s_, 16); s_ += __shfl_xor(s_, 32);
      if (lane < 16) red[wave * 128 + 8 * tc + e] = s_;
    }
  }
  __syncthreads();
  if (tid < 128) rh[tid] = rsqrtf((red[tid] + red[128 + tid] + red[256 + tid] + red[384 + tid]) * (1.f / 512.f) + EPSV) / ra[tid];
  __syncthreads();
#pragma unroll
  for (int i = 0; i < 2; ++i)
#pragma unroll
    for (int e = 0; e < 16; ++e) {
      const float sc = rh[64 * wp + 32 * i + (e & 3) + 8 * (e >> 2) + 4 * (lane >> 5)];
      acc[i][0][e] *= sc; acc[i][1][e] *= sc;
    }
  for (int ks = 8; ks < 16; ++ks) {
#pragma unroll
    for (int i = 0; i < 4; ++i) {
      *(u32x4*)(As + swz_off(r8 + 32 * i, ch)) = gv[i];
      *(u32x4*)(Bs + swz_off(r8 + 32 * i, ch)) = bv[i];
    }
    __syncthreads();
    if (ks < 15) {
#pragma unroll
      for (int i = 0; i < 4; ++i) {
        gv[i] = ldg16(P.z2, at_off + (unsigned)(ks - 7) * 128u + (unsigned)i * (32u * 1536u * 2u));
        bv[i] = ldg16(wsrc, b_off + (unsigned)(ks + 1) * 128u + (unsigned)i * 65536u);
      }
    }
#pragma unroll
    for (int kk = 0; kk < 4; ++kk) {
      bf16x8 a[2], b[2];
#pragma unroll
      for (int i = 0; i < 2; ++i) a[i] = *(const bf16x8*)(As + swz_off(64 * wp + 32 * i + (lane & 31), 2 * kk + (lane >> 5)));
#pragma unroll
      for (int j = 0; j < 2; ++j) b[j] = *(const bf16x8*)(Bs + swz_off(64 * wq + 32 * j + (lane & 31), 2 * kk + (lane >> 5)));
#pragma unroll
      for (int i = 0; i < 2; ++i)
#pragma unroll
        for (int j = 0; j < 2; ++j) acc[i][j] = mfma32(a[i], b[j], acc[i][j]);
    }
    __syncthreads();
  }
#pragma unroll
  for (int i = 0; i < 2; ++i)
#pragma unroll
    for (int j = 0; j < 2; ++j) {
      const int n = n0 + 64 * wq + 32 * j + (lane & 31);
      const unsigned eoff = (unsigned)(((64 * wp + 32 * i + 4 * (lane >> 5)) * 1024 + n) * 4);
      float* outb = P.out + (long)tok0 * 1024;
#pragma unroll
      for (int g4 = 0; g4 < 4; ++g4) {
        float xr[4];
#pragma unroll
        for (int e = 0; e < 4; ++e) xr[e] = *(const float*)((const char*)xres + (eoff + (unsigned)(g4 * 8 + e) * 4096u));
#pragma unroll
        for (int e = 0; e < 4; ++e)
          *(float*)((char*)outb + (eoff + (unsigned)(g4 * 8 + e) * 4096u)) =
              xr[e] + acc[i][j][4 * g4 + e] * ra[64 * wp + 32 * i + 8 * g4 + 4 * (lane >> 5) + e];
      }
    }
  __syncthreads();
}

__device__ void phase_p3(const Params& P, int layer, int bid, int nb, char* lds) {
  for (int v = bid; v < 3072; v += nb) {
    int wv = v >> 9, within = v & 511, x = within & 7, idx = within >> 3;
    int mt = wv * 64 + x * 8 + (idx >> 3);
    int nt = idx & 7;
    p3_tile(P, layer, mt, nt, lds);
  }
}

#define XB_TMO      128
#define XB_XCNT(j)  (256  + 64 * (j))
#define XB_XSUB(j)  (1280 + 64 * (j))
#define XB_XGEN(j)  (2304 + 64 * (j))
#define XB_TOP      3328
#define XB_TOPGEN   3392
#define XCD_BAR_WORDS 3456
#define XB_SPIN_CAP (1u << 18)
#define LAS __attribute__((address_space(3)))

__device__ __forceinline__ unsigned xb_ld(unsigned* p)              { return __hip_atomic_load(p, __ATOMIC_RELAXED, __HIP_MEMORY_SCOPE_AGENT); }
__device__ __forceinline__ unsigned xb_add(unsigned* p, unsigned v) { return __hip_atomic_fetch_add(p, v, __ATOMIC_RELAXED, __HIP_MEMORY_SCOPE_AGENT); }
__device__ __forceinline__ unsigned xb_xcc_id() { return (unsigned)__builtin_amdgcn_s_getreg((3 << 11) | 20) & 0xFu; }
#define XB_SPIN(cond, bar) do { unsigned _sp = 0; while (cond) { __builtin_amdgcn_s_sleep(1); \
    if ((++_sp & 255u) == 0u) { if (xb_ld(&(bar)[XB_TMO])) break; if (_sp > XB_SPIN_CAP) { atomicAdd(&(bar)[XB_TMO], 1u); break; } } } } while (0)

struct XcdBarrier {
    unsigned* bar; unsigned x;
    volatile LAS unsigned* st;
};

__device__ __forceinline__ XcdBarrier xcd_barrier_post(unsigned* bar, volatile LAS unsigned* st) {
    XcdBarrier b; b.bar = bar; b.x = xb_xcc_id(); b.st = st;
    if (threadIdx.x == 0) (void)xb_add(&bar[XB_XCNT(b.x)], 1u);
    return b;
}
__device__ __forceinline__ void xcd_barrier_complete(unsigned* bar, unsigned x, unsigned& nloc, unsigned& nx) {
    const unsigned G = gridDim.x * gridDim.y * gridDim.z;
    unsigned sum, cnt, mine, sp = 0u;
    for (;;) {
        sum = 0u; cnt = 0u; mine = 0u;
#pragma unroll
        for (unsigned j = 0; j < 16; ++j) { const unsigned c = xb_ld(&bar[XB_XCNT(j)]); sum += c; cnt += (c > 0u) ? 1u : 0u; mine = (j == x) ? c : mine; }
        if (sum == G) break;
        __builtin_amdgcn_s_sleep(1);
        if ((++sp & 255u) == 0u) { if (xb_ld(&bar[XB_TMO])) break; if (sp > XB_SPIN_CAP) { atomicAdd(&bar[XB_TMO], 1u); break; } }
    }
    nloc = mine > 0u ? mine : 1u; nx = cnt > 0u ? cnt : 1u;
}

__device__ __forceinline__ void xcd_barrier(const XcdBarrier& b) {
    asm volatile("s_waitcnt vmcnt(0)" ::: "memory");
    __syncthreads();
    if (threadIdx.x == 0) {
        unsigned* bar = b.bar;
        __builtin_amdgcn_s_waitcnt(0);
        unsigned nloc = b.st[0], nx = b.st[1];
        if (nloc == 0u) { xcd_barrier_complete(bar, b.x, nloc, nx); b.st[0] = nloc; b.st[1] = nx; }
        const unsigned old = xb_add(&bar[XB_XSUB(b.x)], 1u);
        const unsigned gen = old / nloc;
        if (old + 1u == (gen + 1u) * nloc) {
            __builtin_amdgcn_fence(__ATOMIC_RELEASE, "agent");
            asm volatile("s_waitcnt vmcnt(0)" ::: "memory");
            const unsigned og = xb_add(&bar[XB_TOP], 1u);
            const unsigned tg = og / nx;
            if (og + 1u == (tg + 1u) * nx) xb_add(&bar[XB_TOPGEN], 1u);
            else XB_SPIN(xb_ld(&bar[XB_TOPGEN]) == tg, bar);
            __builtin_amdgcn_fence(__ATOMIC_ACQUIRE, "agent");
            xb_add(&bar[XB_XGEN(b.x)], 1u);
            asm volatile("s_waitcnt vmcnt(0)" ::: "memory");
        } else {
            XB_SPIN(xb_ld(&bar[XB_XGEN(b.x)]) == gen, bar);
            __builtin_amdgcn_fence(__ATOMIC_ACQUIRE, "agent");
            asm volatile("s_waitcnt vmcnt(0)" ::: "memory");
        }
    }
    __syncthreads();
}


__device__ __forceinline__ void run_phase(const Params& P, int ph, int bid, int nb, char* lds) {
  switch (ph) {
    case 0: phase_prep(P, bid, nb, lds); break;
    case 1: phase_p1(P, 0, bid, nb, lds, 0); break;
    case 2: phase_p2(P, 0, bid, nb, lds, 3); break;
    case 3: phase_p3(P, 0, bid, nb, lds); break;
    case 4: phase_p1(P, 1, bid, nb, lds, 0); break;
    case 5: phase_p2(P, 1, bid, nb, lds, 3); break;
    case 6: phase_p3(P, 1, bid, nb, lds); break;
  }
}

#if MULTI
__global__ void __launch_bounds__(256, 2) phase_kernel(Params P, int ph) {
  __shared__ __attribute__((aligned(16))) char lds[LDS_BYTES];
  run_phase(P, ph, blockIdx.x, gridDim.x, lds);
}
#else
__global__ void __launch_bounds__(256, 2) mega_kernel(Params P) {
  __shared__ __attribute__((aligned(16))) char lds[LDS_BYTES];
  cg::grid_group grid = cg::this_grid();
  __shared__ uint4 xb_words;
  if (threadIdx.x == 0) xb_words = make_uint4(0u, 0u, 0u, 0u);
  __syncthreads();
  const XcdBarrier xb = xcd_barrier_post(P.bar, (volatile LAS unsigned*)&xb_words);
  const int bid = blockIdx.x, nb = gridDim.x;
#pragma unroll 1
  for (int st = 0; st < NSTEPS; ++st) {
    const int ph = (int)((PROG >> (4 * st)) & 15ull);
    const int layer = (ph >= 4 && ph <= 6) ? 1 : 0;
    const int sub = ph == 0 ? 0 : (ph <= 6 ? ((ph - 1) % 3 + 1) : ph - 3);
    switch (sub) {
      case 0: phase_prep(P, bid, nb, lds); break;
      case 1: phase_p1(P, layer, bid, nb, lds, 0); break;
      case 6: case 7: case 8: phase_p1(P, 0, bid, nb, lds, sub - 5); break;
      case 2: phase_p2(P, layer, bid, nb, lds, 3); break;
      case 3: phase_p3(P, layer, bid, nb, lds); break;
      case 4: phase_p2(P, layer, bid, nb, lds, 1); break;
      case 5: phase_p2(P, layer, bid, nb, lds, 2); break;
    }
    if (st == 0) grid.sync();
    else if (st < NSTEPS - 1) xcd_barrier(xb);
  }
}
#endif

extern "C" void kernel_launch(void* const* d_in, const int* in_sizes, int n_in, void* d_out, int out_size,
                              void* d_ws, size_t ws_size, hipStream_t stream) {
  Params P{};
  P.xp = (const float*)d_in[0]; P.xs = (const float*)d_in[1];
  P.norm_g = (const float*)d_in[2]; P.w_in = (const float*)d_in[3]; P.conv_w = (const float*)d_in[4];
  P.conv_b = (const float*)d_in[5]; P.f_w1 = (const float*)d_in[6]; P.f_b1 = (const float*)d_in[7];
  P.f_fr1 = (const float*)d_in[8]; P.f_w2 = (const float*)d_in[9]; P.f_b2 = (const float*)d_in[10];
  P.f_fr2 = (const float*)d_in[11]; P.f_w3 = (const float*)d_in[12]; P.hy_bias = (const float*)d_in[13];
  P.qn_g = (const float*)d_in[14]; P.kn_g = (const float*)d_in[15]; P.rpb = (const float*)d_in[16];
  P.on_hy = (const float*)d_in[17]; P.on_att = (const float*)d_in[18]; P.w_out = (const float*)d_in[19];
  P.out = (float*)d_out;
  char* ws = (char*)d_ws;
  size_t off = 0;
  P.zT = (unsigned short*)(ws + off); off += (size_t)2560 * NTOK * 2;
  P.z2 = (unsigned short*)(ws + off); off += (size_t)NTOK * 1536 * 2;
  P.filt = (unsigned short*)(ws + off); off += (size_t)2 * 512 * 24576 * 2;
  P.winT = (unsigned short*)(ws + off); off += (size_t)2 * 4096 * 1024 * 2;
  P.woutT = (unsigned short*)(ws + off); off += (size_t)2 * 1024 * 1024 * 2;
  P.ssqA = (float*)(ws + off); off += (size_t)NTOK * 8 * 4;
  P.rstd1 = (float*)(ws + off); off += (size_t)NTOK * 4;
  P.bar = (unsigned*)(ws + off); off += (size_t)XCD_BAR_WORDS * 4;
  P.xb1 = (unsigned short*)d_out;
  if (off > ws_size) { fprintf(stderr, "workspace too small: need %zu have %zu\n", off, ws_size); return; }
#if MULTI
  for (int ph = 0; ph < 7; ++ph) phase_kernel<<<512, 256, 0, stream>>>(P, ph);
#else
  static int grid_blocks = 0;
  if (!grid_blocks) {
    int dev = 0, cus = 0, per_cu = 0;
    hipGetDevice(&dev);
    hipDeviceGetAttribute(&cus, hipDeviceAttributeMultiprocessorCount, dev);
    hipOccupancyMaxActiveBlocksPerMultiprocessor(&per_cu, mega_kernel, 256, 0);
    if (per_cu > 2) per_cu = 2;
    grid_blocks = cus * per_cu;
  }
  hipMemsetAsync(P.bar, 0, (size_t)XCD_BAR_WORDS * 4, stream);
  void* args[] = {&P};
  hipError_t e = hipLaunchCooperativeKernel((void*)mega_kernel, dim3(grid_blocks), dim3(256), args, 0, stream);
  if (e != hipSuccess) fprintf(stderr, "cooperative launch failed: %s (grid %d)\n", hipGetErrorString(e), grid_blocks);
#endif
}
```

```cpp
#include <hip/hip_runtime.h>
#include <hip/hip_cooperative_groups.h>
#include <stdint.h>
#include <stdio.h>
namespace cg = cooperative_groups;

#ifndef MULTI
#define MULTI 0
#endif

typedef __attribute__((ext_vector_type(8))) short bf16x8;
typedef __attribute__((ext_vector_type(4))) short s16x4;
typedef __attribute__((ext_vector_type(16))) float f32x16;
typedef __attribute__((ext_vector_type(4))) float f32x4;
typedef short v4i16_t __attribute__((ext_vector_type(4)));
typedef __attribute__((ext_vector_type(4))) unsigned int u32x4;
typedef __attribute__((ext_vector_type(2))) unsigned int u32x2;
typedef __attribute__((address_space(3))) const char* lds_cptr;

#define NTOK 49152
#define NPTOK 32768
#define EPSV 1e-6f
#define LOG2E 1.4426950408889634f
#define LDS_BYTES 74240
#ifndef PROG
#define PROG 0x6543210ull
#define NSTEPS 7
#endif

struct Params {
  const float* xp; const float* xs;
  const float* norm_g; const float* w_in; const float* conv_w; const float* conv_b;
  const float* f_w1; const float* f_b1; const float* f_fr1; const float* f_w2; const float* f_b2;
  const float* f_fr2; const float* f_w3; const float* hy_bias; const float* qn_g; const float* kn_g;
  const float* rpb; const float* on_hy; const float* on_att; const float* w_out;
  float* out;
  unsigned short* zT;
  unsigned short* z2;
  unsigned short* filt;
  unsigned short* winT;
  unsigned short* woutT;
  float* ssqA;
  unsigned short* xb1;
  float* rstd1;
  unsigned* bar;
  float* ssqH;
  float* ssqX;
};

__device__ __forceinline__ int opaque_tid() { int t = threadIdx.x; asm volatile("" : "+v"(t)); return t; }
__device__ __forceinline__ unsigned short f2bf(float f) {
  unsigned int u = __float_as_uint(f);
  u += 0x7fffu + ((u >> 16) & 1u);
  return (unsigned short)(u >> 16);
}
__device__ __forceinline__ float bf2f(unsigned short h) { return __uint_as_float(((unsigned int)h) << 16); }
typedef __attribute__((ext_vector_type(2))) float f32x2_t;
typedef __attribute__((ext_vector_type(2))) __bf16 bf16x2_t;
__device__ __forceinline__ unsigned int pack2(float a, float b) { f32x2_t v = {a, b}; return __builtin_bit_cast(unsigned int, __builtin_convertvector(v, bf16x2_t)); }
__device__ __forceinline__ unsigned int pack2t(float a, float b) { return pack2(a, b); }
__device__ __forceinline__ float lo2f(unsigned int u) { return __uint_as_float(u << 16); }
__device__ __forceinline__ float hi2f(unsigned int u) { return __uint_as_float(u & 0xffff0000u); }
__device__ __forceinline__ float silu_f(float g) { return g / (1.f + __expf(-g)); }
__device__ __forceinline__ int swz_off(int row, int ch) { return row * 128 + ((ch ^ ((row >> 1) & 7)) << 4); }

__device__ __forceinline__ f32x16 mfma32(bf16x8 a, bf16x8 b, f32x16 c) { return __builtin_amdgcn_mfma_f32_32x32x16_bf16(a, b, c, 0, 0, 0); }
__device__ __forceinline__ f32x4 mfma16(bf16x8 a, bf16x8 b, f32x4 c) { return __builtin_amdgcn_mfma_f32_16x16x32_bf16(a, b, c, 0, 0, 0); }

__device__ __forceinline__ u32x4 mk4(unsigned a, unsigned b, unsigned c, unsigned d) { u32x4 r = {a, b, c, d}; return r; }
__device__ __forceinline__ u32x2 mk2(unsigned a, unsigned b) { u32x2 r = {a, b}; return r; }
__device__ __forceinline__ bf16x8 u4_to_frag(u32x4 v) {
  union { u32x4 u; bf16x8 f; } x; x.u = v; return x.f;
}

__device__ void filter_unit(const Params& P, int u, char* lds) {
  const int tid = opaque_tid(), lane = tid & 63;
  const int wave = __builtin_amdgcn_readfirstlane(tid >> 6);
  const int l = u / 192; const int rr = u % 192;
  const int set = rr < 128 ? 0 : 1; const int pch = set ? rr - 128 : rr;
  const int L = set ? 4096 : 8192;
  const int p = pch * 64 + lane;
  const float t01 = (float)p / (float)(L - 1);
  const float pl = (float)p / (float)L;
  float* zs = (float*)lds;
  float* h1s = zs + 33 * 64;
  char* Hq = lds + 24832;
  char* Ws = lds + 33024;
  if (wave == 0) {
    zs[lane] = t01;
#pragma unroll
    for (int k = 0; k < 16; ++k) {
      float fk = 1e-4f + (float)k * ((15.f - 1e-4f) / 15.f);
      float tr = fk * pl; tr -= floorf(tr);
      zs[(1 + k) * 64 + lane] = __builtin_amdgcn_cosf(tr);
      zs[(17 + k) * 64 + lane] = -__builtin_amdgcn_sinf(tr);
    }
  }
  __syncthreads();
  const float* w1 = P.f_w1 + l * 33 * 64; const float* b1 = P.f_b1 + l * 64; const float* fr1 = P.f_fr1 + l * 64;
  const float* w2 = P.f_w2 + l * 64 * 64; const float* b2 = P.f_b2 + l * 64; const float* fr2 = P.f_fr2 + l * 64;
  const float* w3 = P.f_w3 + l * 64 * 1024;
  const int j0 = wave * 16;
  {
    float acc[16];
#pragma unroll
    for (int j = 0; j < 16; ++j) acc[j] = b1[j0 + j];
#pragma unroll 3
    for (int i = 0; i < 33; ++i) {
      const float zv = zs[i * 64 + lane];
#pragma unroll
      for (int j = 0; j < 16; ++j) acc[j] += zv * w1[i * 64 + j0 + j];
    }
#pragma unroll
    for (int j = 0; j < 16; ++j) h1s[(j0 + j) * 64 + lane] = __builtin_amdgcn_sinf(fr1[j0 + j] * acc[j] * 0.15915494309189535f);
  }
  __syncthreads();
  {
    float acc[16];
#pragma unroll
    for (int j = 0; j < 16; ++j) acc[j] = b2[j0 + j];
#pragma unroll 4
    for (int i = 0; i < 64; ++i) {
      const float hv = h1s[i * 64 + lane];
#pragma unroll
      for (int j = 0; j < 16; ++j) acc[j] += hv * w2[i * 64 + j0 + j];
    }
    float hh[16];
#pragma unroll
    for (int j = 0; j < 16; ++j) hh[j] = __builtin_amdgcn_sinf(fr2[j0 + j] * acc[j] * 0.15915494309189535f);
    *(u32x4*)(Hq + swz_off(lane, 2 * wave)) = mk4(pack2t(hh[0], hh[1]), pack2t(hh[2], hh[3]), pack2t(hh[4], hh[5]), pack2t(hh[6], hh[7]));
    *(u32x4*)(Hq + swz_off(lane, 2 * wave + 1)) = mk4(pack2t(hh[8], hh[9]), pack2t(hh[10], hh[11]), pack2t(hh[12], hh[13]), pack2t(hh[14], hh[15]));
  }
  const float mind = -3.0701134573253943f, maxd = -15.350567286626972f;
  const int setoff = set ? 16384 : 0;
  const int qpos0 = pch * 64 + (lane & 31);
  for (int nc = 0; nc < 8; ++nc) {
    const int n0 = nc * 128;
    __syncthreads();
#pragma unroll
    for (int i = 0; i < 4; ++i) {
      const int id = tid + 256 * i; const int krow = id >> 4, c8 = id & 15;
      const float* src = w3 + krow * 1024 + n0 + 8 * c8;
      f32x4 a0 = *(const f32x4*)src, a1 = *(const f32x4*)(src + 4);
      *(u32x4*)(Ws + krow * 320 + c8 * 16) = mk4(pack2(a0.x, a0.y), pack2(a0.z, a0.w), pack2(a1.x, a1.y), pack2(a1.z, a1.w));
    }
    __syncthreads();
    f32x16 acc[2];
#pragma unroll
    for (int j = 0; j < 2; ++j) {
#pragma unroll
      for (int e = 0; e < 16; ++e) acc[j][e] = 0.f;
    }
#pragma unroll
    for (int kk = 0; kk < 4; ++kk) {
      const int l16 = lane & 15;
      const int krow = 16 * kk + 8 * (lane >> 5) + (l16 >> 2);
      const int ncol = 32 * wave + 16 * ((lane >> 4) & 1) + 4 * (l16 & 3);
      lds_cptr ap = (lds_cptr)Ws + krow * 320 + ncol * 2;
      s16x4 lo = __builtin_bit_cast(s16x4, __builtin_amdgcn_ds_read_tr16_b64_v4i16((__attribute__((address_space(3))) v4i16_t*)ap));
      s16x4 hi = __builtin_bit_cast(s16x4, __builtin_amdgcn_ds_read_tr16_b64_v4i16((__attribute__((address_space(3))) v4i16_t*)(ap + 4 * 320)));
      bf16x8 a = (bf16x8){lo[0], lo[1], lo[2], lo[3], hi[0], hi[1], hi[2], hi[3]};
#pragma unroll
      for (int j = 0; j < 2; ++j) {
        bf16x8 b = *(const bf16x8*)(Hq + swz_off(32 * j + (lane & 31), 2 * kk + (lane >> 5)));
        acc[j] = mfma32(a, b, acc[j]);
      }
    }
#pragma unroll
    for (int j = 0; j < 2; ++j) {
      const int pos = qpos0 + 32 * j;
      const float tq = (float)pos / (float)(L - 1);
#pragma unroll
      for (int e = 0; e < 16; ++e) {
        const int col = n0 + 32 * wave + (e & 3) + 8 * (e >> 2) + 4 * (lane >> 5);
        const float delta = fabsf(mind + (float)col * ((maxd - mind) / 1023.f));
        const float val = acc[j][e] * __expf(-tq * delta);
        const int c = col & 511;
        unsigned short* dst = P.filt + ((long)(l * 512 + c)) * 24576 + setoff;
        if (col < 512) dst[L - pos] = f2bf(val);
        else { if (pos > 0) dst[L + pos] = f2bf(val); else dst[0] = 0; }
      }
    }
  }
  __syncthreads();
}

__device__ void phase_prep(const Params& P, int bid, int nb, char* lds) {
  const int tid = opaque_tid();
  const long gt = (long)bid * 256 + tid, gs = (long)nb * 256;
  for (long i = gt; i < 2L * 128 * 4096; i += gs) {
    int n = (int)(i & 4095); int kc = (int)((i >> 12) & 127); int l = (int)(i >> 19);
    const float* w = P.w_in + ((long)l * 1024 + kc * 8) * 4096 + n;
    const float* g = P.norm_g + l * 1024 + kc * 8;
    unsigned int o[4];
#pragma unroll
    for (int j = 0; j < 4; ++j) o[j] = pack2(w[(long)(2 * j) * 4096] * g[2 * j], w[(long)(2 * j + 1) * 4096] * g[2 * j + 1]);
    *(u32x4*)(P.winT + ((long)l * 4096 + n) * 1024 + kc * 8) = mk4(o[0], o[1], o[2], o[3]);
  }
  for (long i = gt; i < 2L * 128 * 1024; i += gs) {
    int n = (int)(i & 1023); int kc = (int)((i >> 10) & 127); int l = (int)(i >> 17);
    const float* w = P.w_out + ((long)l * 1024 + kc * 8) * 1024 + n;
    const float* g = (kc < 64) ? (P.on_hy + l * 512 + kc * 8) : (P.on_att + l * 512 + (kc - 64) * 8);
    unsigned int o[4];
#pragma unroll
    for (int j = 0; j < 4; ++j) o[j] = pack2(w[(long)(2 * j) * 1024] * g[2 * j], w[(long)(2 * j + 1) * 1024] * g[2 * j + 1]);
    *(u32x4*)(P.woutT + ((long)l * 1024 + n) * 1024 + kc * 8) = mk4(o[0], o[1], o[2], o[3]);
  }
  {
    const int lane = tid & 63; const int gw = bid * 4 + (tid >> 6);
    for (int row = gw; row < NTOK; row += nb * 4) {
      const float* src = (row < NPTOK) ? P.xp + (long)row * 1024 : P.xs + (long)(row - NPTOK) * 1024;
      unsigned short* dst = P.xb1 + (long)row * 1024;
      float ss = 0.f;
#pragma unroll
      for (int i = 0; i < 4; ++i) {
        const f32x4 a = *(const f32x4*)(src + (i * 64 + lane) * 4);
        ss += a.x * a.x + a.y * a.y + a.z * a.z + a.w * a.w;
        *(u32x2*)(dst + (i * 64 + lane) * 4) = mk2(pack2(a.x, a.y), pack2(a.z, a.w));
      }
      ss += __shfl_xor(ss, 32); ss += __shfl_xor(ss, 16); ss += __shfl_xor(ss, 8);
      ss += __shfl_xor(ss, 4); ss += __shfl_xor(ss, 2); ss += __shfl_xor(ss, 1);
      if (lane == 0) P.rstd1[row] = rsqrtf(ss * (1.f / 1024.f) + EPSV);
    }
  }
  for (int u = bid; u < 384; u += nb) filter_unit(P, u, lds);
}

__device__ __forceinline__ u32x4 ldg16(const void* base, unsigned off) { return *(const u32x4*)((const char*)base + off); }

__device__ __forceinline__ void unpack8(u32x4 v, float* f) {
  f[0] = lo2f(v.x); f[1] = hi2f(v.x); f[2] = lo2f(v.y); f[3] = hi2f(v.y);
  f[4] = lo2f(v.z); f[5] = hi2f(v.z); f[6] = lo2f(v.w); f[7] = hi2f(v.w);
}

__device__ void p1_tile(const Params& P, int layer, int mt, int nt, char* lds, int variant) {
  const int tid = opaque_tid(), lane = tid & 63, wave = tid >> 6;
  const int tok0 = mt * 128, n0 = nt * 128;
  bool swap; int dst0; int mode = 0;
  const bool gate = (n0 >= 1536 && n0 < 2048) || (n0 >= 3584);
  if (n0 < 1536) { swap = false; dst0 = n0; }
  else if (n0 < 2048) { swap = false; dst0 = 2048 + (n0 - 1536); }
  else if (n0 < 2560) { swap = true; dst0 = n0 - 2048; mode = 1; }
  else if (n0 < 3072) { swap = true; dst0 = 512 + (n0 - 2560); mode = 2; }
  else if (n0 < 3584) { swap = false; dst0 = 1536 + (n0 - 3072); }
  else { swap = true; dst0 = 1024 + (n0 - 3584); }
  const float* xsrc = (layer == 0) ? ((tok0 < NPTOK) ? P.xp + (long)tok0 * 1024 : P.xs + (long)(tok0 - NPTOK) * 1024)
                                   : P.out + (long)tok0 * 1024;
  const unsigned short* wsrc = P.winT + ((long)layer * 4096 + n0) * 1024;
  char* S = lds; float* rs = (float*)(lds + 65536);
  const int wp = wave >> 1, wq = wave & 1;
  f32x16 acc[2][2];
#pragma unroll
  for (int i = 0; i < 2; ++i)
#pragma unroll
    for (int j = 0; j < 2; ++j)
#pragma unroll
      for (int e = 0; e < 16; ++e) acc[i][j][e] = 0.f;
  const int r8 = tid >> 3, ch = tid & 7;
  const int r16 = tid >> 4, c4 = tid & 15;
  f32x4 av[8]; u32x4 bv[4]; float ssq[8];
#pragma unroll
  for (int i = 0; i < 8; ++i) ssq[i] = 0.f;
  const unsigned a_off = (unsigned)((r16 * 1024 + c4 * 4) * 4);
  const unsigned b_off = (unsigned)((r8 * 1024 + ch * 8) * 2);
#define P1_LOAD(ks_) do { \
    _Pragma("unroll") for (int i = 0; i < 8; ++i) av[i] = *(const f32x4*)((const char*)xsrc + (a_off + (unsigned)i * 65536u + (unsigned)(ks_) * 256u)); \
    _Pragma("unroll") for (int i = 0; i < 4; ++i) bv[i] = ldg16(wsrc, b_off + (unsigned)i * 65536u + (unsigned)(ks_) * 128u); } while (0)
#define P1_STORE(buf_) do { \
    char* As_ = lds + (buf_) * 32768; char* Bs_ = As_ + 16384; \
    _Pragma("unroll") for (int i = 0; i < 8; ++i) { \
      f32x4 a0 = av[i]; \
      ssq[i] += a0.x * a0.x + a0.y * a0.y + a0.z * a0.z + a0.w * a0.w; \
      const int row_ = r16 + 16 * i; \
      *(u32x2*)(As_ + row_ * 128 + (((c4 >> 1) ^ ((row_ >> 1) & 7)) << 4) + (c4 & 1) * 8) = mk2(pack2(a0.x, a0.y), pack2(a0.z, a0.w)); } \
    _Pragma("unroll") for (int i = 0; i < 4; ++i) *(u32x4*)(Bs_ + swz_off(r8 + 32 * i, ch)) = bv[i]; } while (0)
  if (layer == 0) {
    const unsigned short* asrc = P.xb1 + (long)tok0 * 1024;
    unsigned goff[4], loff[4];
#pragma unroll
    for (int i = 0; i < 4; ++i) {
      const int m = wave * 4 + i; const int row = 8 * m + (lane >> 3); const int cc = (lane & 7) ^ ((row >> 1) & 7);
      goff[i] = (unsigned)(row * 2048 + cc * 16); loff[i] = (unsigned)(m * 1024 + lane * 16);
    }
#define P1_DMA(ks_, buf_) do { _Pragma("unroll") for (int i = 0; i < 4; ++i) { \
      __builtin_amdgcn_global_load_lds((const unsigned*)((const char*)asrc + goff[i] + (unsigned)(ks_) * 128u), (unsigned*)(lds + (buf_) * 32768 + loff[i]), 16, 0, 0); \
      __builtin_amdgcn_global_load_lds((const unsigned*)((const char*)wsrc + goff[i] + (unsigned)(ks_) * 128u), (unsigned*)(lds + (buf_) * 32768 + 16384 + loff[i]), 16, 0, 0); } } while (0)
    P1_DMA(0, 0);
    if (tid < 128) rs[tid] = P.rstd1[tok0 + tid];
    for (int ks = 0; ks < 16; ++ks) {
      const int cur = ks & 1;
      __syncthreads();
      if (ks + 1 < 16) P1_DMA(ks + 1, cur ^ 1);
      const char* As = lds + cur * 32768; const char* Bs = As + 16384;
      const char* Pb = swap ? Bs : As; const char* Qb = swap ? As : Bs;
#pragma unroll
      for (int kk = 0; kk < 4; ++kk) {
        bf16x8 a[2], b[2];
#pragma unroll
        for (int i = 0; i < 2; ++i) a[i] = *(const bf16x8*)(Pb + swz_off(64 * wp + 32 * i + (lane & 31), 2 * kk + (lane >> 5)));
#pragma unroll
        for (int j = 0; j < 2; ++j) b[j] = *(const bf16x8*)(Qb + swz_off(64 * wq + 32 * j + (lane & 31), 2 * kk + (lane >> 5)));
#pragma unroll
        for (int i = 0; i < 2; ++i)
#pragma unroll
          for (int j = 0; j < 2; ++j) acc[i][j] = mfma32(a[i], b[j], acc[i][j]);
      }
    }
#undef P1_DMA
    __syncthreads();
  } else {
  P1_LOAD(0);
  P1_STORE(0);
  P1_LOAD(1);
  __syncthreads();
  for (int ks = 0; ks < 16; ++ks) {
    const int cur = ks & 1;
    if (ks + 1 < 16) P1_STORE(cur ^ 1);
    if (ks + 2 < 16 && !(variant & 1)) P1_LOAD(ks + 2);
    __builtin_amdgcn_sched_barrier(0);
    const char* As = lds + cur * 32768; const char* Bs = As + 16384;
    const char* Pb = swap ? Bs : As; const char* Qb = swap ? As : Bs;
#pragma unroll
    for (int kk = 0; kk < 4; ++kk) {
      bf16x8 a[2], b[2];
#pragma unroll
      for (int i = 0; i < 2; ++i) a[i] = *(const bf16x8*)(Pb + swz_off(64 * wp + 32 * i + (lane & 31), 2 * kk + (lane >> 5)));
#pragma unroll
      for (int j = 0; j < 2; ++j) b[j] = *(const bf16x8*)(Qb + swz_off(64 * wq + 32 * j + (lane & 31), 2 * kk + (lane >> 5)));
#pragma unroll
      for (int i = 0; i < 2; ++i)
#pragma unroll
        for (int j = 0; j < 2; ++j) acc[i][j] = mfma32(a[i], b[j], acc[i][j]);
    }
    __syncthreads();
  }
#undef P1_LOAD
#undef P1_STORE
#pragma unroll
  for (int i = 0; i < 8; ++i) {
    float s_ = ssq[i];
    s_ += __shfl_xor(s_, 1); s_ += __shfl_xor(s_, 2); s_ += __shfl_xor(s_, 4); s_ += __shfl_xor(s_, 8);
    if (c4 == 0) rs[r16 + 16 * i] = rsqrtf(s_ * (1.f / 1024.f) + EPSV);
  }
  __syncthreads();
  }
#pragma unroll
  for (int i = 0; i < 2; ++i)
#pragma unroll
    for (int j = 0; j < 2; ++j) {
      const int q = 64 * wq + 32 * j + (lane & 31);
#pragma unroll
      for (int g4 = 0; g4 < 4; ++g4) {
        const int p = 64 * wp + 32 * i + 8 * g4 + 4 * (lane >> 5);
        float v[4];
#pragma unroll
        for (int e = 0; e < 4; ++e) v[e] = acc[i][j][4 * g4 + e] * (swap ? rs[q] : rs[p + e]);
        if (gate) {
#pragma unroll
          for (int e = 0; e < 4; ++e) v[e] = v[e] * __builtin_amdgcn_rcpf(1.f + __expf(-v[e]));
        }
        *(u32x2*)(S + q * 272 + p * 2) = mk2(pack2(v[0], v[1]), pack2(v[2], v[3]));
      }
    }
  __syncthreads();
#pragma unroll
  for (int it = 0; it < 8; ++it) {
    const int id = tid + 256 * it; const int row = id >> 4, c16 = id & 15;
    u32x4 v = *(const u32x4*)(S + row * 272 + c16 * 16);
    if (variant & 2) continue;
    if (!swap) {
      *(u32x4*)(P.zT + (long)(dst0 + row) * NTOK + tok0 + c16 * 8) = v;
    } else {
      if (mode) {
        float f[8];
        f[0] = lo2f(v.x); f[1] = hi2f(v.x); f[2] = lo2f(v.y); f[3] = hi2f(v.y);
        f[4] = lo2f(v.z); f[5] = hi2f(v.z); f[6] = lo2f(v.w); f[7] = hi2f(v.w);
        float ss = 0.f;
#pragma unroll
        for (int e = 0; e < 8; ++e) ss += f[e] * f[e];
        ss += __shfl_xor(ss, 1); ss += __shfl_xor(ss, 2); ss += __shfl_xor(ss, 4);
        float sc = rsqrtf(ss * (1.f / 64.f) + EPSV);
        if (mode == 1) sc *= 0.125f * LOG2E;
        const float* g = (mode == 1 ? P.qn_g : P.kn_g) + layer * 64 + (c16 & 7) * 8;
#pragma unroll
        for (int e = 0; e < 8; ++e) f[e] *= sc * g[e];
        v = mk4(pack2(f[0], f[1]), pack2(f[2], f[3]), pack2(f[4], f[5]), pack2(f[6], f[7]));
      }
      *(u32x4*)(P.z2 + (long)(tok0 + row) * 1536 + dst0 + c16 * 8) = v;
    }
  }
  __syncthreads();
}

__device__ void phase_rstd2(const Params& P, int bid, int nb) {
  const int tid = opaque_tid(), lane = tid & 63;
  for (int row = bid * 4 + (tid >> 6); row < NTOK; row += nb * 4) {
    const char* src = (const char*)P.out + (long)row * 4096;
    float ss = 0.f;
#pragma unroll
    for (int i = 0; i < 2; ++i) {
      const int c = lane + 64 * i;
      float y[8]; unpack8(*(const u32x4*)(src + (c >> 4) * 512 + (c & 15) * 16), y);
#pragma unroll
      for (int e = 0; e < 8; ++e) ss += y[e] * y[e];
    }
    ss += __shfl_xor(ss, 32); ss += __shfl_xor(ss, 16); ss += __shfl_xor(ss, 8);
    ss += __shfl_xor(ss, 4); ss += __shfl_xor(ss, 2); ss += __shfl_xor(ss, 1);
    if (lane == 0) P.rstd1[row] = rsqrtf(ss * (1.f / 1024.f) + EPSV);
  }
}

__device__ __forceinline__ int swz64(int row, int ch) { return row * 64 + ((ch ^ ((row >> 2) & 3)) << 4); }

template <bool SWAP>
__device__ void p1_wide_body(const Params& P, int layer, int tok0, int n0, int dst0, int mode, bool gate, char* lds) {
  constexpr int TP = SWAP ? 4 : 2, TQ = SWAP ? 2 : 4;
  constexpr int STG = 8192 + 16384;
  const int tid = opaque_tid(), lane = tid & 63, wave = tid >> 6;
  const int wp = wave >> 1, wq = wave & 1;
  const unsigned rstride = layer ? 4096u : 2048u, ablk = layer ? 512u : 256u;
  const char* asrc = (const char*)P.xb1 + (long)tok0 * rstride;
  const unsigned short* wsrc = P.winT + ((long)layer * 4096 + n0) * 1024;
  float* rs = (float*)(lds + 3 * STG);
  f32x16 acc[TP][TQ];
#pragma unroll
  for (int i = 0; i < TP; ++i)
#pragma unroll
    for (int j = 0; j < TQ; ++j)
#pragma unroll
      for (int e = 0; e < 16; ++e) acc[i][j][e] = 0.f;
  unsigned ga[2], la[2], gb[4], lb[4];
#pragma unroll
  for (int i = 0; i < 2; ++i) {
    const int m = wave * 2 + i; const int row = 16 * m + (lane >> 2); const int cc = (lane & 3) ^ ((row >> 2) & 3);
    ga[i] = (unsigned)row * rstride + (unsigned)(cc * 16); la[i] = (unsigned)(m * 1024 + lane * 16);
  }
#pragma unroll
  for (int i = 0; i < 4; ++i) {
    const int m = wave * 4 + i; const int row = 16 * m + (lane >> 2); const int cc = (lane & 3) ^ ((row >> 2) & 3);
    gb[i] = (unsigned)(row * 2048 + cc * 16); lb[i] = (unsigned)(8192 + m * 1024 + lane * 16);
  }
#define PW_DMA(ks_, buf_) do { \
    const unsigned ak_ = ((unsigned)(ks_) >> 2) * ablk + ((unsigned)(ks_) & 3u) * 64u; \
    _Pragma("unroll") for (int i = 0; i < 2; ++i) __builtin_amdgcn_global_load_lds((const unsigned*)(asrc + ga[i] + ak_), (unsigned*)(lds + (buf_) * STG + la[i]), 16, 0, 0); \
    _Pragma("unroll") for (int i = 0; i < 4; ++i) __builtin_amdgcn_global_load_lds((const unsigned*)((const char*)wsrc + gb[i] + (unsigned)(ks_) * 64u), (unsigned*)(lds + (buf_) * STG + lb[i]), 16, 0, 0); } while (0)
  if (tid < 128) {
    if (layer) {
      const f32x4* sp = (const f32x4*)(P.ssqX + (long)(tok0 + tid) * 8);
      const f32x4 s0 = sp[0], s1 = sp[1];
      rs[tid] = rsqrtf((s0.x + s0.y + s0.z + s0.w + s1.x + s1.y + s1.z + s1.w) * (1.f / 1024.f) + EPSV);
    } else rs[tid] = P.rstd1[tok0 + tid];
  }
  asm volatile("s_waitcnt vmcnt(0)" ::: "memory");
  const unsigned lbase = (unsigned)(size_t)(__attribute__((address_space(3))) char*)lds;
  unsigned pa[2], qa[2];
#pragma unroll
  for (int kk = 0; kk < 2; ++kk) {
    pa[kk] = lbase + (SWAP ? 8192u : 0u) + (unsigned)swz64(32 * TP * wp + (lane & 31), 2 * kk + (lane >> 5));
    qa[kk] = lbase + (SWAP ? 0u : 8192u) + (unsigned)swz64(32 * TQ * wq + (lane & 31), 2 * kk + (lane >> 5));
  }
  PW_DMA(0, 0);
  PW_DMA(1, 1);
#define PW_COMP(so_) do { _Pragma("unroll") for (int kk = 0; kk < 2; ++kk) { \
      bf16x8 f0, f1, f2, f3, f4, f5; const unsigned pA = pa[kk] + (so_), qA = qa[kk] + (so_); \
      if (SWAP) asm volatile("ds_read_b128 %0, %6\n\tds_read_b128 %1, %6 offset:2048\n\tds_read_b128 %2, %6 offset:4096\n\tds_read_b128 %3, %6 offset:6144\n\t" \
                             "ds_read_b128 %4, %7\n\tds_read_b128 %5, %7 offset:2048\n\ts_waitcnt lgkmcnt(0)" \
                             : "=&v"(f0), "=&v"(f1), "=&v"(f2), "=&v"(f3), "=&v"(f4), "=&v"(f5) : "v"(pA), "v"(qA) : "memory"); \
      else      asm volatile("ds_read_b128 %0, %6\n\tds_read_b128 %1, %6 offset:2048\n\t" \
                             "ds_read_b128 %2, %7\n\tds_read_b128 %3, %7 offset:2048\n\tds_read_b128 %4, %7 offset:4096\n\tds_read_b128 %5, %7 offset:6144\n\ts_waitcnt lgkmcnt(0)" \
                             : "=&v"(f0), "=&v"(f1), "=&v"(f2), "=&v"(f3), "=&v"(f4), "=&v"(f5) : "v"(pA), "v"(qA) : "memory"); \
      if (SWAP) { const bf16x8 fa_[4] = {f0, f1, f2, f3}; const bf16x8 fb_[2] = {f4, f5}; \
        _Pragma("unroll") for (int i = 0; i < 4; ++i) _Pragma("unroll") for (int j = 0; j < 2; ++j) acc[i][j] = mfma32(fa_[i], fb_[j], acc[i][j]); } \
      else      { const bf16x8 fa_[2] = {f0, f1}; const bf16x8 fb_[4] = {f2, f3, f4, f5}; \
        _Pragma("unroll") for (int i = 0; i < 2; ++i) _Pragma("unroll") for (int j = 0; j < 4; ++j) acc[i][j] = mfma32(fa_[i], fb_[j], acc[i][j]); } } } while (0)
  int b0 = 0, b2 = 2;
  for (int ks = 0; ks < 31; ++ks) {
    asm volatile("s_waitcnt vmcnt(6)" ::: "memory");
    __builtin_amdgcn_s_barrier();
    if (ks + 2 < 32) PW_DMA(ks + 2, b2);
    PW_COMP((unsigned)b0 * (unsigned)STG);
    b0 = (b0 == 2) ? 0 : b0 + 1; b2 = (b2 == 2) ? 0 : b2 + 1;
  }
  asm volatile("s_waitcnt vmcnt(0)" ::: "memory");
  __builtin_amdgcn_s_barrier();
  PW_COMP((unsigned)b0 * (unsigned)STG);
#undef PW_COMP
#undef PW_DMA
  __syncthreads();
#pragma unroll
  for (int i = 0; i < TP; ++i)
#pragma unroll
    for (int j = 0; j < TQ; ++j)
#pragma unroll
      for (int e = 0; e < 16; ++e) {
        const int pl = 32 * TP * wp + 32 * i + (e & 3) + 8 * (e >> 2) + 4 * (lane >> 5);
        const int ql = 32 * TQ * wq + 32 * j + (lane & 31);
        float v = acc[i][j][e] * (SWAP ? rs[ql] : rs[pl]);
        if (gate) v = v * __builtin_amdgcn_rcpf(1.f + __expf(-v));
        acc[i][j][e] = v;
      }
  __syncthreads();
  char* S = lds;
  constexpr unsigned SROW = SWAP ? 528u : 272u;
#pragma unroll
  for (int i = 0; i < TP; ++i)
#pragma unroll
    for (int j = 0; j < TQ; ++j) {
      const unsigned ql = 32u * TQ * wq + 32u * j + (lane & 31);
#pragma unroll
      for (int g4 = 0; g4 < 4; ++g4) {
        const unsigned pl = 32u * TP * wp + 32u * i + 8u * g4 + 4u * (lane >> 5);
        *(u32x2*)(S + ql * SROW + pl * 2u) = mk2(pack2(acc[i][j][4 * g4], acc[i][j][4 * g4 + 1]), pack2(acc[i][j][4 * g4 + 2], acc[i][j][4 * g4 + 3]));
      }
    }
  __syncthreads();
#pragma unroll 4
  for (int it = 0; it < 16; ++it) {
    const unsigned id = tid + 256u * it;
    if (!SWAP) {
      const unsigned row = id >> 4, c16 = id & 15u;
      const u32x4 v = *(const u32x4*)(S + row * 272u + c16 * 16u);
      *(u32x4*)((char*)P.zT + ((unsigned)(dst0 + row) * (unsigned)NTOK + tok0 + c16 * 8u) * 2u) = v;
    } else {
      const unsigned row = id >> 5, c32 = id & 31u;
      u32x4 v = *(const u32x4*)(S + row * 528u + c32 * 16u);
      if (mode) {
        float f[8]; unpack8(v, f);
        float ss = 0.f;
#pragma unroll
        for (int e = 0; e < 8; ++e) ss += f[e] * f[e];
        ss += __shfl_xor(ss, 1); ss += __shfl_xor(ss, 2); ss += __shfl_xor(ss, 4);
        float sc = rsqrtf(ss * (1.f / 64.f) + EPSV);
        if (mode == 1) sc *= 0.125f * LOG2E;
        const float* g = (mode == 1 ? P.qn_g : P.kn_g) + layer * 64 + (c32 & 7) * 8;
#pragma unroll
        for (int e = 0; e < 8; ++e) f[e] *= sc * g[e];
        v = mk4(pack2(f[0], f[1]), pack2(f[2], f[3]), pack2(f[4], f[5]), pack2(f[6], f[7]));
      }
      *(u32x4*)((char*)P.z2 + (((unsigned)(tok0 + row) * 1536u + dst0 + c32 * 8u) * 2u)) = v;
    }
  }
  __syncthreads();
}

__device__ void p1_tile_wide(const Params& P, int layer, int mt, int nt, char* lds) {
  const int tok0 = mt * 128, n0 = nt * 256;
  if (n0 < 1536)       p1_wide_body<false>(P, layer, tok0, n0, n0, 0, false, lds);
  else if (n0 < 2048)  p1_wide_body<false>(P, layer, tok0, n0, 2048 + (n0 - 1536), 0, true, lds);
  else if (n0 < 2560)  p1_wide_body<true>(P, layer, tok0, n0, n0 - 2048, 1, false, lds);
  else if (n0 < 3072)  p1_wide_body<true>(P, layer, tok0, n0, 512 + (n0 - 2560), 2, false, lds);
  else if (n0 < 3584)  p1_wide_body<false>(P, layer, tok0, n0, 1536 + (n0 - 3072), 0, false, lds);
  else                 p1_wide_body<true>(P, layer, tok0, n0, 1024 + (n0 - 3584), 0, true, lds);
}

__device__ void phase_p1(const Params& P, int layer, int bid, int nb, char* lds, int variant) {
  if (variant == 0) {
    for (int v = bid; v < 6144; v += nb) {
      const int wv = v >> 9, within = v & 511, x = within & 7, idx = within >> 3;
      const int mt = wv * 32 + (x >> 1) * 8 + (idx >> 3);
      const int nt = (x & 1) * 8 + (idx & 7);
      p1_tile_wide(P, layer, mt, nt, lds);
    }
    return;
  }
  for (int v = bid; v < 12288; v += nb) {
    int wv = v >> 9, within = v & 511, x = within & 7, idx = within >> 3;
    int mt = wv * 16 + (x >> 2) * 8 + (idx >> 3);
    int nt = (x & 3) * 8 + (idx & 7);
    p1_tile(P, layer, mt, nt, lds, variant);
  }
}

template <int L, int NBP>
__device__ void conv_unit(const Params& P, int layer, int set, int c, int bp0, char* lds) {
  constexpr int NB = L / 32, UB = (NB + 32) * 64, WPB = 4 / NBP, NSTEP = NB / 16 + 1;
  static_assert(NB / WPB == 64, "each wave owns 64 output blocks (4 N-tiles)");
  char* U = lds; char* F = lds + NBP * 2 * UB;
  const int tid = opaque_tid(), lane = tid & 63, wave = tid >> 6;
  const long setbase = (long)(set ? NPTOK : 0) + (long)(2 * bp0) * L;
  const unsigned short* x0r = P.zT + (long)c * NTOK + setbase;
  const unsigned short* x1r = P.zT + (long)(512 + c) * NTOK + setbase;
  const unsigned short* vr = P.zT + (long)(1024 + c) * NTOK + setbase;
  const float* cw = P.conv_w + layer * 3 * 1536; const float* cb = P.conv_b + layer * 1536;
  {
    const float w1a = cw[512 + c], w1b = cw[1536 + 512 + c], w1c = cw[3072 + 512 + c], b1 = cb[512 + c];
    const float wva = cw[1024 + c], wvb = cw[1536 + 1024 + c], wvc = cw[3072 + 1024 + c], bvv = cb[1024 + c];
#pragma unroll
    for (int pp = 0; pp < NBP; ++pp) {
      const int id = tid + 256 * pp; const int pb = id >> 7; const int rem = id & 127; const int side = rem >> 6; const int o = rem & 63;
      *(u32x4*)(U + pb * UB + (side ? (NB + 16) * 64 : 0) + o * 16) = mk4(0, 0, 0, 0);
    }
    static_assert(NBP * 2 * L / 8 == 8 * 256 && 2 * L / 8 <= 8 * 256, "staging loops are written for 8 rounds");
    static_assert(NBP * 2 * L / 8 == 8 * 256, "8 chunks per thread");
#pragma unroll 1
    for (int hf = 0; hf < 2; ++hf) {
      u32x4 XA[4], XB[4]; float HX0[4], HX9[4], HV0[4], HV9[4];
#pragma unroll
      for (int q = 0; q < 4; ++q) {
        const unsigned id = tid + 256u * (4 * hf + q); const unsigned pb = id / (L / 8); const unsigned t8 = (id % (L / 8)) * 8;
        const unsigned bo = (pb * L + t8) * 2u;
        XA[q] = *(const u32x4*)((const char*)x1r + bo); XB[q] = *(const u32x4*)((const char*)vr + bo);
        const unsigned lo_ = t8 > 0 ? bo - 2u : bo, hi_ = (t8 + 8 < (unsigned)L) ? bo + 16u : bo;
        const float xl = bf2f(*(const unsigned short*)((const char*)x1r + lo_)), xh = bf2f(*(const unsigned short*)((const char*)x1r + hi_));
        const float vl = bf2f(*(const unsigned short*)((const char*)vr + lo_)), vh = bf2f(*(const unsigned short*)((const char*)vr + hi_));
        HX0[q] = t8 > 0 ? xl : 0.f; HX9[q] = (t8 + 8 < (unsigned)L) ? xh : 0.f;
        HV0[q] = t8 > 0 ? vl : 0.f; HV9[q] = (t8 + 8 < (unsigned)L) ? vh : 0.f;
      }
#pragma unroll
      for (int q = 0; q < 4; ++q) {
        const unsigned id = tid + 256u * (4 * hf + q); const unsigned pb = id / (L / 8); const unsigned t8 = (id % (L / 8)) * 8;
        const u32x4 xa = XA[q], xb = XB[q];
        const float x0_ = HX0[q], x1_ = lo2f(xa.x), x2_ = hi2f(xa.x), x3_ = lo2f(xa.y), x4_ = hi2f(xa.y),
                    x5_ = lo2f(xa.z), x6_ = hi2f(xa.z), x7_ = lo2f(xa.w), x8_ = hi2f(xa.w), x9_ = HX9[q];
        const float v0_ = HV0[q], v1_ = lo2f(xb.x), v2_ = hi2f(xb.x), v3_ = lo2f(xb.y), v4_ = hi2f(xb.y),
                    v5_ = lo2f(xb.z), v6_ = hi2f(xb.z), v7_ = lo2f(xb.w), v8_ = hi2f(xb.w), v9_ = HV9[q];
#define CU_(xm, xc, xp, vm, vc, vp) ((w1a * (xm) + w1b * (xc) + w1c * (xp) + b1) * (wva * (vm) + wvb * (vc) + wvc * (vp) + bvv))
        const float u0 = CU_(x0_, x1_, x2_, v0_, v1_, v2_), u1 = CU_(x1_, x2_, x3_, v1_, v2_, v3_);
        const float u2 = CU_(x2_, x3_, x4_, v2_, v3_, v4_), u3 = CU_(x3_, x4_, x5_, v3_, v4_, v5_);
        const float u4 = CU_(x4_, x5_, x6_, v4_, v5_, v6_), u5 = CU_(x5_, x6_, x7_, v5_, v6_, v7_);
        const float u6 = CU_(x6_, x7_, x8_, v6_, v7_, v8_), u7 = CU_(x7_, x8_, x9_, v7_, v8_, v9_);
#undef CU_
        const unsigned blk = (t8 >> 5) + 16; const unsigned chunk = (t8 >> 3) & 3;
        *(u32x4*)(U + pb * UB + blk * 64 + ((chunk ^ ((blk >> 2) & 3)) << 4)) = mk4(pack2(u0, u1), pack2(u2, u3), pack2(u4, u5), pack2(u6, u7));
      }
    }
    const unsigned short* fsrc = P.filt + ((long)(layer * 512 + c)) * 24576 + (set ? 16384 : 0);
#pragma unroll
    for (int rd = 0; rd < 2 * L / 8 / 256; ++rd) { const int id = tid + 256 * rd; *(u32x4*)(F + id * 16) = *(const u32x4*)(fsrc + id * 8); }
    if (tid < 8) *(u32x4*)(F + 2 * L * 2 + tid * 16) = mk4(0, 0, 0, 0);
  }
  __syncthreads();

  const int pw = wave / WPB;
  const int T0w = (wave % WPB) * 64;
  const int ii = lane & 31, h = lane >> 5;
  const int bb = (lane >> 4) & 1, mm = lane & 15;
  const char* Uw = U + (pw * 2 + bb) * UB;
  const int base0 = L - ii + 8 * h;
  const int wdw = base0 >> 1; const unsigned sh = (unsigned)(base0 & 1) * 16u;
  f32x16 acc[4];
#pragma unroll
  for (int r = 0; r < 4; ++r)
#pragma unroll
    for (int e = 0; e < 16; ++e) acc[r][e] = 0.f;
  bf16x8 Ar[4][2];
  unsigned raw[2][5];

#define LOADA_RAW(ptr_) do { const unsigned* fp_ = (const unsigned*)(ptr_); \
    _Pragma("unroll") for (int j_ = 0; j_ < 5; ++j_) { raw[0][j_] = fp_[j_]; raw[1][j_] = fp_[8 + j_]; } } while (0)
#define FIXA(dst_) do { _Pragma("unroll") for (int k_ = 0; k_ < 2; ++k_) { union { unsigned u[4]; bf16x8 f; } x_; \
    _Pragma("unroll") for (int j_ = 0; j_ < 4; ++j_) x_.u[j_] = __builtin_amdgcn_alignbit(raw[k_][j_ + 1], raw[k_][j_], sh); \
    (dst_)[k_] = x_.f; } } while (0)
#define LOADB(dst_, q_) do { (dst_)[0] = *(const bf16x8*)(ub0 + 1024 * (q_)); (dst_)[1] = *(const bf16x8*)(ub1 + 1024 * (q_)); } while (0)
#define MMAS(u_, B_) do { _Pragma("unroll") for (int r_ = 0; r_ < 4; ++r_) { \
    acc[r_] = mfma32(Ar[(r_ - (u_) + 4) & 3][0], (B_)[0], acc[r_]); \
    acc[r_] = mfma32(Ar[(r_ - (u_) + 4) & 3][1], (B_)[1], acc[r_]); } } while (0)

  for (int e = 0; e < 16; ++e) {
    const int sb0 = e - 15;
    const int D0 = T0w - sb0;
    const char* fa = F + 4 * wdw - 64 * D0;
    const int blk0 = sb0 + mm + 16; const int swz = (blk0 >> 2) & 3;
    const char* ub0 = Uw + blk0 * 64 + ((h ^ swz) << 4);
    const char* ub1 = Uw + blk0 * 64 + (((2 + h) ^ swz) << 4);
    unsigned rawp[3][2][5];
#pragma unroll
    for (int s_ = 1; s_ < 4; ++s_) { const unsigned* fp_ = (const unsigned*)(fa - 1024 * s_);
#pragma unroll
      for (int j_ = 0; j_ < 5; ++j_) { rawp[s_ - 1][0][j_] = fp_[j_]; rawp[s_ - 1][1][j_] = fp_[8 + j_]; } }
    bf16x8 Bc[2], Bn[2];
    LOADA_RAW(fa); LOADB(Bc, 0);
#pragma unroll
    for (int s_ = 1; s_ < 4; ++s_) {
#pragma unroll
      for (int k_ = 0; k_ < 2; ++k_) { union { unsigned u[4]; bf16x8 f; } x_;
#pragma unroll
        for (int j_ = 0; j_ < 4; ++j_) x_.u[j_] = __builtin_amdgcn_alignbit(rawp[s_ - 1][k_][j_ + 1], rawp[s_ - 1][k_][j_], sh);
        Ar[s_][k_] = x_.f; }
    }
    for (int Q = 0; Q < (NSTEP - 1) / 4; ++Q) {
      const char* fq = fa + 4096 * Q;
      const int q0 = 4 * Q;
      FIXA(Ar[0]); LOADA_RAW(fq + 1024); LOADB(Bn, q0 + 1); __builtin_amdgcn_sched_barrier(0);
      MMAS(0, Bc); __builtin_amdgcn_sched_barrier(0);
      FIXA(Ar[3]); LOADA_RAW(fq + 2048); LOADB(Bc, q0 + 2); __builtin_amdgcn_sched_barrier(0);
      MMAS(1, Bn); __builtin_amdgcn_sched_barrier(0);
      FIXA(Ar[2]); LOADA_RAW(fq + 3072); LOADB(Bn, q0 + 3); __builtin_amdgcn_sched_barrier(0);
      MMAS(2, Bc); __builtin_amdgcn_sched_barrier(0);
      FIXA(Ar[1]); LOADA_RAW(fq + 4096); LOADB(Bc, q0 + 4); __builtin_amdgcn_sched_barrier(0);
      MMAS(3, Bn); __builtin_amdgcn_sched_barrier(0);
    }
    FIXA(Ar[0]);
    MMAS(0, Bc);
  }
#undef LOADA_RAW
#undef FIXA
#undef LOADB
#undef MMAS
  {
    const float hb = P.hy_bias[layer * 512 + c];
    const float w0a = cw[c], w0b = cw[1536 + c], w0c = cw[3072 + c], b0 = cb[c];
    const long boff = (long)(pw * 2 + bb) * L;
    unsigned short* yout = P.zT + (long)(512 + c) * NTOK + setbase + boff;
    unsigned short* ygout = P.zT + (long)(1024 + c) * NTOK + setbase + boff;
    const unsigned short* sgr = P.zT + (long)(2048 + c) * NTOK + setbase + boff;
    const unsigned short* x0b = x0r + boff;
#pragma unroll
    for (int r = 0; r < 4; ++r) {
      const int t0 = T0w + 16 * r + mm; const int blk = t0 + 16;
#pragma unroll
      for (int g4 = 0; g4 < 4; ++g4) {
        const int t = t0 * 32 + 8 * g4 + 4 * h;
        u32x2 uv = *(const u32x2*)(Uw + blk * 64 + ((g4 ^ ((blk >> 2) & 3)) << 4) + 8 * h);
        const unsigned short* xp = x0b + t;
        u32x2 xv = *(const u32x2*)xp;
        float xs[6];
        xs[0] = t > 0 ? bf2f(xp[-1]) : 0.f; xs[5] = (t + 4 < L) ? bf2f(xp[4]) : 0.f;
        xs[1] = lo2f(xv.x); xs[2] = hi2f(xv.x); xs[3] = lo2f(xv.y); xs[4] = hi2f(xv.y);
        float us[4] = {lo2f(uv.x), hi2f(uv.x), lo2f(uv.y), hi2f(uv.y)};
        float o[4];
#pragma unroll
        for (int e = 0; e < 4; ++e) {
          float x0c = w0a * xs[e] + w0b * xs[e + 1] + w0c * xs[e + 2] + b0;
          float y = acc[r][4 * g4 + e] + hb * us[e];
          o[e] = x0c * y;
        }
        *(u32x2*)(yout + t) = mk2(pack2(o[0], o[1]), pack2(o[2], o[3]));
        const u32x2 sgv = *(const u32x2*)(sgr + t);
        *(u32x2*)(ygout + t) = mk2(pack2(o[0] * lo2f(sgv.x), o[1] * hi2f(sgv.x)), pack2(o[2] * lo2f(sgv.y), o[3] * hi2f(sgv.y)));
      }
    }
  }
  __syncthreads();
}

__device__ void attn_unit(const Params& P, int layer, int a, char* lds) {
  float* rp = (float*)lds;
  const int tid = opaque_tid(), lane = tid & 63, wave = tid >> 6;
  const int hd = a & 7, rowg = a >> 3;
  int rows, r;
  if (rowg < 512) { rows = 128; r = rowg & 127; } else { rows = 64; r = (rowg - 512) & 63; }
  const int rowbase = rowg - r;
  const int r0 = min(max(r - 4, 0), rows - 8);
  for (int i = tid; i < 465; i += 256) rp[i] = P.rpb[(layer * 8 + hd) * 465 + i] * LOG2E;
  __syncthreads();
  const int c0 = wave * 16; const int kc0 = min(max(c0 - 8, 0), 32);
  const int qi = lane & 15, g = lane >> 4;
  const long qtok = (long)rowg * 64 + c0 + qi;
  const unsigned short* qptr = P.z2 + qtok * 1536 + hd * 64 + 8 * g;
  const bf16x8 Qf0 = *(const bf16x8*)qptr, Qf1 = *(const bf16x8*)(qptr + 32);
  f32x4 S[16];
  const long bandtok = (long)(rowbase + r0) * 64;
  {
    bf16x8 Kf[16][2];
#pragma unroll
    for (int T = 0; T < 16; ++T) {
      const int kr = T >> 1, half = T & 1;
      const unsigned ktok = (unsigned)bandtok + kr * 64 + kc0 + 8 * (qi >> 2) + (qi & 3) + 4 * half;
      const unsigned ko = (ktok * 1536u + 512u + hd * 64 + 8 * g) * 2u;
      Kf[T][0] = *(const bf16x8*)((const char*)P.z2 + ko); Kf[T][1] = *(const bf16x8*)((const char*)P.z2 + (ko + 64u));
    }
    __builtin_amdgcn_sched_barrier(0);
#pragma unroll
    for (int T = 0; T < 16; ++T) {
      f32x4 s_ = {0.f, 0.f, 0.f, 0.f};
      s_ = mfma16(Kf[T][0], Qf0, s_); s_ = mfma16(Kf[T][1], Qf1, s_);
      S[T] = s_;
    }
  }
  bf16x8 Vf[8][4];
  const unsigned vo0 = ((unsigned)(1536 + hd * 64 + qi) * (unsigned)NTOK + (unsigned)bandtok + kc0 + 8 * g) * 2u;
#define ATT_VLOAD(kr_) do { _Pragma("unroll") for (int dt = 0; dt < 4; ++dt) \
    Vf[kr_][dt] = *(const bf16x8*)((const char*)P.zT + (vo0 + (unsigned)dt * (16u * NTOK * 2u) + (unsigned)(kr_) * 128u)); } while (0)
#pragma unroll
  for (int kr = 0; kr < 4; ++kr) ATT_VLOAD(kr);
  __builtin_amdgcn_sched_barrier(0);
  const int qc = c0 + qi; const int cs = min(max(qc - 8, 0), 48);
  float mx = -1e30f;
#pragma unroll
  for (int T = 0; T < 16; ++T) {
    const int kr = T >> 1, half = T & 1;
    const int ro = r0 + kr - r + 7;
#pragma unroll
    for (int e = 0; e < 4; ++e) {
      const int kc = kc0 + 8 * g + e + 4 * half;
      const bool valid = (kc >= cs) && (kc < cs + 16);
      const int idx = valid ? (ro * 31 + kc - qc + 15) : 0;
      float v = valid ? (S[T][e] + rp[idx]) : -1e30f;
      S[T][e] = v; mx = fmaxf(mx, v);
    }
  }
  mx = fmaxf(mx, __shfl_xor(mx, 16)); mx = fmaxf(mx, __shfl_xor(mx, 32));
  float sum = 0.f;
#pragma unroll
  for (int T = 0; T < 16; ++T)
#pragma unroll
    for (int e = 0; e < 4; ++e) { float p = exp2f(S[T][e] - mx); S[T][e] = p; sum += p; }
  sum += __shfl_xor(sum, 16); sum += __shfl_xor(sum, 32);
#pragma unroll
  for (int kr = 4; kr < 8; ++kr) ATT_VLOAD(kr);
#undef ATT_VLOAD
  f32x4 O[4];
#pragma unroll
  for (int dt = 0; dt < 4; ++dt) O[dt] = (f32x4){0.f, 0.f, 0.f, 0.f};
#pragma unroll
  for (int kr = 0; kr < 8; ++kr) {
    union { unsigned u[4]; bf16x8 f; } pf;
    pf.u[0] = pack2(S[2 * kr][0], S[2 * kr][1]); pf.u[1] = pack2(S[2 * kr][2], S[2 * kr][3]);
    pf.u[2] = pack2(S[2 * kr + 1][0], S[2 * kr + 1][1]); pf.u[3] = pack2(S[2 * kr + 1][2], S[2 * kr + 1][3]);
#pragma unroll
    for (int dt = 0; dt < 4; ++dt) O[dt] = mfma16(Vf[kr][dt], pf.f, O[dt]);
  }
  const float inv = 1.f / sum; float ss = 0.f;
#pragma unroll
  for (int dt = 0; dt < 4; ++dt) {
    float o[4];
#pragma unroll
    for (int e = 0; e < 4; ++e) { o[e] = O[dt][e] * inv; ss += o[e] * o[e]; }
    const u32x2 sgv = *(const u32x2*)(P.z2 + qtok * 1536 + 1024 + hd * 64 + 16 * dt + 4 * g);
    *(u32x2*)(P.z2 + qtok * 1536 + hd * 64 + 16 * dt + 4 * g) = mk2(pack2(o[0] * lo2f(sgv.x), o[1] * hi2f(sgv.x)), pack2(o[2] * lo2f(sgv.y), o[3] * hi2f(sgv.y)));
  }
  ss += __shfl_xor(ss, 16); ss += __shfl_xor(ss, 32);
  if (g == 0) P.ssqA[qtok * 8 + hd] = ss;
  __syncthreads();
}

__device__ void phase_p2(const Params& P, int layer, int bid, int nb, char* lds, int what) {
  const bool attn_first = (what == 3) && (bid >= (nb >> 1));
  if (attn_first) for (int a = bid; a < 6144; a += nb) attn_unit(P, layer, a, lds);
  if (what & 1) for (int u = bid; u < 1536; u += nb) {
    if (u < 1024) conv_unit<8192, 1>(P, layer, 0, u & 511, u >> 9, lds);
    else conv_unit<4096, 2>(P, layer, 1, u - 1024, 0, lds);
  }
  if ((what & 2) && !attn_first) for (int a = bid; a < 6144; a += nb) attn_unit(P, layer, a, lds);
}

__device__ void phase_hyT(const Params& P, int bid, int nb, char* lds) {
  const int tid = opaque_tid(), lane = tid & 63, wave = tid >> 6;
  const int krow = tid >> 4, tc = tid & 15;
  char* Tk = lds;
  float* red = (float*)(lds + 64 * 264);
  for (int u = bid; u < 3072; u += nb) {
    const int mt = u >> 3, g = u & 7; const int tok0 = mt * 128;
    float ssh[8];
#pragma unroll
    for (int e = 0; e < 8; ++e) ssh[e] = 0.f;
#pragma unroll
    for (int i = 0; i < 4; ++i) {
      const int k = krow + 16 * i;
      const u32x4 raw = ldg16(P.zT, (unsigned)(((512 + 64 * g + k) * NTOK + tok0 + 8 * tc) * 2));
      const u32x4 gat = ldg16(P.zT, (unsigned)(((1024 + 64 * g + k) * NTOK + tok0 + 8 * tc) * 2));
      float y[8]; unpack8(raw, y);
#pragma unroll
      for (int e = 0; e < 8; ++e) ssh[e] += y[e] * y[e];
      *(u32x2*)(Tk + k * 264 + tc * 16) = mk2(gat.x, gat.y);
      *(u32x2*)(Tk + k * 264 + tc * 16 + 8) = mk2(gat.z, gat.w);
    }
#pragma unroll
    for (int e = 0; e < 8; ++e) {
      float s_ = ssh[e];
      s_ += __shfl_xor(s_, 16); s_ += __shfl_xor(s_, 32);
      if (lane < 16) red[wave * 128 + 8 * tc + e] = s_;
    }
    __syncthreads();
    if (tid < 128) P.ssqH[(long)(tok0 + tid) * 8 + g] = red[tid] + red[128 + tid] + red[256 + tid] + red[384 + tid];
#pragma unroll
    for (int i = 0; i < 4; ++i) {
      const int id = tid + 256 * i; const int tok = id >> 3, kc = id & 7;
      unsigned short v[8];
#pragma unroll
      for (int e = 0; e < 8; ++e) v[e] = *(const unsigned short*)(Tk + (8 * kc + e) * 264 + tok * 2);
      *(u32x4*)(P.z2 + (long)(tok0 + tok) * 1536 + 512 + 64 * g + 8 * kc) =
          mk4((unsigned)v[0] | ((unsigned)v[1] << 16), (unsigned)v[2] | ((unsigned)v[3] << 16),
              (unsigned)v[4] | ((unsigned)v[5] << 16), (unsigned)v[6] | ((unsigned)v[7] << 16));
    }
    __syncthreads();
  }
}

__device__ void p3_tile(const Params& P, int layer, int mt, int nt, char* lds) {
  constexpr int ASTR = 272, STG = 64 * ASTR + 16384;
  const int tid = opaque_tid(), lane = tid & 63, wave = tid >> 6;
  const int tok0 = mt * 128, n0 = nt * 128;
  const unsigned short* wsrc = P.woutT + ((long)layer * 1024 + n0) * 1024;
  const float* xres = (layer == 0) ? ((tok0 < NPTOK) ? P.xp + (long)tok0 * 1024 : P.xs + (long)(tok0 - NPTOK) * 1024)
                                   : P.out + (long)tok0 * 1024;
  float* rh = (float*)(lds + 2 * STG); float* ra = rh + 128;
  if (tid < 128) {
    const f32x4* sp = (const f32x4*)(P.ssqA + (long)(tok0 + tid) * 8);
    f32x4 s0 = sp[0], s1 = sp[1];
    const float rat = rsqrtf((s0.x + s0.y + s0.z + s0.w + s1.x + s1.y + s1.z + s1.w) * (1.f / 512.f) + EPSV);
    const f32x4* hp = (const f32x4*)(P.ssqH + (long)(tok0 + tid) * 8);
    f32x4 h0 = hp[0], h1 = hp[1];
    const float rht = rsqrtf((h0.x + h0.y + h0.z + h0.w + h1.x + h1.y + h1.z + h1.w) * (1.f / 512.f) + EPSV);
    ra[tid] = rat;
    rh[tid] = rht / rat;
  }
  const int wp = wave >> 1, wq = wave & 1;
  const int r8 = tid >> 3, ch = tid & 7;
  const int kr = tid >> 4, tc = tid & 15;
  f32x16 acc[2][2];
#pragma unroll
  for (int i = 0; i < 2; ++i)
#pragma unroll
    for (int j = 0; j < 2; ++j)
#pragma unroll
      for (int e = 0; e < 16; ++e) acc[i][j][e] = 0.f;
  u32x4 gv[4], bv[4];
  const unsigned yg_off = (unsigned)(((1024 + kr) * NTOK + tok0 + 8 * tc) * 2);
  const unsigned at_off = (unsigned)(((tok0 + r8) * 1536 + 8 * ch) * 2);
  const unsigned b_off = (unsigned)((r8 * 1024 + ch * 8) * 2);
#define P3_LOAD_HY(k_) do { _Pragma("unroll") for (int i = 0; i < 4; ++i) { \
    gv[i] = ldg16(P.zT, yg_off + (unsigned)(k_) * (64u * NTOK * 2u) + (unsigned)i * (16u * NTOK * 2u)); \
    bv[i] = ldg16(wsrc, b_off + (unsigned)(k_) * 128u + (unsigned)i * 65536u); } } while (0)
#define P3_LOAD_AT(k_) do { _Pragma("unroll") for (int i = 0; i < 4; ++i) { \
    gv[i] = ldg16(P.z2, at_off + (unsigned)((k_) - 8) * 128u + (unsigned)i * (32u * 1536u * 2u)); \
    bv[i] = ldg16(wsrc, b_off + (unsigned)(k_) * 128u + (unsigned)i * 65536u); } } while (0)
#define P3_STORE_HY(buf_) do { char* A_ = lds + (buf_) * STG; char* B_ = A_ + 64 * ASTR; \
    _Pragma("unroll") for (int i = 0; i < 4; ++i) { *(u32x4*)(A_ + (kr + 16 * i) * ASTR + tc * 16) = gv[i]; \
      *(u32x4*)(B_ + swz_off(r8 + 32 * i, ch)) = bv[i]; } } while (0)
#define P3_STORE_AT(buf_) do { char* A_ = lds + (buf_) * STG; char* B_ = A_ + 64 * ASTR; \
    _Pragma("unroll") for (int i = 0; i < 4; ++i) { *(u32x4*)(A_ + swz_off(r8 + 32 * i, ch)) = gv[i]; \
      *(u32x4*)(B_ + swz_off(r8 + 32 * i, ch)) = bv[i]; } } while (0)
#define P3_MMA_HY(cur_) do { const char* As = lds + (cur_) * STG; const char* Bs = As + 64 * ASTR; \
    _Pragma("unroll") for (int kk = 0; kk < 4; ++kk) { bf16x8 a[2], b[2]; \
      _Pragma("unroll") for (int i = 0; i < 2; ++i) { \
        const int l16 = lane & 15; const int krow = 16 * kk + 8 * (lane >> 5) + (l16 >> 2); \
        const int tcol = 64 * wp + 32 * i + 16 * ((lane >> 4) & 1) + 4 * (l16 & 3); \
        lds_cptr ap = (lds_cptr)As + krow * ASTR + tcol * 2; \
        s16x4 lo = __builtin_bit_cast(s16x4, __builtin_amdgcn_ds_read_tr16_b64_v4i16((__attribute__((address_space(3))) v4i16_t*)ap)); \
        s16x4 hi = __builtin_bit_cast(s16x4, __builtin_amdgcn_ds_read_tr16_b64_v4i16((__attribute__((address_space(3))) v4i16_t*)(ap + 4 * ASTR))); \
        a[i] = (bf16x8){lo[0], lo[1], lo[2], lo[3], hi[0], hi[1], hi[2], hi[3]}; } \
      _Pragma("unroll") for (int j = 0; j < 2; ++j) b[j] = *(const bf16x8*)(Bs + swz_off(64 * wq + 32 * j + (lane & 31), 2 * kk + (lane >> 5))); \
      _Pragma("unroll") for (int i = 0; i < 2; ++i) _Pragma("unroll") for (int j = 0; j < 2; ++j) acc[i][j] = mfma32(a[i], b[j], acc[i][j]); } } while (0)
#define P3_MMA_AT(cur_) do { const char* As = lds + (cur_) * STG; const char* Bs = As + 64 * ASTR; \
    _Pragma("unroll") for (int kk = 0; kk < 4; ++kk) { bf16x8 a[2], b[2]; \
      _Pragma("unroll") for (int i = 0; i < 2; ++i) a[i] = *(const bf16x8*)(As + swz_off(64 * wp + 32 * i + (lane & 31), 2 * kk + (lane >> 5))); \
      _Pragma("unroll") for (int j = 0; j < 2; ++j) b[j] = *(const bf16x8*)(Bs + swz_off(64 * wq + 32 * j + (lane & 31), 2 * kk + (lane >> 5))); \
      _Pragma("unroll") for (int i = 0; i < 2; ++i) _Pragma("unroll") for (int j = 0; j < 2; ++j) acc[i][j] = mfma32(a[i], b[j], acc[i][j]); } } while (0)
  P3_LOAD_HY(0);
  P3_STORE_HY(0);
  P3_LOAD_HY(1);
  __syncthreads();
  for (int ks = 0; ks < 6; ++ks) {
    const int cur = ks & 1;
    P3_STORE_HY(cur ^ 1);
    P3_LOAD_HY(ks + 2);
    P3_MMA_HY(cur);
    __syncthreads();
  }
  P3_STORE_HY(1); P3_LOAD_AT(8); P3_MMA_HY(0); __syncthreads();
  P3_STORE_AT(0); P3_LOAD_AT(9); P3_MMA_HY(1); __syncthreads();
#pragma unroll
  for (int i = 0; i < 2; ++i)
#pragma unroll
    for (int e = 0; e < 16; ++e) {
      const float sc = rh[64 * wp + 32 * i + (e & 3) + 8 * (e >> 2) + 4 * (lane >> 5)];
      acc[i][0][e] *= sc; acc[i][1][e] *= sc;
    }
  for (int ks = 8; ks < 16; ++ks) {
    const int cur = ks & 1;
    if (ks + 1 < 16) P3_STORE_AT(cur ^ 1);
    if (ks + 2 < 16) P3_LOAD_AT(ks + 2);
    P3_MMA_AT(cur);
    __syncthreads();
  }
#undef P3_LOAD_HY
#undef P3_LOAD_AT
#undef P3_STORE_HY
#undef P3_STORE_AT
#undef P3_MMA_HY
#undef P3_MMA_AT
  char* blk = (char*)P.out + (long)tok0 * 4096 + nt * 512;
  char* Sh = lds; char* Sl = lds + 34816;
#pragma unroll
  for (int i = 0; i < 2; ++i)
#pragma unroll
    for (int e = 0; e < 16; ++e) {
      const float sc = ra[64 * wp + 32 * i + (e & 3) + 8 * (e >> 2) + 4 * (lane >> 5)];
      acc[i][0][e] *= sc; acc[i][1][e] *= sc;
    }
  __syncthreads();
  if (layer == 0) {
#pragma unroll
    for (int i = 0; i < 2; ++i)
#pragma unroll
      for (int j = 0; j < 2; ++j) {
        const int nl = 64 * wq + 32 * j + (lane & 31);
#pragma unroll
        for (int e = 0; e < 16; ++e) {
          const int r = 64 * wp + 32 * i + (e & 3) + 8 * (e >> 2) + 4 * (lane >> 5);
          const float v = xres[(long)r * 1024 + n0 + nl] + acc[i][j][e];
          const unsigned ph = pack2(v, 0.f);
          const unsigned pl = pack2(v - lo2f(ph), 0.f);
          *(unsigned short*)(Sh + r * 272 + nl * 2) = (unsigned short)ph;
          *(unsigned short*)(Sl + r * 272 + nl * 2) = (unsigned short)pl;
        }
      }
    __syncthreads();
#pragma unroll
    for (int it = 0; it < 16; ++it) {
      const int id = tid + 256 * it; const int half = id >> 11, row = (id >> 4) & 127, c16 = id & 15;
      const u32x4 cv = *(const u32x4*)((half ? Sl : Sh) + row * 272 + c16 * 16);
      *(u32x4*)(blk + row * 4096 + half * 256 + c16 * 16) = cv;
      if (it < 8) {
        float f[8]; unpack8(cv, f);
        float ss = 0.f;
#pragma unroll
        for (int e = 0; e < 8; ++e) ss += f[e] * f[e];
        ss += __shfl_xor(ss, 1); ss += __shfl_xor(ss, 2); ss += __shfl_xor(ss, 4); ss += __shfl_xor(ss, 8);
        if (c16 == 0) P.ssqX[(long)(tok0 + row) * 8 + nt] = ss;
      }
    }
  } else {
#pragma unroll
    for (int it = 0; it < 16; ++it) {
      const int id = tid + 256 * it; const int half = id >> 11, row = (id >> 4) & 127, c16 = id & 15;
      *(u32x4*)((half ? Sl : Sh) + row * 272 + c16 * 16) = *(const u32x4*)(blk + row * 4096 + half * 256 + c16 * 16);
    }
    __syncthreads();
#pragma unroll
    for (int i = 0; i < 2; ++i)
#pragma unroll
      for (int j = 0; j < 2; ++j) {
        const int nl = 64 * wq + 32 * j + (lane & 31);
#pragma unroll
        for (int e = 0; e < 16; ++e) {
          const int r = 64 * wp + 32 * i + (e & 3) + 8 * (e >> 2) + 4 * (lane >> 5);
          const float xh = bf2f(*(const unsigned short*)(Sh + r * 272 + nl * 2));
          const float xl = bf2f(*(const unsigned short*)(Sl + r * 272 + nl * 2));
          *(float*)(blk + r * 4096 + nl * 4) = (xh + xl) + acc[i][j][e];
        }
      }
  }
  __syncthreads();
}

__device__ void p3_wide(const Params& P, int layer, int mt, int nt, char* lds) {
  constexpr int STG = 8192 + 16384;
  const int tid = opaque_tid(), lane = tid & 63, wave = tid >> 6;
  const int wp = wave >> 1, wq = wave & 1;
  const int tok0 = mt * 128, n0 = nt * 256;
  const char* asrc = (const char*)P.z2 + (long)tok0 * 3072;
  const unsigned short* wsrc = P.woutT + ((long)layer * 1024 + n0) * 1024;
  const float* xres = (tok0 < NPTOK) ? P.xp + (long)tok0 * 1024 : P.xs + (long)(tok0 - NPTOK) * 1024;
  float* rh = (float*)(lds + 2 * STG); float* ra = rh + 128;
  f32x16 acc[2][4];
#pragma unroll
  for (int i = 0; i < 2; ++i)
#pragma unroll
    for (int j = 0; j < 4; ++j)
#pragma unroll
      for (int e = 0; e < 16; ++e) acc[i][j][e] = 0.f;
  unsigned ga[2], la[2], gb[4], lb[4];
#pragma unroll
  for (int i = 0; i < 2; ++i) {
    const int m = wave * 2 + i; const int row = 16 * m + (lane >> 2); const int cc = (lane & 3) ^ ((row >> 2) & 3);
    ga[i] = (unsigned)(row * 3072 + cc * 16); la[i] = (unsigned)(m * 1024 + lane * 16);
  }
#pragma unroll
  for (int i = 0; i < 4; ++i) {
    const int m = wave * 4 + i; const int row = 16 * m + (lane >> 2); const int cc = (lane & 3) ^ ((row >> 2) & 3);
    gb[i] = (unsigned)(row * 2048 + cc * 16); lb[i] = (unsigned)(8192 + m * 1024 + lane * 16);
  }
#define P3W_DMA(ks_, buf_) do { const unsigned ak_ = (((unsigned)(ks_) + 16u) & 31u) * 64u; \
    _Pragma("unroll") for (int i = 0; i < 2; ++i) __builtin_amdgcn_global_load_lds((const unsigned*)(asrc + ga[i] + ak_), (unsigned*)(lds + (buf_) * STG + la[i]), 16, 0, 0); \
    _Pragma("unroll") for (int i = 0; i < 4; ++i) __builtin_amdgcn_global_load_lds((const unsigned*)((const char*)wsrc + gb[i] + (unsigned)(ks_) * 64u), (unsigned*)(lds + (buf_) * STG + lb[i]), 16, 0, 0); } while (0)
  P3W_DMA(0, 0);
  if (tid < 128) {
    const f32x4* sp = (const f32x4*)(P.ssqA + (long)(tok0 + tid) * 8);
    const f32x4 s0 = sp[0], s1 = sp[1];
    const float rat = rsqrtf((s0.x + s0.y + s0.z + s0.w + s1.x + s1.y + s1.z + s1.w) * (1.f / 512.f) + EPSV);
    const f32x4* hp = (const f32x4*)(P.ssqH + (long)(tok0 + tid) * 8);
    const f32x4 h0 = hp[0], h1 = hp[1];
    const float rht = rsqrtf((h0.x + h0.y + h0.z + h0.w + h1.x + h1.y + h1.z + h1.w) * (1.f / 512.f) + EPSV);
    ra[tid] = rat; rh[tid] = rht / rat;
  }
#define P3W_STEP(ks_) do { const int cur = (ks_) & 1; \
    __syncthreads(); \
    if ((ks_) + 1 < 32) P3W_DMA((ks_) + 1, cur ^ 1); \
    const char* Ts = lds + cur * STG; const char* Ws = Ts + 8192; \
    _Pragma("unroll") for (int kk = 0; kk < 2; ++kk) { bf16x8 a[2], b[4]; \
      _Pragma("unroll") for (int i = 0; i < 2; ++i) a[i] = *(const bf16x8*)(Ts + swz64(64 * wp + 32 * i + (lane & 31), 2 * kk + (lane >> 5))); \
      _Pragma("unroll") for (int j = 0; j < 4; ++j) b[j] = *(const bf16x8*)(Ws + swz64(128 * wq + 32 * j + (lane & 31), 2 * kk + (lane >> 5))); \
      _Pragma("unroll") for (int i = 0; i < 2; ++i) _Pragma("unroll") for (int j = 0; j < 4; ++j) acc[i][j] = mfma32(a[i], b[j], acc[i][j]); } } while (0)
  for (int ks = 0; ks < 16; ++ks) P3W_STEP(ks);
#pragma unroll
  for (int i = 0; i < 2; ++i)
#pragma unroll
    for (int e = 0; e < 16; ++e) {
      const float sc = rh[64 * wp + 32 * i + (e & 3) + 8 * (e >> 2) + 4 * (lane >> 5)];
#pragma unroll
      for (int j = 0; j < 4; ++j) acc[i][j][e] *= sc;
    }
  for (int ks = 16; ks < 32; ++ks) P3W_STEP(ks);
#undef P3W_STEP
#undef P3W_DMA
  __syncthreads();
#pragma unroll
  for (int i = 0; i < 2; ++i)
#pragma unroll
    for (int e = 0; e < 16; ++e) {
      const float sc = ra[64 * wp + 32 * i + (e & 3) + 8 * (e >> 2) + 4 * (lane >> 5)];
#pragma unroll
      for (int j = 0; j < 4; ++j) acc[i][j][e] *= sc;
    }
  __syncthreads();
  char* Sa = lds;
#pragma unroll
  for (int i = 0; i < 2; ++i)
#pragma unroll
    for (int j = 0; j < 4; ++j)
#pragma unroll
      for (int e = 0; e < 16; ++e) {
        const unsigned r = 64u * wp + 32u * i + (e & 3) + 8u * (e >> 2) + 4u * (lane >> 5);
        const unsigned n = 128u * wq + 32u * j + (lane & 31);
        *(unsigned short*)(Sa + r * 528u + n * 2u) = (unsigned short)pack2(acc[i][j][e], 0.f);
      }
  __syncthreads();
#pragma unroll 4
  for (int it = 0; it < 16; ++it) {
    const unsigned id = tid + 256u * it; const unsigned row = id >> 5, c32 = id & 31u, cbl = c32 >> 4, c16 = c32 & 15u;
    float av[8]; unpack8(*(const u32x4*)(Sa + row * 528u + c32 * 16u), av);
    char* blk = (char*)P.out + (long)(tok0 + row) * 4096 + (2 * nt + cbl) * 512;
    if (layer == 0) {
      const f32x4* xp_ = (const f32x4*)(xres + (long)row * 1024 + n0 + 8 * c32);
      const f32x4 x0 = xp_[0], x1 = xp_[1];
      const float v[8] = {x0.x + av[0], x0.y + av[1], x0.z + av[2], x0.w + av[3], x1.x + av[4], x1.y + av[5], x1.z + av[6], x1.w + av[7]};
      unsigned hi[4], lo[4]; float ss = 0.f;
#pragma unroll
      for (int q = 0; q < 4; ++q) {
        hi[q] = pack2(v[2 * q], v[2 * q + 1]);
        const float h0 = lo2f(hi[q]), h1 = hi2f(hi[q]);
        lo[q] = pack2(v[2 * q] - h0, v[2 * q + 1] - h1);
        ss += h0 * h0 + h1 * h1;
      }
      *(u32x4*)(blk + c16 * 16u) = mk4(hi[0], hi[1], hi[2], hi[3]);
      *(u32x4*)(blk + 256u + c16 * 16u) = mk4(lo[0], lo[1], lo[2], lo[3]);
      ss += __shfl_xor(ss, 1); ss += __shfl_xor(ss, 2); ss += __shfl_xor(ss, 4); ss += __shfl_xor(ss, 8);
      if (c16 == 0) P.ssqX[(long)(tok0 + row) * 8 + 2 * nt + cbl] = ss;
    } else {
      float h[8], l[8];
      unpack8(*(const u32x4*)(blk + c16 * 16u), h);
      unpack8(*(const u32x4*)(blk + 256u + c16 * 16u), l);
      f32x4 o0 = {(h[0] + l[0]) + av[0], (h[1] + l[1]) + av[1], (h[2] + l[2]) + av[2], (h[3] + l[3]) + av[3]};
      f32x4 o1 = {(h[4] + l[4]) + av[4], (h[5] + l[5]) + av[5], (h[6] + l[6]) + av[6], (h[7] + l[7]) + av[7]};
      *(f32x4*)(blk + c16 * 32u) = o0;
      *(f32x4*)(blk + c16 * 32u + 16u) = o1;
    }
  }
  __syncthreads();
}

__device__ void phase_p3(const Params& P, int layer, int bid, int nb, char* lds) {
  for (int v = bid; v < 1536; v += nb) {
    const int wv = v >> 9, within = v & 511, x = within & 7, idx = within >> 3;
    const int mt = wv * 128 + x * 16 + (idx >> 2);
    const int nt = idx & 3;
    p3_wide(P, layer, mt, nt, lds);
  }
}

#define XB_TMO      128
#define XB_XCNT(j)  (256  + 64 * (j))
#define XB_XSUB(j)  (1280 + 64 * (j))
#define XB_XGEN(j)  (2304 + 64 * (j))
#define XB_TOP      3328
#define XB_TOPGEN   3392
#define XCD_BAR_WORDS 3456
#define XB_SPIN_CAP (1u << 18)
#define LAS __attribute__((address_space(3)))

__device__ __forceinline__ unsigned xb_ld(unsigned* p)              { return __hip_atomic_load(p, __ATOMIC_RELAXED, __HIP_MEMORY_SCOPE_AGENT); }
__device__ __forceinline__ unsigned xb_add(unsigned* p, unsigned v) { return __hip_atomic_fetch_add(p, v, __ATOMIC_RELAXED, __HIP_MEMORY_SCOPE_AGENT); }
__device__ __forceinline__ unsigned xb_xcc_id() { return (unsigned)__builtin_amdgcn_s_getreg((3 << 11) | 20) & 0xFu; }
#define XB_SPIN(cond, bar) do { unsigned _sp = 0; while (cond) { __builtin_amdgcn_s_sleep(1); \
    if ((++_sp & 255u) == 0u) { if (xb_ld(&(bar)[XB_TMO])) break; if (_sp > XB_SPIN_CAP) { atomicAdd(&(bar)[XB_TMO], 1u); break; } } } } while (0)

struct XcdBarrier {
    unsigned* bar; unsigned x;
    volatile LAS unsigned* st;
};

__device__ __forceinline__ XcdBarrier xcd_barrier_post(unsigned* bar, volatile LAS unsigned* st) {
    XcdBarrier b; b.bar = bar; b.x = xb_xcc_id(); b.st = st;
    if (threadIdx.x == 0) (void)xb_add(&bar[XB_XCNT(b.x)], 1u);
    return b;
}
__device__ __forceinline__ void xcd_barrier_complete(unsigned* bar, unsigned x, unsigned& nloc, unsigned& nx) {
    const unsigned G = gridDim.x * gridDim.y * gridDim.z;
    unsigned sum, cnt, mine, sp = 0u;
    for (;;) {
        sum = 0u; cnt = 0u; mine = 0u;
#pragma unroll
        for (unsigned j = 0; j < 16; ++j) { const unsigned c = xb_ld(&bar[XB_XCNT(j)]); sum += c; cnt += (c > 0u) ? 1u : 0u; mine = (j == x) ? c : mine; }
        if (sum == G) break;
        __builtin_amdgcn_s_sleep(1);
        if ((++sp & 255u) == 0u) { if (xb_ld(&bar[XB_TMO])) break; if (sp > XB_SPIN_CAP) { atomicAdd(&bar[XB_TMO], 1u); break; } }
    }
    nloc = mine > 0u ? mine : 1u; nx = cnt > 0u ? cnt : 1u;
}

__device__ __forceinline__ void xcd_barrier(const XcdBarrier& b) {
    asm volatile("s_waitcnt vmcnt(0)" ::: "memory");
    __syncthreads();
    if (threadIdx.x == 0) {
        unsigned* bar = b.bar;
        __builtin_amdgcn_s_waitcnt(0);
        unsigned nloc = b.st[0], nx = b.st[1];
        if (nloc == 0u) { xcd_barrier_complete(bar, b.x, nloc, nx); b.st[0] = nloc; b.st[1] = nx; }
        const unsigned old = xb_add(&bar[XB_XSUB(b.x)], 1u);
        const unsigned gen = old / nloc;
        if (old + 1u == (gen + 1u) * nloc) {
            __builtin_amdgcn_fence(__ATOMIC_RELEASE, "agent");
            asm volatile("s_waitcnt vmcnt(0)" ::: "memory");
            const unsigned og = xb_add(&bar[XB_TOP], 1u);
            const unsigned tg = og / nx;
            if (og + 1u == (tg + 1u) * nx) xb_add(&bar[XB_TOPGEN], 1u);
            else XB_SPIN(xb_ld(&bar[XB_TOPGEN]) == tg, bar);
            __builtin_amdgcn_fence(__ATOMIC_ACQUIRE, "agent");
            xb_add(&bar[XB_XGEN(b.x)], 1u);
            asm volatile("s_waitcnt vmcnt(0)" ::: "memory");
        } else {
            XB_SPIN(xb_ld(&bar[XB_XGEN(b.x)]) == gen, bar);
            __builtin_amdgcn_fence(__ATOMIC_ACQUIRE, "agent");
            asm volatile("s_waitcnt vmcnt(0)" ::: "memory");
        }
    }
    __syncthreads();
}


__device__ __forceinline__ void run_phase(const Params& P, int ph, int bid, int nb, char* lds) {
  switch (ph) {
    case 0: phase_prep(P, bid, nb, lds); break;
    case 1: phase_p1(P, 0, bid, nb, lds, 0); break;
    case 2: phase_p2(P, 0, bid, nb, lds, 3); break;
    case 3: phase_p3(P, 0, bid, nb, lds); break;
    case 4: phase_p1(P, 1, bid, nb, lds, 0); break;
    case 5: phase_p2(P, 1, bid, nb, lds, 3); break;
    case 6: phase_p3(P, 1, bid, nb, lds); break;
  }
}

#if MULTI
#error "MULTI=1 debug path is stale (no ssqH pre-pass); kept only as a reference for the phase order"
__global__ void __launch_bounds__(256, 2) phase_kernel(Params P, int ph) {
  __shared__ __attribute__((aligned(16))) char lds[LDS_BYTES];
  run_phase(P, ph, blockIdx.x, gridDim.x, lds);
}
#else
__global__ void __launch_bounds__(256, 2) mega_kernel(Params P) {
  __shared__ __attribute__((aligned(16))) char lds[LDS_BYTES];
  cg::grid_group grid = cg::this_grid();
  __shared__ uint4 xb_words;
  if (threadIdx.x == 0) xb_words = make_uint4(0u, 0u, 0u, 0u);
  __syncthreads();
  const XcdBarrier xb = xcd_barrier_post(P.bar, (volatile LAS unsigned*)&xb_words);
  const int bid = blockIdx.x, nb = gridDim.x;
#pragma unroll 1
  for (int st = 0; st < NSTEPS; ++st) {
    const int ph = (int)((PROG >> (4 * st)) & 15ull);
    const int layer = (ph >= 4 && ph <= 6) ? 1 : 0;
    const int sub = ph == 0 ? 0 : (ph <= 6 ? ((ph - 1) % 3 + 1) : ph - 3);
    switch (sub) {
      case 0: phase_prep(P, bid, nb, lds); break;
      case 1: phase_p1(P, layer, bid, nb, lds, 0); break;
      case 6: case 7: case 8: phase_p1(P, 0, bid, nb, lds, sub - 5); break;
      case 2: phase_p2(P, layer, bid, nb, lds, 3); break;
      case 3: phase_hyT(P, bid, nb, lds); xcd_barrier(xb); phase_p3(P, layer, bid, nb, lds); break;
      case 4: phase_p2(P, layer, bid, nb, lds, 1); break;
      case 5: phase_p2(P, layer, bid, nb, lds, 2); break;
    }
    if (st == 0) grid.sync();
    else if (st < NSTEPS - 1) xcd_barrier(xb);
  }
}
#endif

extern "C" void kernel_launch(void* const* d_in, const int* in_sizes, int n_in, void* d_out, int out_size,
                              void* d_ws, size_t ws_size, hipStream_t stream) {
  Params P{};
  P.xp = (const float*)d_in[0]; P.xs = (const float*)d_in[1];
  P.norm_g = (const float*)d_in[2]; P.w_in = (const float*)d_in[3]; P.conv_w = (const float*)d_in[4];
  P.conv_b = (const float*)d_in[5]; P.f_w1 = (const float*)d_in[6]; P.f_b1 = (const float*)d_in[7];
  P.f_fr1 = (const float*)d_in[8]; P.f_w2 = (const float*)d_in[9]; P.f_b2 = (const float*)d_in[10];
  P.f_fr2 = (const float*)d_in[11]; P.f_w3 = (const float*)d_in[12]; P.hy_bias = (const float*)d_in[13];
  P.qn_g = (const float*)d_in[14]; P.kn_g = (const float*)d_in[15]; P.rpb = (const float*)d_in[16];
  P.on_hy = (const float*)d_in[17]; P.on_att = (const float*)d_in[18]; P.w_out = (const float*)d_in[19];
  P.out = (float*)d_out;
  char* ws = (char*)d_ws;
  size_t off = 0;
  P.zT = (unsigned short*)(ws + off); off += (size_t)2560 * NTOK * 2;
  P.z2 = (unsigned short*)(ws + off); off += (size_t)NTOK * 1536 * 2;
  P.filt = (unsigned short*)(ws + off); off += (size_t)2 * 512 * 24576 * 2;
  P.winT = (unsigned short*)(ws + off); off += (size_t)2 * 4096 * 1024 * 2;
  P.woutT = (unsigned short*)(ws + off); off += (size_t)2 * 1024 * 1024 * 2;
  P.ssqA = (float*)(ws + off); off += (size_t)NTOK * 8 * 4;
  P.rstd1 = (float*)(ws + off); off += (size_t)NTOK * 4;
  P.bar = (unsigned*)(ws + off); off += (size_t)XCD_BAR_WORDS * 4;
  P.ssqH = (float*)(ws + off); off += (size_t)NTOK * 8 * 4;
  P.ssqX = (float*)(ws + off); off += (size_t)NTOK * 8 * 4;
  P.xb1 = (unsigned short*)d_out;
  if (off > ws_size) { fprintf(stderr, "workspace too small: need %zu have %zu\n", off, ws_size); return; }
#if MULTI
  for (int ph = 0; ph < 7; ++ph) phase_kernel<<<512, 256, 0, stream>>>(P, ph);
#else
  static int grid_blocks = 0;
  if (!grid_blocks) {
    int dev = 0, cus = 0, per_cu = 0;
    hipGetDevice(&dev);
    hipDeviceGetAttribute(&cus, hipDeviceAttributeMultiprocessorCount, dev);
    hipOccupancyMaxActiveBlocksPerMultiprocessor(&per_cu, mega_kernel, 256, 0);
    if (per_cu > 2) per_cu = 2;
    grid_blocks = cus * per_cu;
  }
  hipMemsetAsync(P.bar, 0, (size_t)XCD_BAR_WORDS * 4, stream);
  void* args[] = {&P};
  hipError_t e = hipLaunchCooperativeKernel((void*)mega_kernel, dim3(grid_blocks), dim3(256), args, 0, stream);
  if (e != hipSuccess) fprintf(stderr, "cooperative launch failed: %s (grid %d)\n", hipGetErrorString(e), grid_blocks);
#endif
}
```

```cpp
#include <hip/hip_runtime.h>
#include <hip/hip_cooperative_groups.h>
#include <stdint.h>
#include <stdio.h>
namespace cg = cooperative_groups;

#ifndef MULTI
#define MULTI 0
#endif

typedef __attribute__((ext_vector_type(8))) short bf16x8;
typedef __attribute__((ext_vector_type(4))) short s16x4;
typedef __attribute__((ext_vector_type(16))) float f32x16;
typedef __attribute__((ext_vector_type(4))) float f32x4;
typedef short v4i16_t __attribute__((ext_vector_type(4)));
typedef __attribute__((ext_vector_type(4))) unsigned int u32x4;
typedef __attribute__((ext_vector_type(2))) unsigned int u32x2;
typedef __attribute__((address_space(3))) const char* lds_cptr;

#define NTOK 49152
#define NPTOK 32768
#define EPSV 1e-6f
#define LOG2E 1.4426950408889634f
#define LDS_BYTES 74240
#ifndef PROG
#define PROG 0x6543210ull
#define NSTEPS 7
#endif

struct Params {
  const float* xp; const float* xs;
  const float* norm_g; const float* w_in; const float* conv_w; const float* conv_b;
  const float* f_w1; const float* f_b1; const float* f_fr1; const float* f_w2; const float* f_b2;
  const float* f_fr2; const float* f_w3; const float* hy_bias; const float* qn_g; const float* kn_g;
  const float* rpb; const float* on_hy; const float* on_att; const float* w_out;
  float* out;
  unsigned short* zT;
  unsigned short* z2;
  unsigned short* filt;
  unsigned short* winT;
  unsigned short* woutT;
  float* ssqA;
  unsigned short* xb1;
  float* rstd1;
  unsigned* bar;
  float* ssqH;
  float* ssqX;
};

__device__ __forceinline__ int opaque_tid() { int t = threadIdx.x; asm volatile("" : "+v"(t)); return t; }
__device__ __forceinline__ unsigned short f2bf(float f) {
  unsigned int u = __float_as_uint(f);
  u += 0x7fffu + ((u >> 16) & 1u);
  return (unsigned short)(u >> 16);
}
__device__ __forceinline__ float bf2f(unsigned short h) { return __uint_as_float(((unsigned int)h) << 16); }
typedef __attribute__((ext_vector_type(2))) float f32x2_t;
typedef __attribute__((ext_vector_type(2))) __bf16 bf16x2_t;
__device__ __forceinline__ unsigned int pack2(float a, float b) { f32x2_t v = {a, b}; return __builtin_bit_cast(unsigned int, __builtin_convertvector(v, bf16x2_t)); }
__device__ __forceinline__ unsigned int pack2t(float a, float b) { return pack2(a, b); }
__device__ __forceinline__ float lo2f(unsigned int u) { return __uint_as_float(u << 16); }
__device__ __forceinline__ float hi2f(unsigned int u) { return __uint_as_float(u & 0xffff0000u); }
__device__ __forceinline__ float silu_f(float g) { return g / (1.f + __expf(-g)); }
__device__ __forceinline__ int swz_off(int row, int ch) { return row * 128 + ((ch ^ ((row >> 1) & 7)) << 4); }

__device__ __forceinline__ f32x16 mfma32(bf16x8 a, bf16x8 b, f32x16 c) { return __builtin_amdgcn_mfma_f32_32x32x16_bf16(a, b, c, 0, 0, 0); }
__device__ __forceinline__ f32x4 mfma16(bf16x8 a, bf16x8 b, f32x4 c) { return __builtin_amdgcn_mfma_f32_16x16x32_bf16(a, b, c, 0, 0, 0); }

__device__ __forceinline__ u32x4 mk4(unsigned a, unsigned b, unsigned c, unsigned d) { u32x4 r = {a, b, c, d}; return r; }
__device__ __forceinline__ u32x2 mk2(unsigned a, unsigned b) { u32x2 r = {a, b}; return r; }
__device__ __forceinline__ bf16x8 u4_to_frag(u32x4 v) {
  union { u32x4 u; bf16x8 f; } x; x.u = v; return x.f;
}

__device__ void filter_unit(const Params& P, int u, char* lds) {
  const int tid = opaque_tid(), lane = tid & 63;
  const int wave = __builtin_amdgcn_readfirstlane(tid >> 6);
  const int l = u / 192; const int rr = u % 192;
  const int set = rr < 128 ? 0 : 1; const int pch = set ? rr - 128 : rr;
  const int L = set ? 4096 : 8192;
  const int p = pch * 64 + lane;
  const float t01 = (float)p / (float)(L - 1);
  const float pl = (float)p / (float)L;
  float* zs = (float*)lds;
  float* h1s = zs + 33 * 64;
  char* Hq = lds + 24832;
  char* Ws = lds + 33024;
  if (wave == 0) {
    zs[lane] = t01;
#pragma unroll
    for (int k = 0; k < 16; ++k) {
      float fk = 1e-4f + (float)k * ((15.f - 1e-4f) / 15.f);
      float tr = fk * pl; tr -= floorf(tr);
      zs[(1 + k) * 64 + lane] = __builtin_amdgcn_cosf(tr);
      zs[(17 + k) * 64 + lane] = -__builtin_amdgcn_sinf(tr);
    }
  }
  __syncthreads();
  const float* w1 = P.f_w1 + l * 33 * 64; const float* b1 = P.f_b1 + l * 64; const float* fr1 = P.f_fr1 + l * 64;
  const float* w2 = P.f_w2 + l * 64 * 64; const float* b2 = P.f_b2 + l * 64; const float* fr2 = P.f_fr2 + l * 64;
  const float* w3 = P.f_w3 + l * 64 * 1024;
  const int j0 = wave * 16;
  {
    float acc[16];
#pragma unroll
    for (int j = 0; j < 16; ++j) acc[j] = b1[j0 + j];
#pragma unroll 3
    for (int i = 0; i < 33; ++i) {
      const float zv = zs[i * 64 + lane];
#pragma unroll
      for (int j = 0; j < 16; ++j) acc[j] += zv * w1[i * 64 + j0 + j];
    }
#pragma unroll
    for (int j = 0; j < 16; ++j) h1s[(j0 + j) * 64 + lane] = __builtin_amdgcn_sinf(fr1[j0 + j] * acc[j] * 0.15915494309189535f);
  }
  __syncthreads();
  {
    float acc[16];
#pragma unroll
    for (int j = 0; j < 16; ++j) acc[j] = b2[j0 + j];
#pragma unroll 4
    for (int i = 0; i < 64; ++i) {
      const float hv = h1s[i * 64 + lane];
#pragma unroll
      for (int j = 0; j < 16; ++j) acc[j] += hv * w2[i * 64 + j0 + j];
    }
    float hh[16];
#pragma unroll
    for (int j = 0; j < 16; ++j) hh[j] = __builtin_amdgcn_sinf(fr2[j0 + j] * acc[j] * 0.15915494309189535f);
    *(u32x4*)(Hq + swz_off(lane, 2 * wave)) = mk4(pack2t(hh[0], hh[1]), pack2t(hh[2], hh[3]), pack2t(hh[4], hh[5]), pack2t(hh[6], hh[7]));
    *(u32x4*)(Hq + swz_off(lane, 2 * wave + 1)) = mk4(pack2t(hh[8], hh[9]), pack2t(hh[10], hh[11]), pack2t(hh[12], hh[13]), pack2t(hh[14], hh[15]));
  }
  const float mind = -3.0701134573253943f, maxd = -15.350567286626972f;
  const int setoff = set ? 16384 : 0;
  const int qpos0 = pch * 64 + (lane & 31);
  for (int nc = 0; nc < 8; ++nc) {
    const int n0 = nc * 128;
    __syncthreads();
#pragma unroll
    for (int i = 0; i < 4; ++i) {
      const int id = tid + 256 * i; const int krow = id >> 4, c8 = id & 15;
      const float* src = w3 + krow * 1024 + n0 + 8 * c8;
      f32x4 a0 = *(const f32x4*)src, a1 = *(const f32x4*)(src + 4);
      *(u32x4*)(Ws + krow * 320 + c8 * 16) = mk4(pack2(a0.x, a0.y), pack2(a0.z, a0.w), pack2(a1.x, a1.y), pack2(a1.z, a1.w));
    }
    __syncthreads();
    f32x16 acc[2];
#pragma unroll
    for (int j = 0; j < 2; ++j) {
#pragma unroll
      for (int e = 0; e < 16; ++e) acc[j][e] = 0.f;
    }
#pragma unroll
    for (int kk = 0; kk < 4; ++kk) {
      const int l16 = lane & 15;
      const int krow = 16 * kk + 8 * (lane >> 5) + (l16 >> 2);
      const int ncol = 32 * wave + 16 * ((lane >> 4) & 1) + 4 * (l16 & 3);
      lds_cptr ap = (lds_cptr)Ws + krow * 320 + ncol * 2;
      s16x4 lo = __builtin_bit_cast(s16x4, __builtin_amdgcn_ds_read_tr16_b64_v4i16((__attribute__((address_space(3))) v4i16_t*)ap));
      s16x4 hi = __builtin_bit_cast(s16x4, __builtin_amdgcn_ds_read_tr16_b64_v4i16((__attribute__((address_space(3))) v4i16_t*)(ap + 4 * 320)));
      bf16x8 a = (bf16x8){lo[0], lo[1], lo[2], lo[3], hi[0], hi[1], hi[2], hi[3]};
#pragma unroll
      for (int j = 0; j < 2; ++j) {
        bf16x8 b = *(const bf16x8*)(Hq + swz_off(32 * j + (lane & 31), 2 * kk + (lane >> 5)));
        acc[j] = mfma32(a, b, acc[j]);
      }
    }
#pragma unroll
    for (int j = 0; j < 2; ++j) {
      const int pos = qpos0 + 32 * j;
      const float tq = (float)pos / (float)(L - 1);
#pragma unroll
      for (int e = 0; e < 16; ++e) {
        const int col = n0 + 32 * wave + (e & 3) + 8 * (e >> 2) + 4 * (lane >> 5);
        const float delta = fabsf(mind + (float)col * ((maxd - mind) / 1023.f));
        const float val = acc[j][e] * __expf(-tq * delta);
        const int c = col & 511;
        unsigned short* dst = P.filt + ((long)(l * 512 + c)) * 24576 + setoff;
        if (col < 512) dst[L - pos] = f2bf(val);
        else { if (pos > 0) dst[L + pos] = f2bf(val); else dst[0] = 0; }
      }
    }
  }
  __syncthreads();
}

__device__ void phase_prep(const Params& P, int bid, int nb, char* lds) {
  const int tid = opaque_tid();
  const long gt = (long)bid * 256 + tid, gs = (long)nb * 256;
  for (long i = gt; i < 2L * 128 * 4096; i += gs) {
    int n = (int)(i & 4095); int kc = (int)((i >> 12) & 127); int l = (int)(i >> 19);
    const float* w = P.w_in + ((long)l * 1024 + kc * 8) * 4096 + n;
    const float* g = P.norm_g + l * 1024 + kc * 8;
    unsigned int o[4];
#pragma unroll
    for (int j = 0; j < 4; ++j) o[j] = pack2(w[(long)(2 * j) * 4096] * g[2 * j], w[(long)(2 * j + 1) * 4096] * g[2 * j + 1]);
    *(u32x4*)(P.winT + ((long)l * 4096 + n) * 1024 + kc * 8) = mk4(o[0], o[1], o[2], o[3]);
  }
  for (long i = gt; i < 2L * 128 * 1024; i += gs) {
    int n = (int)(i & 1023); int kc = (int)((i >> 10) & 127); int l = (int)(i >> 17);
    const float* w = P.w_out + ((long)l * 1024 + kc * 8) * 1024 + n;
    const float* g = (kc < 64) ? (P.on_hy + l * 512 + kc * 8) : (P.on_att + l * 512 + (kc - 64) * 8);
    unsigned int o[4];
#pragma unroll
    for (int j = 0; j < 4; ++j) o[j] = pack2(w[(long)(2 * j) * 1024] * g[2 * j], w[(long)(2 * j + 1) * 1024] * g[2 * j + 1]);
    *(u32x4*)(P.woutT + ((long)l * 1024 + n) * 1024 + kc * 8) = mk4(o[0], o[1], o[2], o[3]);
  }
  {
    const int lane = tid & 63; const int gw = bid * 4 + (tid >> 6);
    for (int row = gw; row < NTOK; row += nb * 4) {
      const float* src = (row < NPTOK) ? P.xp + (long)row * 1024 : P.xs + (long)(row - NPTOK) * 1024;
      unsigned short* dst = P.xb1 + (long)row * 1024;
      float ss = 0.f;
#pragma unroll
      for (int i = 0; i < 4; ++i) {
        const f32x4 a = *(const f32x4*)(src + (i * 64 + lane) * 4);
        ss += a.x * a.x + a.y * a.y + a.z * a.z + a.w * a.w;
        *(u32x2*)(dst + (i * 64 + lane) * 4) = mk2(pack2(a.x, a.y), pack2(a.z, a.w));
      }
      ss += __shfl_xor(ss, 32); ss += __shfl_xor(ss, 16); ss += __shfl_xor(ss, 8);
      ss += __shfl_xor(ss, 4); ss += __shfl_xor(ss, 2); ss += __shfl_xor(ss, 1);
      if (lane == 0) P.rstd1[row] = rsqrtf(ss * (1.f / 1024.f) + EPSV);
    }
  }
  for (int u = bid; u < 384; u += nb) filter_unit(P, u, lds);
}

__device__ __forceinline__ u32x4 ldg16(const void* base, unsigned off) { return *(const u32x4*)((const char*)base + off); }

__device__ __forceinline__ void unpack8(u32x4 v, float* f) {
  f[0] = lo2f(v.x); f[1] = hi2f(v.x); f[2] = lo2f(v.y); f[3] = hi2f(v.y);
  f[4] = lo2f(v.z); f[5] = hi2f(v.z); f[6] = lo2f(v.w); f[7] = hi2f(v.w);
}

__device__ void p1_tile(const Params& P, int layer, int mt, int nt, char* lds, int variant) {
  const int tid = opaque_tid(), lane = tid & 63, wave = tid >> 6;
  const int tok0 = mt * 128, n0 = nt * 128;
  bool swap; int dst0; int mode = 0;
  const bool gate = (n0 >= 1536 && n0 < 2048) || (n0 >= 3584);
  if (n0 < 1536) { swap = false; dst0 = n0; }
  else if (n0 < 2048) { swap = false; dst0 = 2048 + (n0 - 1536); }
  else if (n0 < 2560) { swap = true; dst0 = n0 - 2048; mode = 1; }
  else if (n0 < 3072) { swap = true; dst0 = 512 + (n0 - 2560); mode = 2; }
  else if (n0 < 3584) { swap = false; dst0 = 1536 + (n0 - 3072); }
  else { swap = true; dst0 = 1024 + (n0 - 3584); }
  const float* xsrc = (layer == 0) ? ((tok0 < NPTOK) ? P.xp + (long)tok0 * 1024 : P.xs + (long)(tok0 - NPTOK) * 1024)
                                   : P.out + (long)tok0 * 1024;
  const unsigned short* wsrc = P.winT + ((long)layer * 4096 + n0) * 1024;
  char* S = lds; float* rs = (float*)(lds + 65536);
  const int wp = wave >> 1, wq = wave & 1;
  f32x16 acc[2][2];
#pragma unroll
  for (int i = 0; i < 2; ++i)
#pragma unroll
    for (int j = 0; j < 2; ++j)
#pragma unroll
      for (int e = 0; e < 16; ++e) acc[i][j][e] = 0.f;
  const int r8 = tid >> 3, ch = tid & 7;
  const int r16 = tid >> 4, c4 = tid & 15;
  f32x4 av[8]; u32x4 bv[4]; float ssq[8];
#pragma unroll
  for (int i = 0; i < 8; ++i) ssq[i] = 0.f;
  const unsigned a_off = (unsigned)((r16 * 1024 + c4 * 4) * 4);
  const unsigned b_off = (unsigned)((r8 * 1024 + ch * 8) * 2);
#define P1_LOAD(ks_) do { \
    _Pragma("unroll") for (int i = 0; i < 8; ++i) av[i] = *(const f32x4*)((const char*)xsrc + (a_off + (unsigned)i * 65536u + (unsigned)(ks_) * 256u)); \
    _Pragma("unroll") for (int i = 0; i < 4; ++i) bv[i] = ldg16(wsrc, b_off + (unsigned)i * 65536u + (unsigned)(ks_) * 128u); } while (0)
#define P1_STORE(buf_) do { \
    char* As_ = lds + (buf_) * 32768; char* Bs_ = As_ + 16384; \
    _Pragma("unroll") for (int i = 0; i < 8; ++i) { \
      f32x4 a0 = av[i]; \
      ssq[i] += a0.x * a0.x + a0.y * a0.y + a0.z * a0.z + a0.w * a0.w; \
      const int row_ = r16 + 16 * i; \
      *(u32x2*)(As_ + row_ * 128 + (((c4 >> 1) ^ ((row_ >> 1) & 7)) << 4) + (c4 & 1) * 8) = mk2(pack2(a0.x, a0.y), pack2(a0.z, a0.w)); } \
    _Pragma("unroll") for (int i = 0; i < 4; ++i) *(u32x4*)(Bs_ + swz_off(r8 + 32 * i, ch)) = bv[i]; } while (0)
  if (layer == 0) {
    const unsigned short* asrc = P.xb1 + (long)tok0 * 1024;
    unsigned goff[4], loff[4];
#pragma unroll
    for (int i = 0; i < 4; ++i) {
      const int m = wave * 4 + i; const int row = 8 * m + (lane >> 3); const int cc = (lane & 7) ^ ((row >> 1) & 7);
      goff[i] = (unsigned)(row * 2048 + cc * 16); loff[i] = (unsigned)(m * 1024 + lane * 16);
    }
#define P1_DMA(ks_, buf_) do { _Pragma("unroll") for (int i = 0; i < 4; ++i) { \
      __builtin_amdgcn_global_load_lds((const unsigned*)((const char*)asrc + goff[i] + (unsigned)(ks_) * 128u), (unsigned*)(lds + (buf_) * 32768 + loff[i]), 16, 0, 0); \
      __builtin_amdgcn_global_load_lds((const unsigned*)((const char*)wsrc + goff[i] + (unsigned)(ks_) * 128u), (unsigned*)(lds + (buf_) * 32768 + 16384 + loff[i]), 16, 0, 0); } } while (0)
    P1_DMA(0, 0);
    if (tid < 128) rs[tid] = P.rstd1[tok0 + tid];
    for (int ks = 0; ks < 16; ++ks) {
      const int cur = ks & 1;
      __syncthreads();
      if (ks + 1 < 16) P1_DMA(ks + 1, cur ^ 1);
      const char* As = lds + cur * 32768; const char* Bs = As + 16384;
      const char* Pb = swap ? Bs : As; const char* Qb = swap ? As : Bs;
#pragma unroll
      for (int kk = 0; kk < 4; ++kk) {
        bf16x8 a[2], b[2];
#pragma unroll
        for (int i = 0; i < 2; ++i) a[i] = *(const bf16x8*)(Pb + swz_off(64 * wp + 32 * i + (lane & 31), 2 * kk + (lane >> 5)));
#pragma unroll
        for (int j = 0; j < 2; ++j) b[j] = *(const bf16x8*)(Qb + swz_off(64 * wq + 32 * j + (lane & 31), 2 * kk + (lane >> 5)));
#pragma unroll
        for (int i = 0; i < 2; ++i)
#pragma unroll
          for (int j = 0; j < 2; ++j) acc[i][j] = mfma32(a[i], b[j], acc[i][j]);
      }
    }
#undef P1_DMA
    __syncthreads();
  } else {
  P1_LOAD(0);
  P1_STORE(0);
  P1_LOAD(1);
  __syncthreads();
  for (int ks = 0; ks < 16; ++ks) {
    const int cur = ks & 1;
    if (ks + 1 < 16) P1_STORE(cur ^ 1);
    if (ks + 2 < 16 && !(variant & 1)) P1_LOAD(ks + 2);
    __builtin_amdgcn_sched_barrier(0);
    const char* As = lds + cur * 32768; const char* Bs = As + 16384;
    const char* Pb = swap ? Bs : As; const char* Qb = swap ? As : Bs;
#pragma unroll
    for (int kk = 0; kk < 4; ++kk) {
      bf16x8 a[2], b[2];
#pragma unroll
      for (int i = 0; i < 2; ++i) a[i] = *(const bf16x8*)(Pb + swz_off(64 * wp + 32 * i + (lane & 31), 2 * kk + (lane >> 5)));
#pragma unroll
      for (int j = 0; j < 2; ++j) b[j] = *(const bf16x8*)(Qb + swz_off(64 * wq + 32 * j + (lane & 31), 2 * kk + (lane >> 5)));
#pragma unroll
      for (int i = 0; i < 2; ++i)
#pragma unroll
        for (int j = 0; j < 2; ++j) acc[i][j] = mfma32(a[i], b[j], acc[i][j]);
    }
    __syncthreads();
  }
#undef P1_LOAD
#undef P1_STORE
#pragma unroll
  for (int i = 0; i < 8; ++i) {
    float s_ = ssq[i];
    s_ += __shfl_xor(s_, 1); s_ += __shfl_xor(s_, 2); s_ += __shfl_xor(s_, 4); s_ += __shfl_xor(s_, 8);
    if (c4 == 0) rs[r16 + 16 * i] = rsqrtf(s_ * (1.f / 1024.f) + EPSV);
  }
  __syncthreads();
  }
#pragma unroll
  for (int i = 0; i < 2; ++i)
#pragma unroll
    for (int j = 0; j < 2; ++j) {
      const int q = 64 * wq + 32 * j + (lane & 31);
#pragma unroll
      for (int g4 = 0; g4 < 4; ++g4) {
        const int p = 64 * wp + 32 * i + 8 * g4 + 4 * (lane >> 5);
        float v[4];
#pragma unroll
        for (int e = 0; e < 4; ++e) v[e] = acc[i][j][4 * g4 + e] * (swap ? rs[q] : rs[p + e]);
        if (gate) {
#pragma unroll
          for (int e = 0; e < 4; ++e) v[e] = v[e] * __builtin_amdgcn_rcpf(1.f + __expf(-v[e]));
        }
        *(u32x2*)(S + q * 272 + p * 2) = mk2(pack2(v[0], v[1]), pack2(v[2], v[3]));
      }
    }
  __syncthreads();
#pragma unroll
  for (int it = 0; it < 8; ++it) {
    const int id = tid + 256 * it; const int row = id >> 4, c16 = id & 15;
    u32x4 v = *(const u32x4*)(S + row * 272 + c16 * 16);
    if (variant & 2) continue;
    if (!swap) {
      *(u32x4*)(P.zT + (long)(dst0 + row) * NTOK + tok0 + c16 * 8) = v;
    } else {
      if (mode) {
        float f[8];
        f[0] = lo2f(v.x); f[1] = hi2f(v.x); f[2] = lo2f(v.y); f[3] = hi2f(v.y);
        f[4] = lo2f(v.z); f[5] = hi2f(v.z); f[6] = lo2f(v.w); f[7] = hi2f(v.w);
        float ss = 0.f;
#pragma unroll
        for (int e = 0; e < 8; ++e) ss += f[e] * f[e];
        ss += __shfl_xor(ss, 1); ss += __shfl_xor(ss, 2); ss += __shfl_xor(ss, 4);
        float sc = rsqrtf(ss * (1.f / 64.f) + EPSV);
        if (mode == 1) sc *= 0.125f * LOG2E;
        const float* g = (mode == 1 ? P.qn_g : P.kn_g) + layer * 64 + (c16 & 7) * 8;
#pragma unroll
        for (int e = 0; e < 8; ++e) f[e] *= sc * g[e];
        v = mk4(pack2(f[0], f[1]), pack2(f[2], f[3]), pack2(f[4], f[5]), pack2(f[6], f[7]));
      }
      *(u32x4*)(P.z2 + (long)(tok0 + row) * 1536 + dst0 + c16 * 8) = v;
    }
  }
  __syncthreads();
}

__device__ void phase_rstd2(const Params& P, int bid, int nb) {
  const int tid = opaque_tid(), lane = tid & 63;
  for (int row = bid * 4 + (tid >> 6); row < NTOK; row += nb * 4) {
    const char* src = (const char*)P.out + (long)row * 4096;
    float ss = 0.f;
#pragma unroll
    for (int i = 0; i < 2; ++i) {
      const int c = lane + 64 * i;
      float y[8]; unpack8(*(const u32x4*)(src + (c >> 4) * 512 + (c & 15) * 16), y);
#pragma unroll
      for (int e = 0; e < 8; ++e) ss += y[e] * y[e];
    }
    ss += __shfl_xor(ss, 32); ss += __shfl_xor(ss, 16); ss += __shfl_xor(ss, 8);
    ss += __shfl_xor(ss, 4); ss += __shfl_xor(ss, 2); ss += __shfl_xor(ss, 1);
    if (lane == 0) P.rstd1[row] = rsqrtf(ss * (1.f / 1024.f) + EPSV);
  }
}

__device__ __forceinline__ int swz64(int row, int ch) { return row * 64 + ((ch ^ ((row >> 2) & 3)) << 4); }

template <bool SWAP>
__device__ void p1_wide_body(const Params& P, int layer, int tok0, int n0, int dst0, int mode, bool gate, char* lds) {
  constexpr int TP = SWAP ? 4 : 2, TQ = SWAP ? 2 : 4;
  constexpr int STG = 8192 + 16384;
  const int tid = opaque_tid(), lane = tid & 63, wave = tid >> 6;
  const int wp = wave >> 1, wq = wave & 1;
  const unsigned rstride = layer ? 4096u : 2048u, ablk = layer ? 512u : 256u;
  const char* asrc = (const char*)P.xb1 + (long)tok0 * rstride;
  const unsigned short* wsrc = P.winT + ((long)layer * 4096 + n0) * 1024;
  float* rs = (float*)(lds + 3 * STG);
  f32x16 acc[TP][TQ];
#pragma unroll
  for (int i = 0; i < TP; ++i)
#pragma unroll
    for (int j = 0; j < TQ; ++j)
#pragma unroll
      for (int e = 0; e < 16; ++e) acc[i][j][e] = 0.f;
  unsigned ga[2], la[2], gb[4], lb[4];
#pragma unroll
  for (int i = 0; i < 2; ++i) {
    const int m = wave * 2 + i; const int row = 16 * m + (lane >> 2); const int cc = (lane & 3) ^ ((row >> 2) & 3);
    ga[i] = (unsigned)row * rstride + (unsigned)(cc * 16); la[i] = (unsigned)(m * 1024 + lane * 16);
  }
#pragma unroll
  for (int i = 0; i < 4; ++i) {
    const int m = wave * 4 + i; const int row = 16 * m + (lane >> 2); const int cc = (lane & 3) ^ ((row >> 2) & 3);
    gb[i] = (unsigned)(row * 2048 + cc * 16); lb[i] = (unsigned)(8192 + m * 1024 + lane * 16);
  }
#define PW_DMA(ks_, buf_) do { \
    const unsigned ak_ = ((unsigned)(ks_) >> 2) * ablk + ((unsigned)(ks_) & 3u) * 64u; \
    _Pragma("unroll") for (int i = 0; i < 2; ++i) __builtin_amdgcn_global_load_lds((const unsigned*)(asrc + ga[i] + ak_), (unsigned*)(lds + (buf_) * STG + la[i]), 16, 0, 0); \
    _Pragma("unroll") for (int i = 0; i < 4; ++i) __builtin_amdgcn_global_load_lds((const unsigned*)((const char*)wsrc + gb[i] + (unsigned)(ks_) * 64u), (unsigned*)(lds + (buf_) * STG + lb[i]), 16, 0, 0); } while (0)
  if (tid < 128) {
    if (layer) {
      const f32x4* sp = (const f32x4*)(P.ssqX + (long)(tok0 + tid) * 8);
      const f32x4 s0 = sp[0], s1 = sp[1];
      rs[tid] = rsqrtf((s0.x + s0.y + s0.z + s0.w + s1.x + s1.y + s1.z + s1.w) * (1.f / 1024.f) + EPSV);
    } else rs[tid] = P.rstd1[tok0 + tid];
  }
  asm volatile("s_waitcnt vmcnt(0)" ::: "memory");
  const unsigned lbase = (unsigned)(size_t)(__attribute__((address_space(3))) char*)lds;
  unsigned pa[2], qa[2];
#pragma unroll
  for (int kk = 0; kk < 2; ++kk) {
    pa[kk] = lbase + (SWAP ? 8192u : 0u) + (unsigned)swz64(32 * TP * wp + (lane & 31), 2 * kk + (lane >> 5));
    qa[kk] = lbase + (SWAP ? 0u : 8192u) + (unsigned)swz64(32 * TQ * wq + (lane & 31), 2 * kk + (lane >> 5));
  }
  PW_DMA(0, 0);
  PW_DMA(1, 1);
#define PW_COMP(so_) do { _Pragma("unroll") for (int kk = 0; kk < 2; ++kk) { \
      bf16x8 f0, f1, f2, f3, f4, f5; const unsigned pA = pa[kk] + (so_), qA = qa[kk] + (so_); \
      if (SWAP) asm volatile("ds_read_b128 %0, %6\n\tds_read_b128 %1, %6 offset:2048\n\tds_read_b128 %2, %6 offset:4096\n\tds_read_b128 %3, %6 offset:6144\n\t" \
                             "ds_read_b128 %4, %7\n\tds_read_b128 %5, %7 offset:2048\n\ts_waitcnt lgkmcnt(0)" \
                             : "=&v"(f0), "=&v"(f1), "=&v"(f2), "=&v"(f3), "=&v"(f4), "=&v"(f5) : "v"(pA), "v"(qA) : "memory"); \
      else      asm volatile("ds_read_b128 %0, %6\n\tds_read_b128 %1, %6 offset:2048\n\t" \
                             "ds_read_b128 %2, %7\n\tds_read_b128 %3, %7 offset:2048\n\tds_read_b128 %4, %7 offset:4096\n\tds_read_b128 %5, %7 offset:6144\n\ts_waitcnt lgkmcnt(0)" \
                             : "=&v"(f0), "=&v"(f1), "=&v"(f2), "=&v"(f3), "=&v"(f4), "=&v"(f5) : "v"(pA), "v"(qA) : "memory"); \
      if (SWAP) { const bf16x8 fa_[4] = {f0, f1, f2, f3}; const bf16x8 fb_[2] = {f4, f5}; \
        _Pragma("unroll") for (int i = 0; i < 4; ++i) _Pragma("unroll") for (int j = 0; j < 2; ++j) acc[i][j] = mfma32(fa_[i], fb_[j], acc[i][j]); } \
      else      { const bf16x8 fa_[2] = {f0, f1}; const bf16x8 fb_[4] = {f2, f3, f4, f5}; \
        _Pragma("unroll") for (int i = 0; i < 2; ++i) _Pragma("unroll") for (int j = 0; j < 4; ++j) acc[i][j] = mfma32(fa_[i], fb_[j], acc[i][j]); } } } while (0)
  int b0 = 0, b2 = 2;
  for (int ks = 0; ks < 31; ++ks) {
    asm volatile("s_waitcnt vmcnt(6)" ::: "memory");
    __builtin_amdgcn_s_barrier();
    if (ks + 2 < 32) PW_DMA(ks + 2, b2);
    PW_COMP((unsigned)b0 * (unsigned)STG);
    b0 = (b0 == 2) ? 0 : b0 + 1; b2 = (b2 == 2) ? 0 : b2 + 1;
  }
  asm volatile("s_waitcnt vmcnt(0)" ::: "memory");
  __builtin_amdgcn_s_barrier();
  PW_COMP((unsigned)b0 * (unsigned)STG);
#undef PW_COMP
#undef PW_DMA
  __syncthreads();
#pragma unroll
  for (int i = 0; i < TP; ++i)
#pragma unroll
    for (int j = 0; j < TQ; ++j)
#pragma unroll
      for (int e = 0; e < 16; ++e) {
        const int pl = 32 * TP * wp + 32 * i + (e & 3) + 8 * (e >> 2) + 4 * (lane >> 5);
        const int ql = 32 * TQ * wq + 32 * j + (lane & 31);
        float v = acc[i][j][e] * (SWAP ? rs[ql] : rs[pl]);
        if (gate) v = v * __builtin_amdgcn_rcpf(1.f + __expf(-v));
        acc[i][j][e] = v;
      }
  __syncthreads();
  char* S = lds;
  constexpr unsigned SROW = SWAP ? 528u : 272u;
#pragma unroll
  for (int i = 0; i < TP; ++i)
#pragma unroll
    for (int j = 0; j < TQ; ++j) {
      const unsigned ql = 32u * TQ * wq + 32u * j + (lane & 31);
#pragma unroll
      for (int g4 = 0; g4 < 4; ++g4) {
        const unsigned pl = 32u * TP * wp + 32u * i + 8u * g4 + 4u * (lane >> 5);
        *(u32x2*)(S + ql * SROW + pl * 2u) = mk2(pack2(acc[i][j][4 * g4], acc[i][j][4 * g4 + 1]), pack2(acc[i][j][4 * g4 + 2], acc[i][j][4 * g4 + 3]));
      }
    }
  __syncthreads();
  float gq[8];
#pragma unroll
  for (int e = 0; e < 8; ++e) gq[e] = 1.f;
  if (SWAP && mode) {
    const f32x4* gp = (const f32x4*)((mode == 1 ? P.qn_g : P.kn_g) + layer * 64 + (tid & 7) * 8);
    const f32x4 g0 = gp[0], g1 = gp[1];
    const float k = (mode == 1) ? 0.125f * LOG2E : 1.f;
    gq[0] = g0.x * k; gq[1] = g0.y * k; gq[2] = g0.z * k; gq[3] = g0.w * k; gq[4] = g1.x * k; gq[5] = g1.y * k; gq[6] = g1.z * k; gq[7] = g1.w * k;
  }
#pragma unroll 4
  for (int it = 0; it < 16; ++it) {
    const unsigned id = tid + 256u * it;
    if (!SWAP) {
      const unsigned row = id >> 4, c16 = id & 15u;
      const u32x4 v = *(const u32x4*)(S + row * 272u + c16 * 16u);
      *(u32x4*)((char*)P.zT + ((unsigned)(dst0 + row) * (unsigned)NTOK + tok0 + c16 * 8u) * 2u) = v;
    } else {
      const unsigned row = id >> 5, c32 = id & 31u;
      u32x4 v = *(const u32x4*)(S + row * 528u + c32 * 16u);
      if (mode) {
        float f[8]; unpack8(v, f);
        float ss = 0.f;
#pragma unroll
        for (int e = 0; e < 8; ++e) ss += f[e] * f[e];
        ss += __shfl_xor(ss, 1); ss += __shfl_xor(ss, 2); ss += __shfl_xor(ss, 4);
        const float sc = rsqrtf(ss * (1.f / 64.f) + EPSV);
#pragma unroll
        for (int e = 0; e < 8; ++e) f[e] *= sc * gq[e];
        v = mk4(pack2(f[0], f[1]), pack2(f[2], f[3]), pack2(f[4], f[5]), pack2(f[6], f[7]));
      }
      *(u32x4*)((char*)P.z2 + (((unsigned)(tok0 + row) * 1536u + dst0 + c32 * 8u) * 2u)) = v;
    }
  }
  __syncthreads();
}

__device__ void p1_tile_wide(const Params& P, int layer, int mt, int nt, char* lds) {
  const int tok0 = mt * 128, n0 = nt * 256;
  if (n0 < 1536)       p1_wide_body<false>(P, layer, tok0, n0, n0, 0, false, lds);
  else if (n0 < 2048)  p1_wide_body<false>(P, layer, tok0, n0, 2048 + (n0 - 1536), 0, true, lds);
  else if (n0 < 2560)  p1_wide_body<true>(P, layer, tok0, n0, n0 - 2048, 1, false, lds);
  else if (n0 < 3072)  p1_wide_body<true>(P, layer, tok0, n0, 512 + (n0 - 2560), 2, false, lds);
  else if (n0 < 3584)  p1_wide_body<false>(P, layer, tok0, n0, 1536 + (n0 - 3072), 0, false, lds);
  else                 p1_wide_body<true>(P, layer, tok0, n0, 1024 + (n0 - 3584), 0, true, lds);
}

__device__ void phase_p1(const Params& P, int layer, int bid, int nb, char* lds, int variant) {
  if (variant == 0) {
    for (int v = bid; v < 6144; v += nb) {
      const int wv = v >> 9, within = v & 511, x = within & 7, idx = within >> 3;
      const int mt = wv * 32 + (x >> 1) * 8 + (idx >> 3);
      const int nt = (x & 1) * 8 + (idx & 7);
      p1_tile_wide(P, layer, mt, nt, lds);
    }
    return;
  }
  for (int v = bid; v < 12288; v += nb) {
    int wv = v >> 9, within = v & 511, x = within & 7, idx = within >> 3;
    int mt = wv * 16 + (x >> 2) * 8 + (idx >> 3);
    int nt = (x & 3) * 8 + (idx & 7);
    p1_tile(P, layer, mt, nt, lds, variant);
  }
}

template <int L, int NBP>
__device__ void conv_unit(const Params& P, int layer, int set, int c, int bp0, char* lds) {
  constexpr int NB = L / 32, UB = (NB + 32) * 64, WPB = 4 / NBP, NSTEP = NB / 16 + 1;
  static_assert(NB / WPB == 64, "each wave owns 64 output blocks (4 N-tiles)");
  char* U = lds; char* F = lds + NBP * 2 * UB;
  const int tid = opaque_tid(), lane = tid & 63, wave = tid >> 6;
  const long setbase = (long)(set ? NPTOK : 0) + (long)(2 * bp0) * L;
  const unsigned short* x0r = P.zT + (long)c * NTOK + setbase;
  const unsigned short* x1r = P.zT + (long)(512 + c) * NTOK + setbase;
  const unsigned short* vr = P.zT + (long)(1024 + c) * NTOK + setbase;
  const float* cw = P.conv_w + layer * 3 * 1536; const float* cb = P.conv_b + layer * 1536;
  {
    const float w1a = cw[512 + c], w1b = cw[1536 + 512 + c], w1c = cw[3072 + 512 + c], b1 = cb[512 + c];
    const float wva = cw[1024 + c], wvb = cw[1536 + 1024 + c], wvc = cw[3072 + 1024 + c], bvv = cb[1024 + c];
#pragma unroll
    for (int pp = 0; pp < NBP; ++pp) {
      const int id = tid + 256 * pp; const int pb = id >> 7; const int rem = id & 127; const int side = rem >> 6; const int o = rem & 63;
      *(u32x4*)(U + pb * UB + (side ? (NB + 16) * 64 : 0) + o * 16) = mk4(0, 0, 0, 0);
    }
    static_assert(NBP * 2 * L / 8 == 8 * 256 && 2 * L / 8 <= 8 * 256, "staging loops are written for 8 rounds");
    static_assert(NBP * 2 * L / 8 == 8 * 256, "8 chunks per thread");
#pragma unroll 1
    for (int hf = 0; hf < 2; ++hf) {
      u32x4 XA[4], XB[4]; float HX0[4], HX9[4], HV0[4], HV9[4];
#pragma unroll
      for (int q = 0; q < 4; ++q) {
        const unsigned id = tid + 256u * (4 * hf + q); const unsigned pb = id / (L / 8); const unsigned t8 = (id % (L / 8)) * 8;
        const unsigned bo = (pb * L + t8) * 2u;
        XA[q] = *(const u32x4*)((const char*)x1r + bo); XB[q] = *(const u32x4*)((const char*)vr + bo);
        const unsigned lo_ = t8 > 0 ? bo - 2u : bo, hi_ = (t8 + 8 < (unsigned)L) ? bo + 16u : bo;
        const float xl = bf2f(*(const unsigned short*)((const char*)x1r + lo_)), xh = bf2f(*(const unsigned short*)((const char*)x1r + hi_));
        const float vl = bf2f(*(const unsigned short*)((const char*)vr + lo_)), vh = bf2f(*(const unsigned short*)((const char*)vr + hi_));
        HX0[q] = t8 > 0 ? xl : 0.f; HX9[q] = (t8 + 8 < (unsigned)L) ? xh : 0.f;
        HV0[q] = t8 > 0 ? vl : 0.f; HV9[q] = (t8 + 8 < (unsigned)L) ? vh : 0.f;
      }
#pragma unroll
      for (int q = 0; q < 4; ++q) {
        const unsigned id = tid + 256u * (4 * hf + q); const unsigned pb = id / (L / 8); const unsigned t8 = (id % (L / 8)) * 8;
        const u32x4 xa = XA[q], xb = XB[q];
        const float x0_ = HX0[q], x1_ = lo2f(xa.x), x2_ = hi2f(xa.x), x3_ = lo2f(xa.y), x4_ = hi2f(xa.y),
                    x5_ = lo2f(xa.z), x6_ = hi2f(xa.z), x7_ = lo2f(xa.w), x8_ = hi2f(xa.w), x9_ = HX9[q];
        const float v0_ = HV0[q], v1_ = lo2f(xb.x), v2_ = hi2f(xb.x), v3_ = lo2f(xb.y), v4_ = hi2f(xb.y),
                    v5_ = lo2f(xb.z), v6_ = hi2f(xb.z), v7_ = lo2f(xb.w), v8_ = hi2f(xb.w), v9_ = HV9[q];
#define CU_(xm, xc, xp, vm, vc, vp) ((w1a * (xm) + w1b * (xc) + w1c * (xp) + b1) * (wva * (vm) + wvb * (vc) + wvc * (vp) + bvv))
        const float u0 = CU_(x0_, x1_, x2_, v0_, v1_, v2_), u1 = CU_(x1_, x2_, x3_, v1_, v2_, v3_);
        const float u2 = CU_(x2_, x3_, x4_, v2_, v3_, v4_), u3 = CU_(x3_, x4_, x5_, v3_, v4_, v5_);
        const float u4 = CU_(x4_, x5_, x6_, v4_, v5_, v6_), u5 = CU_(x5_, x6_, x7_, v5_, v6_, v7_);
        const float u6 = CU_(x6_, x7_, x8_, v6_, v7_, v8_), u7 = CU_(x7_, x8_, x9_, v7_, v8_, v9_);
#undef CU_
        const unsigned blk = (t8 >> 5) + 16; const unsigned chunk = (t8 >> 3) & 3;
        *(u32x4*)(U + pb * UB + blk * 64 + ((chunk ^ ((blk >> 2) & 3)) << 4)) = mk4(pack2(u0, u1), pack2(u2, u3), pack2(u4, u5), pack2(u6, u7));
      }
    }
    const unsigned short* fsrc = P.filt + ((long)(layer * 512 + c)) * 24576 + (set ? 16384 : 0);
#pragma unroll
    for (int rd = 0; rd < 2 * L / 8 / 256; ++rd) { const int id = tid + 256 * rd; *(u32x4*)(F + id * 16) = *(const u32x4*)(fsrc + id * 8); }
    if (tid < 8) *(u32x4*)(F + 2 * L * 2 + tid * 16) = mk4(0, 0, 0, 0);
  }
  __syncthreads();

  const int pw = wave / WPB;
  const int T0w = (wave % WPB) * 64;
  const int ii = lane & 31, h = lane >> 5;
  const int bb = (lane >> 4) & 1, mm = lane & 15;
  const char* Uw = U + (pw * 2 + bb) * UB;
  const int base0 = L - ii + 8 * h;
  const int wdw = base0 >> 1; const unsigned sh = (unsigned)(base0 & 1) * 16u;
  f32x16 acc[4];
#pragma unroll
  for (int r = 0; r < 4; ++r)
#pragma unroll
    for (int e = 0; e < 16; ++e) acc[r][e] = 0.f;
  bf16x8 Ar[4][2];
  unsigned raw[2][5];

#define LOADA_RAW(ptr_) do { const unsigned* fp_ = (const unsigned*)(ptr_); \
    _Pragma("unroll") for (int j_ = 0; j_ < 5; ++j_) { raw[0][j_] = fp_[j_]; raw[1][j_] = fp_[8 + j_]; } } while (0)
#define FIXA(dst_) do { _Pragma("unroll") for (int k_ = 0; k_ < 2; ++k_) { union { unsigned u[4]; bf16x8 f; } x_; \
    _Pragma("unroll") for (int j_ = 0; j_ < 4; ++j_) x_.u[j_] = __builtin_amdgcn_alignbit(raw[k_][j_ + 1], raw[k_][j_], sh); \
    (dst_)[k_] = x_.f; } } while (0)
#define LOADB(dst_, q_) do { (dst_)[0] = *(const bf16x8*)(ub0 + 1024 * (q_)); (dst_)[1] = *(const bf16x8*)(ub1 + 1024 * (q_)); } while (0)
#define MMAS(u_, B_) do { _Pragma("unroll") for (int r_ = 0; r_ < 4; ++r_) { \
    acc[r_] = mfma32(Ar[(r_ - (u_) + 4) & 3][0], (B_)[0], acc[r_]); \
    acc[r_] = mfma32(Ar[(r_ - (u_) + 4) & 3][1], (B_)[1], acc[r_]); } } while (0)

  for (int e = 0; e < 16; ++e) {
    const int sb0 = e - 15;
    const int D0 = T0w - sb0;
    const char* fa = F + 4 * wdw - 64 * D0;
    const int blk0 = sb0 + mm + 16; const int swz = (blk0 >> 2) & 3;
    const char* ub0 = Uw + blk0 * 64 + ((h ^ swz) << 4);
    const char* ub1 = Uw + blk0 * 64 + (((2 + h) ^ swz) << 4);
    unsigned rawp[3][2][5];
#pragma unroll
    for (int s_ = 1; s_ < 4; ++s_) { const unsigned* fp_ = (const unsigned*)(fa - 1024 * s_);
#pragma unroll
      for (int j_ = 0; j_ < 5; ++j_) { rawp[s_ - 1][0][j_] = fp_[j_]; rawp[s_ - 1][1][j_] = fp_[8 + j_]; } }
    bf16x8 Bc[2], Bn[2];
    LOADA_RAW(fa); LOADB(Bc, 0);
#pragma unroll
    for (int s_ = 1; s_ < 4; ++s_) {
#pragma unroll
      for (int k_ = 0; k_ < 2; ++k_) { union { unsigned u[4]; bf16x8 f; } x_;
#pragma unroll
        for (int j_ = 0; j_ < 4; ++j_) x_.u[j_] = __builtin_amdgcn_alignbit(rawp[s_ - 1][k_][j_ + 1], rawp[s_ - 1][k_][j_], sh);
        Ar[s_][k_] = x_.f; }
    }
    for (int Q = 0; Q < (NSTEP - 1) / 4; ++Q) {
      const char* fq = fa + 4096 * Q;
      const int q0 = 4 * Q;
      FIXA(Ar[0]); LOADA_RAW(fq + 1024); LOADB(Bn, q0 + 1); __builtin_amdgcn_sched_barrier(0);
      MMAS(0, Bc); __builtin_amdgcn_sched_barrier(0);
      FIXA(Ar[3]); LOADA_RAW(fq + 2048); LOADB(Bc, q0 + 2); __builtin_amdgcn_sched_barrier(0);
      MMAS(1, Bn); __builtin_amdgcn_sched_barrier(0);
      FIXA(Ar[2]); LOADA_RAW(fq + 3072); LOADB(Bn, q0 + 3); __builtin_amdgcn_sched_barrier(0);
      MMAS(2, Bc); __builtin_amdgcn_sched_barrier(0);
      FIXA(Ar[1]); LOADA_RAW(fq + 4096); LOADB(Bc, q0 + 4); __builtin_amdgcn_sched_barrier(0);
      MMAS(3, Bn); __builtin_amdgcn_sched_barrier(0);
    }
    FIXA(Ar[0]);
    MMAS(0, Bc);
  }
#undef LOADA_RAW
#undef FIXA
#undef LOADB
#undef MMAS
  {
    const float hb = P.hy_bias[layer * 512 + c];
    const float w0a = cw[c], w0b = cw[1536 + c], w0c = cw[3072 + c], b0 = cb[c];
    const long boff = (long)(pw * 2 + bb) * L;
    unsigned short* yout = P.zT + (long)(512 + c) * NTOK + setbase + boff;
    unsigned short* ygout = P.zT + (long)(1024 + c) * NTOK + setbase + boff;
    const unsigned short* sgr = P.zT + (long)(2048 + c) * NTOK + setbase + boff;
    const unsigned short* x0b = x0r + boff;
#pragma unroll
    for (int rh = 0; rh < 2; ++rh) {
      u32x2 XV[8], SG[8]; float XL[8], XR[8];
#pragma unroll
      for (int q = 0; q < 8; ++q) {
        const int r = 2 * rh + (q >> 2), g4 = q & 3;
        const int t0 = T0w + 16 * r + mm;
        const unsigned t = (unsigned)(t0 * 32 + 8 * g4 + 4 * h);
        const unsigned bo = t * 2u;
        XV[q] = *(const u32x2*)((const char*)x0b + bo);
        SG[q] = *(const u32x2*)((const char*)sgr + bo);
        const unsigned lo_ = t > 0 ? bo - 2u : bo, hi_ = (t + 4 < (unsigned)L) ? bo + 8u : bo;
        const float xl = bf2f(*(const unsigned short*)((const char*)x0b + lo_)), xr = bf2f(*(const unsigned short*)((const char*)x0b + hi_));
        XL[q] = t > 0 ? xl : 0.f; XR[q] = (t + 4 < (unsigned)L) ? xr : 0.f;
      }
#pragma unroll
      for (int q = 0; q < 8; ++q) {
        const int r = 2 * rh + (q >> 2), g4 = q & 3;
        const int t0 = T0w + 16 * r + mm; const int blk = t0 + 16;
        const unsigned t = (unsigned)(t0 * 32 + 8 * g4 + 4 * h);
        const u32x2 uv = *(const u32x2*)(Uw + blk * 64 + ((g4 ^ ((blk >> 2) & 3)) << 4) + 8 * h);
        const u32x2 xv = XV[q], sgv = SG[q];
        const float xs0 = XL[q], xs1 = lo2f(xv.x), xs2 = hi2f(xv.x), xs3 = lo2f(xv.y), xs4 = hi2f(xv.y), xs5 = XR[q];
        const float o0 = (w0a * xs0 + w0b * xs1 + w0c * xs2 + b0) * (acc[r][4 * g4 + 0] + hb * lo2f(uv.x));
        const float o1 = (w0a * xs1 + w0b * xs2 + w0c * xs3 + b0) * (acc[r][4 * g4 + 1] + hb * hi2f(uv.x));
        const float o2 = (w0a * xs2 + w0b * xs3 + w0c * xs4 + b0) * (acc[r][4 * g4 + 2] + hb * lo2f(uv.y));
        const float o3 = (w0a * xs3 + w0b * xs4 + w0c * xs5 + b0) * (acc[r][4 * g4 + 3] + hb * hi2f(uv.y));
        *(u32x2*)(yout + t) = mk2(pack2(o0, o1), pack2(o2, o3));
        *(u32x2*)(ygout + t) = mk2(pack2(o0 * lo2f(sgv.x), o1 * hi2f(sgv.x)), pack2(o2 * lo2f(sgv.y), o3 * hi2f(sgv.y)));
      }
    }
  }
  __syncthreads();
}

__device__ void attn_unit(const Params& P, int layer, int a, char* lds) {
  float* rp = (float*)lds;
  const int tid = opaque_tid(), lane = tid & 63, wave = tid >> 6;
  const int hd = a & 7, rowg = a >> 3;
  int rows, r;
  if (rowg < 512) { rows = 128; r = rowg & 127; } else { rows = 64; r = (rowg - 512) & 63; }
  const int rowbase = rowg - r;
  const int r0 = min(max(r - 4, 0), rows - 8);
  for (int i = tid; i < 465; i += 256) rp[i] = P.rpb[(layer * 8 + hd) * 465 + i] * LOG2E;
  __syncthreads();
  const int c0 = wave * 16; const int kc0 = min(max(c0 - 8, 0), 32);
  const int qi = lane & 15, g = lane >> 4;
  const long qtok = (long)rowg * 64 + c0 + qi;
  const unsigned short* qptr = P.z2 + qtok * 1536 + hd * 64 + 8 * g;
  const bf16x8 Qf0 = *(const bf16x8*)qptr, Qf1 = *(const bf16x8*)(qptr + 32);
  f32x4 S[16];
  const long bandtok = (long)(rowbase + r0) * 64;
  {
    bf16x8 Kf[16][2];
#pragma unroll
    for (int T = 0; T < 16; ++T) {
      const int kr = T >> 1, half = T & 1;
      const unsigned ktok = (unsigned)bandtok + kr * 64 + kc0 + 8 * (qi >> 2) + (qi & 3) + 4 * half;
      const unsigned ko = (ktok * 1536u + 512u + hd * 64 + 8 * g) * 2u;
      Kf[T][0] = *(const bf16x8*)((const char*)P.z2 + ko); Kf[T][1] = *(const bf16x8*)((const char*)P.z2 + (ko + 64u));
    }
    __builtin_amdgcn_sched_barrier(0);
#pragma unroll
    for (int T = 0; T < 16; ++T) {
      f32x4 s_ = {0.f, 0.f, 0.f, 0.f};
      s_ = mfma16(Kf[T][0], Qf0, s_); s_ = mfma16(Kf[T][1], Qf1, s_);
      S[T] = s_;
    }
  }
  bf16x8 Vf[8][4];
  const unsigned vo0 = ((unsigned)(1536 + hd * 64 + qi) * (unsigned)NTOK + (unsigned)bandtok + kc0 + 8 * g) * 2u;
#define ATT_VLOAD(kr_) do { _Pragma("unroll") for (int dt = 0; dt < 4; ++dt) \
    Vf[kr_][dt] = *(const bf16x8*)((const char*)P.zT + (vo0 + (unsigned)dt * (16u * NTOK * 2u) + (unsigned)(kr_) * 128u)); } while (0)
#pragma unroll
  for (int kr = 0; kr < 4; ++kr) ATT_VLOAD(kr);
  __builtin_amdgcn_sched_barrier(0);
  const int qc = c0 + qi; const int cs = min(max(qc - 8, 0), 48);
  float mx = -1e30f;
#pragma unroll
  for (int T = 0; T < 16; ++T) {
    const int kr = T >> 1, half = T & 1;
    const int ro = r0 + kr - r + 7;
#pragma unroll
    for (int e = 0; e < 4; ++e) {
      const int kc = kc0 + 8 * g + e + 4 * half;
      const bool valid = (kc >= cs) && (kc < cs + 16);
      const int idx = valid ? (ro * 31 + kc - qc + 15) : 0;
      float v = valid ? (S[T][e] + rp[idx]) : -1e30f;
      S[T][e] = v; mx = fmaxf(mx, v);
    }
  }
  mx = fmaxf(mx, __shfl_xor(mx, 16)); mx = fmaxf(mx, __shfl_xor(mx, 32));
  float sum = 0.f;
#pragma unroll
  for (int T = 0; T < 16; ++T)
#pragma unroll
    for (int e = 0; e < 4; ++e) { float p = exp2f(S[T][e] - mx); S[T][e] = p; sum += p; }
  sum += __shfl_xor(sum, 16); sum += __shfl_xor(sum, 32);
#pragma unroll
  for (int kr = 4; kr < 8; ++kr) ATT_VLOAD(kr);
#undef ATT_VLOAD
  f32x4 O[4];
#pragma unroll
  for (int dt = 0; dt < 4; ++dt) O[dt] = (f32x4){0.f, 0.f, 0.f, 0.f};
#pragma unroll
  for (int kr = 0; kr < 8; ++kr) {
    union { unsigned u[4]; bf16x8 f; } pf;
    pf.u[0] = pack2(S[2 * kr][0], S[2 * kr][1]); pf.u[1] = pack2(S[2 * kr][2], S[2 * kr][3]);
    pf.u[2] = pack2(S[2 * kr + 1][0], S[2 * kr + 1][1]); pf.u[3] = pack2(S[2 * kr + 1][2], S[2 * kr + 1][3]);
#pragma unroll
    for (int dt = 0; dt < 4; ++dt) O[dt] = mfma16(Vf[kr][dt], pf.f, O[dt]);
  }
  const float inv = 1.f / sum; float ss = 0.f;
#pragma unroll
  for (int dt = 0; dt < 4; ++dt) {
    float o[4];
#pragma unroll
    for (int e = 0; e < 4; ++e) { o[e] = O[dt][e] * inv; ss += o[e] * o[e]; }
    const u32x2 sgv = *(const u32x2*)(P.z2 + qtok * 1536 + 1024 + hd * 64 + 16 * dt + 4 * g);
    *(u32x2*)(P.z2 + qtok * 1536 + hd * 64 + 16 * dt + 4 * g) = mk2(pack2(o[0] * lo2f(sgv.x), o[1] * hi2f(sgv.x)), pack2(o[2] * lo2f(sgv.y), o[3] * hi2f(sgv.y)));
  }
  ss += __shfl_xor(ss, 16); ss += __shfl_xor(ss, 32);
  if (g == 0) P.ssqA[qtok * 8 + hd] = ss;
  __syncthreads();
}

__device__ void phase_p2(const Params& P, int layer, int bid, int nb, char* lds, int what) {
  const bool attn_first = (what == 3) && (bid >= (nb >> 1));
  if (attn_first) for (int a = bid; a < 6144; a += nb) attn_unit(P, layer, a, lds);
  if (what & 1) for (int u = bid; u < 1536; u += nb) {
    if (u < 1024) conv_unit<8192, 1>(P, layer, 0, u & 511, u >> 9, lds);
    else conv_unit<4096, 2>(P, layer, 1, u - 1024, 0, lds);
  }
  if ((what & 2) && !attn_first) for (int a = bid; a < 6144; a += nb) attn_unit(P, layer, a, lds);
}

__device__ void phase_hyT(const Params& P, int bid, int nb, char* lds) {
  const int tid = opaque_tid(), lane = tid & 63, wave = tid >> 6;
  const int krow = tid >> 4, tc = tid & 15;
  char* Tk = lds;
  float* red = (float*)(lds + 64 * 264);
  for (int u = bid; u < 3072; u += nb) {
    const int mt = u >> 3, g = u & 7; const int tok0 = mt * 128;
    float ssh[8];
#pragma unroll
    for (int e = 0; e < 8; ++e) ssh[e] = 0.f;
#pragma unroll
    for (int i = 0; i < 4; ++i) {
      const int k = krow + 16 * i;
      const u32x4 raw = ldg16(P.zT, (unsigned)(((512 + 64 * g + k) * NTOK + tok0 + 8 * tc) * 2));
      const u32x4 gat = ldg16(P.zT, (unsigned)(((1024 + 64 * g + k) * NTOK + tok0 + 8 * tc) * 2));
      float y[8]; unpack8(raw, y);
#pragma unroll
      for (int e = 0; e < 8; ++e) ssh[e] += y[e] * y[e];
      *(u32x2*)(Tk + k * 264 + tc * 16) = mk2(gat.x, gat.y);
      *(u32x2*)(Tk + k * 264 + tc * 16 + 8) = mk2(gat.z, gat.w);
    }
#pragma unroll
    for (int e = 0; e < 8; ++e) {
      float s_ = ssh[e];
      s_ += __shfl_xor(s_, 16); s_ += __shfl_xor(s_, 32);
      if (lane < 16) red[wave * 128 + 8 * tc + e] = s_;
    }
    __syncthreads();
    if (tid < 128) P.ssqH[(long)(tok0 + tid) * 8 + g] = red[tid] + red[128 + tid] + red[256 + tid] + red[384 + tid];
#pragma unroll
    for (int i = 0; i < 4; ++i) {
      const int id = tid + 256 * i; const int tok = id >> 3, kc = id & 7;
      unsigned short v[8];
#pragma unroll
      for (int e = 0; e < 8; ++e) v[e] = *(const unsigned short*)(Tk + (8 * kc + e) * 264 + tok * 2);
      *(u32x4*)(P.z2 + (long)(tok0 + tok) * 1536 + 512 + 64 * g + 8 * kc) =
          mk4((unsigned)v[0] | ((unsigned)v[1] << 16), (unsigned)v[2] | ((unsigned)v[3] << 16),
              (unsigned)v[4] | ((unsigned)v[5] << 16), (unsigned)v[6] | ((unsigned)v[7] << 16));
    }
    __syncthreads();
  }
}

__device__ void p3_tile(const Params& P, int layer, int mt, int nt, char* lds) {
  constexpr int ASTR = 272, STG = 64 * ASTR + 16384;
  const int tid = opaque_tid(), lane = tid & 63, wave = tid >> 6;
  const int tok0 = mt * 128, n0 = nt * 128;
  const unsigned short* wsrc = P.woutT + ((long)layer * 1024 + n0) * 1024;
  const float* xres = (layer == 0) ? ((tok0 < NPTOK) ? P.xp + (long)tok0 * 1024 : P.xs + (long)(tok0 - NPTOK) * 1024)
                                   : P.out + (long)tok0 * 1024;
  float* rh = (float*)(lds + 2 * STG); float* ra = rh + 128;
  if (tid < 128) {
    const f32x4* sp = (const f32x4*)(P.ssqA + (long)(tok0 + tid) * 8);
    f32x4 s0 = sp[0], s1 = sp[1];
    const float rat = rsqrtf((s0.x + s0.y + s0.z + s0.w + s1.x + s1.y + s1.z + s1.w) * (1.f / 512.f) + EPSV);
    const f32x4* hp = (const f32x4*)(P.ssqH + (long)(tok0 + tid) * 8);
    f32x4 h0 = hp[0], h1 = hp[1];
    const float rht = rsqrtf((h0.x + h0.y + h0.z + h0.w + h1.x + h1.y + h1.z + h1.w) * (1.f / 512.f) + EPSV);
    ra[tid] = rat;
    rh[tid] = rht / rat;
  }
  const int wp = wave >> 1, wq = wave & 1;
  const int r8 = tid >> 3, ch = tid & 7;
  const int kr = tid >> 4, tc = tid & 15;
  f32x16 acc[2][2];
#pragma unroll
  for (int i = 0; i < 2; ++i)
#pragma unroll
    for (int j = 0; j < 2; ++j)
#pragma unroll
      for (int e = 0; e < 16; ++e) acc[i][j][e] = 0.f;
  u32x4 gv[4], bv[4];
  const unsigned yg_off = (unsigned)(((1024 + kr) * NTOK + tok0 + 8 * tc) * 2);
  const unsigned at_off = (unsigned)(((tok0 + r8) * 1536 + 8 * ch) * 2);
  const unsigned b_off = (unsigned)((r8 * 1024 + ch * 8) * 2);
#define P3_LOAD_HY(k_) do { _Pragma("unroll") for (int i = 0; i < 4; ++i) { \
    gv[i] = ldg16(P.zT, yg_off + (unsigned)(k_) * (64u * NTOK * 2u) + (unsigned)i * (16u * NTOK * 2u)); \
    bv[i] = ldg16(wsrc, b_off + (unsigned)(k_) * 128u + (unsigned)i * 65536u); } } while (0)
#define P3_LOAD_AT(k_) do { _Pragma("unroll") for (int i = 0; i < 4; ++i) { \
    gv[i] = ldg16(P.z2, at_off + (unsigned)((k_) - 8) * 128u + (unsigned)i * (32u * 1536u * 2u)); \
    bv[i] = ldg16(wsrc, b_off + (unsigned)(k_) * 128u + (unsigned)i * 65536u); } } while (0)
#define P3_STORE_HY(buf_) do { char* A_ = lds + (buf_) * STG; char* B_ = A_ + 64 * ASTR; \
    _Pragma("unroll") for (int i = 0; i < 4; ++i) { *(u32x4*)(A_ + (kr + 16 * i) * ASTR + tc * 16) = gv[i]; \
      *(u32x4*)(B_ + swz_off(r8 + 32 * i, ch)) = bv[i]; } } while (0)
#define P3_STORE_AT(buf_) do { char* A_ = lds + (buf_) * STG; char* B_ = A_ + 64 * ASTR; \
    _Pragma("unroll") for (int i = 0; i < 4; ++i) { *(u32x4*)(A_ + swz_off(r8 + 32 * i, ch)) = gv[i]; \
      *(u32x4*)(B_ + swz_off(r8 + 32 * i, ch)) = bv[i]; } } while (0)
#define P3_MMA_HY(cur_) do { const char* As = lds + (cur_) * STG; const char* Bs = As + 64 * ASTR; \
    _Pragma("unroll") for (int kk = 0; kk < 4; ++kk) { bf16x8 a[2], b[2]; \
      _Pragma("unroll") for (int i = 0; i < 2; ++i) { \
        const int l16 = lane & 15; const int krow = 16 * kk + 8 * (lane >> 5) + (l16 >> 2); \
        const int tcol = 64 * wp + 32 * i + 16 * ((lane >> 4) & 1) + 4 * (l16 & 3); \
        lds_cptr ap = (lds_cptr)As + krow * ASTR + tcol * 2; \
        s16x4 lo = __builtin_bit_cast(s16x4, __builtin_amdgcn_ds_read_tr16_b64_v4i16((__attribute__((address_space(3))) v4i16_t*)ap)); \
        s16x4 hi = __builtin_bit_cast(s16x4, __builtin_amdgcn_ds_read_tr16_b64_v4i16((__attribute__((address_space(3))) v4i16_t*)(ap + 4 * ASTR))); \
        a[i] = (bf16x8){lo[0], lo[1], lo[2], lo[3], hi[0], hi[1], hi[2], hi[3]}; } \
      _Pragma("unroll") for (int j = 0; j < 2; ++j) b[j] = *(const bf16x8*)(Bs + swz_off(64 * wq + 32 * j + (lane & 31), 2 * kk + (lane >> 5))); \
      _Pragma("unroll") for (int i = 0; i < 2; ++i) _Pragma("unroll") for (int j = 0; j < 2; ++j) acc[i][j] = mfma32(a[i], b[j], acc[i][j]); } } while (0)
#define P3_MMA_AT(cur_) do { const char* As = lds + (cur_) * STG; const char* Bs = As + 64 * ASTR; \
    _Pragma("unroll") for (int kk = 0; kk < 4; ++kk) { bf16x8 a[2], b[2]; \
      _Pragma("unroll") for (int i = 0; i < 2; ++i) a[i] = *(const bf16x8*)(As + swz_off(64 * wp + 32 * i + (lane & 31), 2 * kk + (lane >> 5))); \
      _Pragma("unroll") for (int j = 0; j < 2; ++j) b[j] = *(const bf16x8*)(Bs + swz_off(64 * wq + 32 * j + (lane & 31), 2 * kk + (lane >> 5))); \
      _Pragma("unroll") for (int i = 0; i < 2; ++i) _Pragma("unroll") for (int j = 0; j < 2; ++j) acc[i][j] = mfma32(a[i], b[j], acc[i][j]); } } while (0)
  P3_LOAD_HY(0);
  P3_STORE_HY(0);
  P3_LOAD_HY(1);
  __syncthreads();
  for (int ks = 0; ks < 6; ++ks) {
    const int cur = ks & 1;
    P3_STORE_HY(cur ^ 1);
    P3_LOAD_HY(ks + 2);
    P3_MMA_HY(cur);
    __syncthreads();
  }
  P3_STORE_HY(1); P3_LOAD_AT(8); P3_MMA_HY(0); __syncthreads();
  P3_STORE_AT(0); P3_LOAD_AT(9); P3_MMA_HY(1); __syncthreads();
#pragma unroll
  for (int i = 0; i < 2; ++i)
#pragma unroll
    for (int e = 0; e < 16; ++e) {
      const float sc = rh[64 * wp + 32 * i + (e & 3) + 8 * (e >> 2) + 4 * (lane >> 5)];
      acc[i][0][e] *= sc; acc[i][1][e] *= sc;
    }
  for (int ks = 8; ks < 16; ++ks) {
    const int cur = ks & 1;
    if (ks + 1 < 16) P3_STORE_AT(cur ^ 1);
    if (ks + 2 < 16) P3_LOAD_AT(ks + 2);
    P3_MMA_AT(cur);
    __syncthreads();
  }
#undef P3_LOAD_HY
#undef P3_LOAD_AT
#undef P3_STORE_HY
#undef P3_STORE_AT
#undef P3_MMA_HY
#undef P3_MMA_AT
  char* blk = (char*)P.out + (long)tok0 * 4096 + nt * 512;
  char* Sh = lds; char* Sl = lds + 34816;
#pragma unroll
  for (int i = 0; i < 2; ++i)
#pragma unroll
    for (int e = 0; e < 16; ++e) {
      const float sc = ra[64 * wp + 32 * i + (e & 3) + 8 * (e >> 2) + 4 * (lane >> 5)];
      acc[i][0][e] *= sc; acc[i][1][e] *= sc;
    }
  __syncthreads();
  if (layer == 0) {
#pragma unroll
    for (int i = 0; i < 2; ++i)
#pragma unroll
      for (int j = 0; j < 2; ++j) {
        const int nl = 64 * wq + 32 * j + (lane & 31);
#pragma unroll
        for (int e = 0; e < 16; ++e) {
          const int r = 64 * wp + 32 * i + (e & 3) + 8 * (e >> 2) + 4 * (lane >> 5);
          const float v = xres[(long)r * 1024 + n0 + nl] + acc[i][j][e];
          const unsigned ph = pack2(v, 0.f);
          const unsigned pl = pack2(v - lo2f(ph), 0.f);
          *(unsigned short*)(Sh + r * 272 + nl * 2) = (unsigned short)ph;
          *(unsigned short*)(Sl + r * 272 + nl * 2) = (unsigned short)pl;
        }
      }
    __syncthreads();
#pragma unroll
    for (int it = 0; it < 16; ++it) {
      const int id = tid + 256 * it; const int half = id >> 11, row = (id >> 4) & 127, c16 = id & 15;
      const u32x4 cv = *(const u32x4*)((half ? Sl : Sh) + row * 272 + c16 * 16);
      *(u32x4*)(blk + row * 4096 + half * 256 + c16 * 16) = cv;
      if (it < 8) {
        float f[8]; unpack8(cv, f);
        float ss = 0.f;
#pragma unroll
        for (int e = 0; e < 8; ++e) ss += f[e] * f[e];
        ss += __shfl_xor(ss, 1); ss += __shfl_xor(ss, 2); ss += __shfl_xor(ss, 4); ss += __shfl_xor(ss, 8);
        if (c16 == 0) P.ssqX[(long)(tok0 + row) * 8 + nt] = ss;
      }
    }
  } else {
#pragma unroll
    for (int it = 0; it < 16; ++it) {
      const int id = tid + 256 * it; const int half = id >> 11, row = (id >> 4) & 127, c16 = id & 15;
      *(u32x4*)((half ? Sl : Sh) + row * 272 + c16 * 16) = *(const u32x4*)(blk + row * 4096 + half * 256 + c16 * 16);
    }
    __syncthreads();
#pragma unroll
    for (int i = 0; i < 2; ++i)
#pragma unroll
      for (int j = 0; j < 2; ++j) {
        const int nl = 64 * wq + 32 * j + (lane & 31);
#pragma unroll
        for (int e = 0; e < 16; ++e) {
          const int r = 64 * wp + 32 * i + (e & 3) + 8 * (e >> 2) + 4 * (lane >> 5);
          const float xh = bf2f(*(const unsigned short*)(Sh + r * 272 + nl * 2));
          const float xl = bf2f(*(const unsigned short*)(Sl + r * 272 + nl * 2));
          *(float*)(blk + r * 4096 + nl * 4) = (xh + xl) + acc[i][j][e];
        }
      }
  }
  __syncthreads();
}

__device__ void p3_wide(const Params& P, int layer, int mt, int nt, char* lds) {
  constexpr int STG = 8192 + 16384;
  const int tid = opaque_tid(), lane = tid & 63, wave = tid >> 6;
  const int wp = wave >> 1, wq = wave & 1;
  const int tok0 = mt * 128, n0 = nt * 256;
  const char* asrc = (const char*)P.z2 + (long)tok0 * 3072;
  const unsigned short* wsrc = P.woutT + ((long)layer * 1024 + n0) * 1024;
  const float* xres = (tok0 < NPTOK) ? P.xp + (long)tok0 * 1024 : P.xs + (long)(tok0 - NPTOK) * 1024;
  float* rh = (float*)(lds + 2 * STG); float* ra = rh + 128;
  f32x16 acc[2][4];
#pragma unroll
  for (int i = 0; i < 2; ++i)
#pragma unroll
    for (int j = 0; j < 4; ++j)
#pragma unroll
      for (int e = 0; e < 16; ++e) acc[i][j][e] = 0.f;
  unsigned ga[2], la[2], gb[4], lb[4];
#pragma unroll
  for (int i = 0; i < 2; ++i) {
    const int m = wave * 2 + i; const int row = 16 * m + (lane >> 2); const int cc = (lane & 3) ^ ((row >> 2) & 3);
    ga[i] = (unsigned)(row * 3072 + cc * 16); la[i] = (unsigned)(m * 1024 + lane * 16);
  }
#pragma unroll
  for (int i = 0; i < 4; ++i) {
    const int m = wave * 4 + i; const int row = 16 * m + (lane >> 2); const int cc = (lane & 3) ^ ((row >> 2) & 3);
    gb[i] = (unsigned)(row * 2048 + cc * 16); lb[i] = (unsigned)(8192 + m * 1024 + lane * 16);
  }
#define P3W_DMA(ks_, buf_) do { const unsigned ak_ = (((unsigned)(ks_) + 16u) & 31u) * 64u; \
    _Pragma("unroll") for (int i = 0; i < 2; ++i) __builtin_amdgcn_global_load_lds((const unsigned*)(asrc + ga[i] + ak_), (unsigned*)(lds + (buf_) * STG + la[i]), 16, 0, 0); \
    _Pragma("unroll") for (int i = 0; i < 4; ++i) __builtin_amdgcn_global_load_lds((const unsigned*)((const char*)wsrc + gb[i] + (unsigned)(ks_) * 64u), (unsigned*)(lds + (buf_) * STG + lb[i]), 16, 0, 0); } while (0)
  P3W_DMA(0, 0);
  if (tid < 128) {
    const f32x4* sp = (const f32x4*)(P.ssqA + (long)(tok0 + tid) * 8);
    const f32x4 s0 = sp[0], s1 = sp[1];
    const float rat = rsqrtf((s0.x + s0.y + s0.z + s0.w + s1.x + s1.y + s1.z + s1.w) * (1.f / 512.f) + EPSV);
    const f32x4* hp = (const f32x4*)(P.ssqH + (long)(tok0 + tid) * 8);
    const f32x4 h0 = hp[0], h1 = hp[1];
    const float rht = rsqrtf((h0.x + h0.y + h0.z + h0.w + h1.x + h1.y + h1.z + h1.w) * (1.f / 512.f) + EPSV);
    ra[tid] = rat; rh[tid] = rht / rat;
  }
#define P3W_STEP(ks_) do { const int cur = (ks_) & 1; \
    __syncthreads(); \
    if ((ks_) + 1 < 32) P3W_DMA((ks_) + 1, cur ^ 1); \
    const char* Ts = lds + cur * STG; const char* Ws = Ts + 8192; \
    _Pragma("unroll") for (int kk = 0; kk < 2; ++kk) { bf16x8 a[2], b[4]; \
      _Pragma("unroll") for (int i = 0; i < 2; ++i) a[i] = *(const bf16x8*)(Ts + swz64(64 * wp + 32 * i + (lane & 31), 2 * kk + (lane >> 5))); \
      _Pragma("unroll") for (int j = 0; j < 4; ++j) b[j] = *(const bf16x8*)(Ws + swz64(128 * wq + 32 * j + (lane & 31), 2 * kk + (lane >> 5))); \
      _Pragma("unroll") for (int i = 0; i < 2; ++i) _Pragma("unroll") for (int j = 0; j < 4; ++j) acc[i][j] = mfma32(a[i], b[j], acc[i][j]); } } while (0)
  for (int ks = 0; ks < 16; ++ks) P3W_STEP(ks);
#pragma unroll
  for (int i = 0; i < 2; ++i)
#pragma unroll
    for (int e = 0; e < 16; ++e) {
      const float sc = rh[64 * wp + 32 * i + (e & 3) + 8 * (e >> 2) + 4 * (lane >> 5)];
#pragma unroll
      for (int j = 0; j < 4; ++j) acc[i][j][e] *= sc;
    }
  for (int ks = 16; ks < 32; ++ks) P3W_STEP(ks);
#undef P3W_STEP
#undef P3W_DMA
  __syncthreads();
#pragma unroll
  for (int i = 0; i < 2; ++i)
#pragma unroll
    for (int e = 0; e < 16; ++e) {
      const float sc = ra[64 * wp + 32 * i + (e & 3) + 8 * (e >> 2) + 4 * (lane >> 5)];
#pragma unroll
      for (int j = 0; j < 4; ++j) acc[i][j][e] *= sc;
    }
  __syncthreads();
  char* Sa = lds;
#pragma unroll
  for (int i = 0; i < 2; ++i)
#pragma unroll
    for (int j = 0; j < 4; ++j)
#pragma unroll
      for (int e = 0; e < 16; ++e) {
        const unsigned r = 64u * wp + 32u * i + (e & 3) + 8u * (e >> 2) + 4u * (lane >> 5);
        const unsigned n = 128u * wq + 32u * j + (lane & 31);
        *(unsigned short*)(Sa + r * 528u + n * 2u) = (unsigned short)pack2(acc[i][j][e], 0.f);
      }
  __syncthreads();
#pragma unroll
  for (int grp = 0; grp < 4; ++grp) {
    u32x4 A_[4], G0[4], G1[4];
#pragma unroll
    for (int q = 0; q < 4; ++q) {
      const unsigned id = tid + 256u * (4 * grp + q); const unsigned row = id >> 5, c32 = id & 31u, cbl = c32 >> 4, c16 = c32 & 15u;
      A_[q] = *(const u32x4*)(Sa + row * 528u + c32 * 16u);
      const char* blk = (const char*)P.out + (long)(tok0 + row) * 4096 + (2 * nt + cbl) * 512;
      const char* xrow = (const char*)(xres + (long)row * 1024 + n0 + 8 * c32);
      const char* p0 = layer ? blk + c16 * 16u : xrow;
      const char* p1 = layer ? blk + 256u + c16 * 16u : xrow + 16;
      G0[q] = *(const u32x4*)p0; G1[q] = *(const u32x4*)p1;
    }
#pragma unroll
    for (int q = 0; q < 4; ++q) {
      const unsigned id = tid + 256u * (4 * grp + q); const unsigned row = id >> 5, c32 = id & 31u, cbl = c32 >> 4, c16 = c32 & 15u;
      float av[8]; unpack8(A_[q], av);
      char* blk = (char*)P.out + (long)(tok0 + row) * 4096 + (2 * nt + cbl) * 512;
      if (layer == 0) {
        const f32x4 x0 = __builtin_bit_cast(f32x4, G0[q]), x1 = __builtin_bit_cast(f32x4, G1[q]);
        const float v[8] = {x0.x + av[0], x0.y + av[1], x0.z + av[2], x0.w + av[3], x1.x + av[4], x1.y + av[5], x1.z + av[6], x1.w + av[7]};
        unsigned hi[4], lo[4]; float ss = 0.f;
#pragma unroll
        for (int k = 0; k < 4; ++k) {
          hi[k] = pack2(v[2 * k], v[2 * k + 1]);
          const float h0 = lo2f(hi[k]), h1 = hi2f(hi[k]);
          lo[k] = pack2(v[2 * k] - h0, v[2 * k + 1] - h1);
          ss += h0 * h0 + h1 * h1;
        }
        *(u32x4*)(blk + c16 * 16u) = mk4(hi[0], hi[1], hi[2], hi[3]);
        *(u32x4*)(blk + 256u + c16 * 16u) = mk4(lo[0], lo[1], lo[2], lo[3]);
        ss += __shfl_xor(ss, 1); ss += __shfl_xor(ss, 2); ss += __shfl_xor(ss, 4); ss += __shfl_xor(ss, 8);
        if (c16 == 0) P.ssqX[(long)(tok0 + row) * 8 + 2 * nt + cbl] = ss;
      } else {
        float h[8], l[8];
        unpack8(G0[q], h); unpack8(G1[q], l);
        f32x4 o0 = {(h[0] + l[0]) + av[0], (h[1] + l[1]) + av[1], (h[2] + l[2]) + av[2], (h[3] + l[3]) + av[3]};
        f32x4 o1 = {(h[4] + l[4]) + av[4], (h[5] + l[5]) + av[5], (h[6] + l[6]) + av[6], (h[7] + l[7]) + av[7]};
        *(f32x4*)(blk + c16 * 32u) = o0;
        *(f32x4*)(blk + c16 * 32u + 16u) = o1;
      }
    }
  }
  __syncthreads();
}

__device__ void phase_p3(const Params& P, int layer, int bid, int nb, char* lds) {
  for (int v = bid; v < 1536; v += nb) {
    const int wv = v >> 9, within = v & 511, x = within & 7, idx = within >> 3;
    const int mt = wv * 128 + x * 16 + (idx >> 2);
    const int nt = idx & 3;
    p3_wide(P, layer, mt, nt, lds);
  }
}

#define XB_TMO      128
#define XB_XCNT(j)  (256  + 64 * (j))
#define XB_XSUB(j)  (1280 + 64 * (j))
#define XB_XGEN(j)  (2304 + 64 * (j))
#define XB_TOP      3328
#define XB_TOPGEN   3392
#define XCD_BAR_WORDS 3456
#define XB_SPIN_CAP (1u << 18)
#define LAS __attribute__((address_space(3)))

__device__ __forceinline__ unsigned xb_ld(unsigned* p)              { return __hip_atomic_load(p, __ATOMIC_RELAXED, __HIP_MEMORY_SCOPE_AGENT); }
__device__ __forceinline__ unsigned xb_add(unsigned* p, unsigned v) { return __hip_atomic_fetch_add(p, v, __ATOMIC_RELAXED, __HIP_MEMORY_SCOPE_AGENT); }
__device__ __forceinline__ unsigned xb_xcc_id() { return (unsigned)__builtin_amdgcn_s_getreg((3 << 11) | 20) & 0xFu; }
#define XB_SPIN(cond, bar) do { unsigned _sp = 0; while (cond) { __builtin_amdgcn_s_sleep(1); \
    if ((++_sp & 255u) == 0u) { if (xb_ld(&(bar)[XB_TMO])) break; if (_sp > XB_SPIN_CAP) { atomicAdd(&(bar)[XB_TMO], 1u); break; } } } } while (0)

struct XcdBarrier {
    unsigned* bar; unsigned x;
    volatile LAS unsigned* st;
};

__device__ __forceinline__ XcdBarrier xcd_barrier_post(unsigned* bar, volatile LAS unsigned* st) {
    XcdBarrier b; b.bar = bar; b.x = xb_xcc_id(); b.st = st;
    if (threadIdx.x == 0) (void)xb_add(&bar[XB_XCNT(b.x)], 1u);
    return b;
}
__device__ __forceinline__ void xcd_barrier_complete(unsigned* bar, unsigned x, unsigned& nloc, unsigned& nx) {
    const unsigned G = gridDim.x * gridDim.y * gridDim.z;
    unsigned sum, cnt, mine, sp = 0u;
    for (;;) {
        sum = 0u; cnt = 0u; mine = 0u;
#pragma unroll
        for (unsigned j = 0; j < 16; ++j) { const unsigned c = xb_ld(&bar[XB_XCNT(j)]); sum += c; cnt += (c > 0u) ? 1u : 0u; mine = (j == x) ? c : mine; }
        if (sum == G) break;
        __builtin_amdgcn_s_sleep(1);
        if ((++sp & 255u) == 0u) { if (xb_ld(&bar[XB_TMO])) break; if (sp > XB_SPIN_CAP) { atomicAdd(&bar[XB_TMO], 1u); break; } }
    }
    nloc = mine > 0u ? mine : 1u; nx = cnt > 0u ? cnt : 1u;
}

__device__ __forceinline__ void xcd_barrier(const XcdBarrier& b) {
    asm volatile("s_waitcnt vmcnt(0)" ::: "memory");
    __syncthreads();
    if (threadIdx.x == 0) {
        unsigned* bar = b.bar;
        __builtin_amdgcn_s_waitcnt(0);
        unsigned nloc = b.st[0], nx = b.st[1];
        if (nloc == 0u) { xcd_barrier_complete(bar, b.x, nloc, nx); b.st[0] = nloc; b.st[1] = nx; }
        const unsigned old = xb_add(&bar[XB_XSUB(b.x)], 1u);
        const unsigned gen = old / nloc;
        if (old + 1u == (gen + 1u) * nloc) {
            __builtin_amdgcn_fence(__ATOMIC_RELEASE, "agent");
            asm volatile("s_waitcnt vmcnt(0)" ::: "memory");
            const unsigned og = xb_add(&bar[XB_TOP], 1u);
            const unsigned tg = og / nx;
            if (og + 1u == (tg + 1u) * nx) xb_add(&bar[XB_TOPGEN], 1u);
            else XB_SPIN(xb_ld(&bar[XB_TOPGEN]) == tg, bar);
            __builtin_amdgcn_fence(__ATOMIC_ACQUIRE, "agent");
            xb_add(&bar[XB_XGEN(b.x)], 1u);
            asm volatile("s_waitcnt vmcnt(0)" ::: "memory");
        } else {
            XB_SPIN(xb_ld(&bar[XB_XGEN(b.x)]) == gen, bar);
            __builtin_amdgcn_fence(__ATOMIC_ACQUIRE, "agent");
            asm volatile("s_waitcnt vmcnt(0)" ::: "memory");
        }
    }
    __syncthreads();
}


__device__ __forceinline__ void run_phase(const Params& P, int ph, int bid, int nb, char* lds) {
  switch (ph) {
    case 0: phase_prep(P, bid, nb, lds); break;
    case 1: phase_p1(P, 0, bid, nb, lds, 0); break;
    case 2: phase_p2(P, 0, bid, nb, lds, 3); break;
    case 3: phase_p3(P, 0, bid, nb, lds); break;
    case 4: phase_p1(P, 1, bid, nb, lds, 0); break;
    case 5: phase_p2(P, 1, bid, nb, lds, 3); break;
    case 6: phase_p3(P, 1, bid, nb, lds); break;
  }
}

#if MULTI
#error "MULTI=1 debug path is stale (no ssqH pre-pass); kept only as a reference for the phase order"
__global__ void __launch_bounds__(256, 2) phase_kernel(Params P, int ph) {
  __shared__ __attribute__((aligned(16))) char lds[LDS_BYTES];
  run_phase(P, ph, blockIdx.x, gridDim.x, lds);
}
#else
__global__ void __launch_bounds__(256, 2) mega_kernel(Params P) {
  __shared__ __attribute__((aligned(16))) char lds[LDS_BYTES];
  cg::grid_group grid = cg::this_grid();
  __shared__ uint4 xb_words;
  if (threadIdx.x == 0) xb_words = make_uint4(0u, 0u, 0u, 0u);
  __syncthreads();
  const XcdBarrier xb = xcd_barrier_post(P.bar, (volatile LAS unsigned*)&xb_words);
  const int bid = blockIdx.x, nb = gridDim.x;
#pragma unroll 1
  for (int st = 0; st < NSTEPS; ++st) {
    const int ph = (int)((PROG >> (4 * st)) & 15ull);
    const int layer = (ph >= 4 && ph <= 6) ? 1 : 0;
    const int sub = ph == 0 ? 0 : (ph <= 6 ? ((ph - 1) % 3 + 1) : ph - 3);
    switch (sub) {
      case 0: phase_prep(P, bid, nb, lds); break;
      case 1: phase_p1(P, layer, bid, nb, lds, 0); break;
      case 6: case 7: case 8: phase_p1(P, 0, bid, nb, lds, sub - 5); break;
      case 2: phase_p2(P, layer, bid, nb, lds, 3); break;
      case 3: phase_hyT(P, bid, nb, lds); xcd_barrier(xb); phase_p3(P, layer, bid, nb, lds); break;
      case 4: phase_p2(P, layer, bid, nb, lds, 1); break;
      case 5: phase_p2(P, layer, bid, nb, lds, 2); break;
    }
    if (st == 0) grid.sync();
    else if (st < NSTEPS - 1) xcd_barrier(xb);
  }
}
#endif

extern "C" void kernel_launch(void* const* d_in, const int* in_sizes, int n_in, void* d_out, int out_size,
                              void* d_ws, size_t ws_size, hipStream_t stream) {
  Params P{};
  P.xp = (const float*)d_in[0]; P.xs = (const float*)d_in[1];
  P.norm_g = (const float*)d_in[2]; P.w_in = (const float*)d_in[3]; P.conv_w = (const float*)d_in[4];
  P.conv_b = (const float*)d_in[5]; P.f_w1 = (const float*)d_in[6]; P.f_b1 = (const float*)d_in[7];
  P.f_fr1 = (const float*)d_in[8]; P.f_w2 = (const float*)d_in[9]; P.f_b2 = (const float*)d_in[10];
  P.f_fr2 = (const float*)d_in[11]; P.f_w3 = (const float*)d_in[12]; P.hy_bias = (const float*)d_in[13];
  P.qn_g = (const float*)d_in[14]; P.kn_g = (const float*)d_in[15]; P.rpb = (const float*)d_in[16];
  P.on_hy = (const float*)d_in[17]; P.on_att = (const float*)d_in[18]; P.w_out = (const float*)d_in[19];
  P.out = (float*)d_out;
  char* ws = (char*)d_ws;
  size_t off = 0;
  P.zT = (unsigned short*)(ws + off); off += (size_t)2560 * NTOK * 2;
  P.z2 = (unsigned short*)(ws + off); off += (size_t)NTOK * 1536 * 2;
  P.filt = (unsigned short*)(ws + off); off += (size_t)2 * 512 * 24576 * 2;
  P.winT = (unsigned short*)(ws + off); off += (size_t)2 * 4096 * 1024 * 2;
  P.woutT = (unsigned short*)(ws + off); off += (size_t)2 * 1024 * 1024 * 2;
  P.ssqA = (float*)(ws + off); off += (size_t)NTOK * 8 * 4;
  P.rstd1 = (float*)(ws + off); off += (size_t)NTOK * 4;
  P.bar = (unsigned*)(ws + off); off += (size_t)XCD_BAR_WORDS * 4;
  P.ssqH = (float*)(ws + off); off += (size_t)NTOK * 8 * 4;
  P.ssqX = (float*)(ws + off); off += (size_t)NTOK * 8 * 4;
  P.xb1 = (unsigned short*)d_out;
  if (off > ws_size) { fprintf(stderr, "workspace too small: need %zu have %zu\n", off, ws_size); return; }
#if MULTI
  for (int ph = 0; ph < 7; ++ph) phase_kernel<<<512, 256, 0, stream>>>(P, ph);
#else
  static int grid_blocks = 0;
  if (!grid_blocks) {
    int dev = 0, cus = 0, per_cu = 0;
    hipGetDevice(&dev);
    hipDeviceGetAttribute(&cus, hipDeviceAttributeMultiprocessorCount, dev);
    hipOccupancyMaxActiveBlocksPerMultiprocessor(&per_cu, mega_kernel, 256, 0);
    if (per_cu > 2) per_cu = 2;
    grid_blocks = cus * per_cu;
  }
  hipMemsetAsync(P.bar, 0, (size_t)XCD_BAR_WORDS * 4, stream);
  void* args[] = {&P};
  hipError_t e = hipLaunchCooperativeKernel((void*)mega_kernel, dim3(grid_blocks), dim3(256), args, 0, stream);
  if (e != hipSuccess) fprintf(stderr, "cooperative launch failed: %s (grid %d)\n", hipGetErrorString(e), grid_blocks);
#endif
}
```
